# Optimizing an MI355X kernel written in HIP

```python
import math
import jax, jax.numpy as jnp
from jax import lax
import numpy as np

D_MODEL = 1024
BATCH = 8
SEQ = 4096
DEPTH = 1

DA_HEADS = 4
DA_HEAD_DIM = 64
DA_V_DIM = 2 * DA_HEAD_DIM
DA_WIDTH = DA_HEADS * DA_V_DIM
Q_BLOCK = 128
ML_HEADS = 4
ML_HEAD_DIM = 128
ML_WIDTH = ML_HEADS * ML_HEAD_DIM
ML_CHUNK = 64
CONV_WIDTH = 4
N_GROUPS = 4
EXPERTS_PER_GROUP = 8
N_EXPERTS = N_GROUPS * EXPERTS_PER_GROUP
TOP_K_IN_GROUP = 2
EXPERT_FF = 512
MOE_BLOCK = 128
NORM_EPS = 1e-6

OFF_DA_Q = 0
OFF_DA_K = OFF_DA_Q + DA_HEADS * 2 * DA_HEAD_DIM
OFF_DA_V = OFF_DA_K + DA_HEADS * 2 * DA_HEAD_DIM
OFF_ML_QK = OFF_DA_V + DA_WIDTH
OFF_ML_V = OFF_ML_QK + 2 * ML_WIDTH
OFF_ML_O = OFF_ML_V + ML_WIDTH
OFF_ML_I = OFF_ML_O + ML_WIDTH
OFF_ML_F = OFF_ML_I + ML_HEADS
IN_WIDTH = OFF_ML_F + ML_HEADS

kernel_name = 'hybrid_diffattn_mlstm_hmoe'


def rms_norm(x, g):
    x32 = x.astype(jnp.float32)
    y = x32 * lax.rsqrt(jnp.mean(x32 * x32, axis=-1, keepdims=True) + NORM_EPS)
    return (y * g.astype(jnp.float32)).astype(x.dtype)


def alibi_slopes(n_heads):
    return jnp.asarray([2.0 ** (-8.0 * (i + 1) / n_heads) for i in range(n_heads)], jnp.float32)


def causal_conv(u, w, b):
    width = w.shape[0]
    s = u.shape[1]
    up = jnp.pad(u, ((0, 0), (width - 1, 0), (0, 0)))
    out = b
    for j in range(width):
        out = out + up[:, j:j + s] * w[j]
    return out


def diff_attention(q, k, v, lam, slopes):
    s_len = q.shape[3]
    scale = DA_HEAD_DIM ** -0.5
    outs = []
    for blk in range(s_len // Q_BLOCK):
        lo, hi = blk * Q_BLOCK, (blk + 1) * Q_BLOCK
        qb = q[:, :, :, lo:hi]
        kb = k[:, :, :, :hi]
        vb = v[:, :, :hi]
        sc = jnp.einsum('bhmqd,bhmkd->bhmqk', qb, kb).astype(jnp.float32) * scale
        dist = (jnp.arange(lo, hi)[:, None] - jnp.arange(hi)[None, :]).astype(jnp.float32)
        bias = -slopes[:, None, None, None] * dist
        sc = jnp.where(dist >= 0, sc + bias, -jnp.inf)
        p = jax.nn.softmax(sc, axis=-1)
        a = p[:, :, 0] - lam * p[:, :, 1]
        outs.append(jnp.einsum('bhqk,bhkd->bhqd', a.astype(v.dtype), vb))
    return jnp.concatenate(outs, axis=2)


def mlstm_chunkwise(q, k, v, i_pre, log_f):
    b_sz, n_h, s_len, dh = q.shape
    n_chunks = s_len // ML_CHUNK
    causal = jnp.tril(jnp.ones((ML_CHUNK, ML_CHUNK), dtype=bool))

    def to_chunks(t):
        t = t.reshape(b_sz, n_h, n_chunks, ML_CHUNK, *t.shape[3:])
        return jnp.moveaxis(t, 2, 0)

    def step(carry, xs):
        c_state, n_state, m_state = carry
        qc, kc, vc, ic, fc = xs
        b = jnp.cumsum(fc, axis=-1)
        d = jnp.where(causal, b[..., :, None] - b[..., None, :] + ic[..., None, :], -jnp.inf)
        inter = b + m_state[..., None]
        m_row = jnp.maximum(jnp.max(d, axis=-1), inter)
        sc = jnp.einsum('bhld,bhsd->bhls', qc, kc) * jnp.exp(d - m_row[..., None])
        w_inter = jnp.exp(inter - m_row)
        num = jnp.einsum('bhls,bhsd->bhld', sc, vc) + w_inter[..., None] * jnp.einsum('bhld,bhde->bhle', qc, c_state)
        den = jnp.sum(sc, axis=-1) + w_inter * jnp.einsum('bhld,bhd->bhl', qc, n_state)
        h = num / jnp.maximum(jnp.abs(den), jnp.exp(-m_row))[..., None]
        b_last = b[..., -1]
        w_log = b_last[..., None] - b + ic
        m_new = jnp.maximum(b_last + m_state, jnp.max(w_log, axis=-1))
        decay = jnp.exp(b_last + m_state - m_new)
        w_in = jnp.exp(w_log - m_new[..., None])
        c_new = decay[..., None, None] * c_state + jnp.einsum('bhs,bhsd,bhse->bhde', w_in, kc, vc)
        n_new = decay[..., None] * n_state + jnp.einsum('bhs,bhsd->bhd', w_in, kc)
        return (c_new, n_new, m_new), h

    init = (jnp.zeros((b_sz, n_h, dh, dh), jnp.float32),
            jnp.zeros((b_sz, n_h, dh), jnp.float32),
            jnp.zeros((b_sz, n_h), jnp.float32))
    xs = (to_chunks(q), to_chunks(k), to_chunks(v), to_chunks(i_pre), to_chunks(log_f))
    _, h = lax.scan(step, init, xs)
    return jnp.moveaxis(h, 0, 2).reshape(b_sz, n_h, s_len, dh)


def hierarchical_moe(xn, w_group, b_group, w_router, b_router, w1, w3, w2):
    n_tok, d = xn.shape
    g_prob = jax.nn.softmax(jnp.einsum('td,dg->tg', xn, w_group).astype(jnp.float32) + b_group.astype(jnp.float32), axis=-1)
    g_top, g_idx = lax.top_k(g_prob, 1)
    e_logits = (jnp.einsum('td,de->te', xn, w_router).astype(jnp.float32) + b_router.astype(jnp.float32))
    e_logits = e_logits.reshape(n_tok, N_GROUPS, EXPERTS_PER_GROUP)[jnp.arange(n_tok), g_idx[:, 0]]
    e_top, e_local = lax.top_k(jax.nn.softmax(e_logits, axis=-1), TOP_K_IN_GROUP)
    e_top = e_top / jnp.sum(e_top, axis=-1, keepdims=True)
    gate = g_top * e_top
    expert_id = g_idx * EXPERTS_PER_GROUP + e_local

    n_assign = n_tok * TOP_K_IN_GROUP
    flat_e = expert_id.reshape(n_assign)
    flat_tok = jnp.repeat(jnp.arange(n_tok, dtype=jnp.int32), TOP_K_IN_GROUP)
    flat_w = gate.reshape(n_assign)
    order = jnp.argsort(flat_e)
    sorted_e = flat_e[order]
    counts = jax.ops.segment_sum(jnp.ones(n_assign, jnp.int32), flat_e, num_segments=N_EXPERTS)
    padded = (counts + MOE_BLOCK - 1) // MOE_BLOCK * MOE_BLOCK
    start = jnp.cumsum(counts) - counts
    pend = jnp.cumsum(padded)
    pstart = pend - padded
    dest = pstart[sorted_e] + (jnp.arange(n_assign, dtype=jnp.int32) - start[sorted_e])
    cap = n_assign + N_EXPERTS * MOE_BLOCK
    n_blocks = cap // MOE_BLOCK
    buf_tok = jnp.zeros(cap, jnp.int32).at[dest].set(flat_tok[order])
    buf_w = jnp.zeros(cap, jnp.float32).at[dest].set(flat_w[order])
    blk_expert = jnp.minimum(jnp.searchsorted(pend, jnp.arange(n_blocks, dtype=jnp.int32) * MOE_BLOCK, side='right'),
                             N_EXPERTS - 1).astype(jnp.int32)
    x_blocks = xn[buf_tok].reshape(n_blocks, MOE_BLOCK, d)

    def run_block(args):
        xb, e = args
        hid = jax.nn.silu(xb @ w1[e]) * (xb @ w3[e])
        return hid @ w2[e]

    y_blocks = lax.map(run_block, (x_blocks, blk_expert))
    y = y_blocks.reshape(cap, d) * buf_w[:, None].astype(xn.dtype)
    return jnp.zeros_like(xn).at[buf_tok].add(y)


def setup_inputs(seed: int = 0) -> dict:
    key = jax.random.key(seed)
    ks = jax.random.split(key, 32)
    f32 = jnp.float32
    L = DEPTH
    D = D_MODEL

    def nrm(k, shape, scale):
        return jax.random.normal(k, shape, f32) * scale

    def gain(k, shape):
        return 1.0 + 0.02 * jax.random.normal(k, shape, f32)

    return {
        'x': nrm(ks[0], (BATCH, SEQ, D), 1.0),
        'attn_norm_g': gain(ks[1], (L, D)),
        'w_in': nrm(ks[2], (L, D, IN_WIDTH), D ** -0.5),
        'da_q_norm_g': gain(ks[3], (L, DA_HEAD_DIM)),
        'da_k_norm_g': gain(ks[4], (L, DA_HEAD_DIM)),
        'da_lambda_q1': nrm(ks[5], (L, DA_HEAD_DIM), 0.1),
        'da_lambda_k1': nrm(ks[6], (L, DA_HEAD_DIM), 0.1),
        'da_lambda_q2': nrm(ks[7], (L, DA_HEAD_DIM), 0.1),
        'da_lambda_k2': nrm(ks[8], (L, DA_HEAD_DIM), 0.1),
        'da_out_norm_g': gain(ks[9], (L, DA_V_DIM)),
        'ml_conv_w': nrm(ks[10], (L, CONV_WIDTH, 2 * ML_WIDTH), CONV_WIDTH ** -0.5),
        'ml_conv_b': nrm(ks[11], (L, 2 * ML_WIDTH), 0.02),
        'ml_i_bias': nrm(ks[12], (L, ML_HEADS), 0.1),
        'ml_f_bias': jnp.linspace(3.0, 6.0, ML_HEADS, dtype=f32)[None, :] + nrm(ks[13], (L, ML_HEADS), 0.1),
        'ml_out_norm_g': gain(ks[14], (L, ML_WIDTH)),
        'w_branch_da': nrm(ks[15], (L, DA_WIDTH, D), DA_WIDTH ** -0.5),
        'w_branch_ml': nrm(ks[16], (L, ML_WIDTH, D), ML_WIDTH ** -0.5),
        'w_gate': nrm(ks[17], (L, D, 2 * D), D ** -0.5),
        'b_gate': nrm(ks[18], (L, 2 * D), 0.02),
        'w_out': nrm(ks[19], (L, D, D), D ** -0.5),
        'ffn_norm_g': gain(ks[20], (L, D)),
        'w_group': nrm(ks[21], (L, D, N_GROUPS), D ** -0.5),
        'b_group': nrm(ks[22], (L, N_GROUPS), 0.01),
        'w_router': nrm(ks[23], (L, D, N_EXPERTS), D ** -0.5),
        'b_router': nrm(ks[24], (L, N_EXPERTS), 0.01),
        'w1': nrm(ks[25], (L, N_EXPERTS, D, EXPERT_FF), D ** -0.5),
        'w3': nrm(ks[26], (L, N_EXPERTS, D, EXPERT_FF), D ** -0.5),
        'w2': nrm(ks[27], (L, N_EXPERTS, EXPERT_FF, D), EXPERT_FF ** -0.5),
    }


def reference(x, attn_norm_g, w_in, da_q_norm_g, da_k_norm_g, da_lambda_q1, da_lambda_k1,
              da_lambda_q2, da_lambda_k2, da_out_norm_g, ml_conv_w, ml_conv_b, ml_i_bias,
              ml_f_bias, ml_out_norm_g, w_branch_da, w_branch_ml, w_gate, b_gate, w_out,
              ffn_norm_g, w_group, b_group, w_router, b_router, w1, w3, w2):
    f32 = jnp.float32
    b_sz, s_len, d = x.shape
    slopes = alibi_slopes(DA_HEADS)
    for layer in range(DEPTH):
        h = rms_norm(x, attn_norm_g[layer])
        proj = jnp.einsum('bsd,de->bse', h, w_in[layer])

        q_da = proj[..., OFF_DA_Q:OFF_DA_K].reshape(b_sz, s_len, DA_HEADS, 2, DA_HEAD_DIM).transpose(0, 2, 3, 1, 4)
        k_da = proj[..., OFF_DA_K:OFF_DA_V].reshape(b_sz, s_len, DA_HEADS, 2, DA_HEAD_DIM).transpose(0, 2, 3, 1, 4)
        v_da = proj[..., OFF_DA_V:OFF_ML_QK].reshape(b_sz, s_len, DA_HEADS, DA_V_DIM).transpose(0, 2, 1, 3)
        q_da = rms_norm(q_da, da_q_norm_g[layer])
        k_da = rms_norm(k_da, da_k_norm_g[layer])
        lam_init = 0.8 - 0.6 * math.exp(-0.3 * layer)
        lam = (jnp.exp(jnp.sum((da_lambda_q1[layer] * da_lambda_k1[layer]).astype(f32)))
               - jnp.exp(jnp.sum((da_lambda_q2[layer] * da_lambda_k2[layer]).astype(f32))) + lam_init)
        o_da = diff_attention(q_da, k_da, v_da, lam, slopes)
        o_da = rms_norm(o_da, da_out_norm_g[layer]) * (1.0 - lam_init)
        y_da = o_da.transpose(0, 2, 1, 3).reshape(b_sz, s_len, DA_WIDTH)

        qk = jax.nn.silu(causal_conv(proj[..., OFF_ML_QK:OFF_ML_V], ml_conv_w[layer], ml_conv_b[layer]))

        def to_heads(t):
            return t.reshape(b_sz, s_len, ML_HEADS, ML_HEAD_DIM).transpose(0, 2, 1, 3).astype(f32)

        q_ml = to_heads(qk[..., :ML_WIDTH]) * (ML_HEAD_DIM ** -0.5)
        k_ml = to_heads(qk[..., ML_WIDTH:])
        v_ml = to_heads(proj[..., OFF_ML_V:OFF_ML_O])
        i_pre = (proj[..., OFF_ML_I:OFF_ML_F] + ml_i_bias[layer]).astype(f32).transpose(0, 2, 1)
        log_f = jax.nn.log_sigmoid((proj[..., OFF_ML_F:IN_WIDTH] + ml_f_bias[layer]).astype(f32)).transpose(0, 2, 1)
        h_ml = mlstm_chunkwise(q_ml, k_ml, v_ml, i_pre, log_f)
        h_ml = rms_norm(h_ml, ml_out_norm_g[layer].reshape(ML_HEADS, 1, ML_HEAD_DIM))
        o_gate = jax.nn.sigmoid(proj[..., OFF_ML_O:OFF_ML_I].astype(f32))
        y_ml = (h_ml.transpose(0, 2, 1, 3).reshape(b_sz, s_len, ML_WIDTH) * o_gate).astype(x.dtype)

        gates = jax.nn.sigmoid(jnp.einsum('bsd,de->bse', h, w_gate[layer]) + b_gate[layer])
        mixed = (gates[..., :d] * jnp.einsum('bsc,cd->bsd', y_da, w_branch_da[layer])
                 + gates[..., d:] * jnp.einsum('bsc,cd->bsd', y_ml, w_branch_ml[layer]))
        x = x + jnp.einsum('bsd,de->bse', mixed, w_out[layer])

        hn = rms_norm(x, ffn_norm_g[layer]).reshape(b_sz * s_len, d)
        moe_out = hierarchical_moe(hn, w_group[layer], b_group[layer], w_router[layer], b_router[layer],
                                   w1[layer], w3[layer], w2[layer])
        x = x + moe_out.reshape(b_sz, s_len, d)
    return x
```

```cpp
#include <hip/hip_runtime.h>
#include <cstdio>
#include <cstdint>

#define LAS __attribute__((address_space(3)))
typedef unsigned short bf16_t;
typedef short bf16x8 __attribute__((ext_vector_type(8)));
typedef short s16x4 __attribute__((ext_vector_type(4)));
typedef float f32x2 __attribute__((ext_vector_type(2)));
typedef float f32x4 __attribute__((ext_vector_type(4)));
typedef float f32x16 __attribute__((ext_vector_type(16)));
typedef unsigned u32x2 __attribute__((ext_vector_type(2)));
typedef unsigned u32x4 __attribute__((ext_vector_type(4)));

constexpr int T = 32768, D = 1024, SEQ = 4096, NBATCH = 8;
constexpr int PW = 5632;
constexpr int IN_W = 3592;
constexpr int PC_Q = 0, PC_K = 512, PC_V = 1024, PC_MQ = 1536, PC_MK = 2048, PC_MV = 2560, PC_MO = 3072, PC_G = 3584;
constexpr int NEXP = 32, FF = 512;
constexpr float NORM_EPS = 1e-6f;
constexpr float LOG2E = 1.4426950408889634f;
constexpr int NTHREADS = 512, NWAVES = 8;

constexpr size_t WS_CTL = 0, CTL_BYTES = 65536;
constexpr size_t WS_WIN = WS_CTL + CTL_BYTES;
constexpr size_t WS_WDA = WS_WIN + (size_t)PW * 1024 * 2;
constexpr size_t WS_WML = WS_WDA + (size_t)1024 * 512 * 2;
constexpr size_t WS_WOUT = WS_WML + (size_t)1024 * 512 * 2;
constexpr size_t WS_IFP = WS_WOUT + (size_t)1024 * 1024 * 2;
constexpr size_t WS_HB = WS_IFP + (size_t)T * 8 * 4;
constexpr size_t WS_MLQK = WS_HB + (size_t)T * 1024 * 2;
constexpr size_t WS_P = WS_MLQK + (size_t)T * 1024 * 2;
constexpr size_t WS_END = WS_P + (size_t)T * PW * 2;
constexpr size_t WS_YDA = WS_HB;
constexpr size_t WS_YML = WS_HB + (size_t)T * 512 * 2;
constexpr size_t WS_MIX = WS_MLQK;
constexpr size_t WS_HN = WS_HB;
constexpr int MOE_ROWS = 65536 + 64 * 256;
constexpr size_t WS_W13 = WS_P;
constexpr size_t WS_W2 = WS_W13 + (size_t)NEXP * 1024 * 1024 * 2;
constexpr size_t WS_HID = WS_W2 + (size_t)NEXP * 1024 * 512 * 2;
constexpr size_t WS_RTOK = WS_HID + (size_t)MOE_ROWS * 512 * 2;
constexpr size_t WS_RGATE = WS_RTOK + (size_t)MOE_ROWS * 4;
constexpr size_t WS_TEID = WS_RGATE + (size_t)MOE_ROWS * 4;
constexpr size_t WS_TGATE = WS_TEID + (size_t)T * 2 * 4;
constexpr size_t WS_WGCNT = WS_TGATE + (size_t)T * 2 * 4;
constexpr size_t WS_MOE_END = WS_WGCNT + (size_t)256 * 64 * 4;
static_assert(WS_MOE_END <= WS_END, "MoE overlay must fit the P region");
constexpr int CW_BAR = 0;
constexpr int CW_MISC = 4096;

constexpr int LDS_BYTES = 160 * 1024;
constexpr int LDS_MISC_OFF = LDS_BYTES - 256;

__device__ __forceinline__ unsigned cvt_pk_bf16(float lo, float hi) { unsigned r; asm volatile("v_cvt_pk_bf16_f32 %0, %1, %2" : "=v"(r) : "v"(lo), "v"(hi)); return r; }
__device__ __forceinline__ float bf_lo(unsigned w) { return __uint_as_float(w << 16); }
__device__ __forceinline__ float bf_hi(unsigned w) { return __uint_as_float(w & 0xffff0000u); }
__device__ __forceinline__ float bf2f(bf16_t b) { return __uint_as_float(((unsigned)b) << 16); }
__device__ __forceinline__ float fast_sigmoid(float x) { return __builtin_amdgcn_rcpf(1.0f + __builtin_amdgcn_exp2f(-LOG2E * x)); }
__device__ __forceinline__ float wave_sum(float v) {
#pragma unroll
    for (int o = 1; o < 64; o <<= 1) v += __shfl_xor(v, o);
    return v;
}
__device__ __forceinline__ int tid_opaque() { int t = (int)threadIdx.x; asm volatile("" : "+v"(t)); return t; }
#define XB_TMO      128
#define XB_XCNT(j)  (256  + 64 * (j))
#define XB_XSUB(j)  (1280 + 64 * (j))
#define XB_XGEN(j)  (2304 + 64 * (j))
#define XB_TOP      3328
#define XB_TOPGEN   3392
#define XCD_BAR_WORDS 3456
#define XB_SPIN_CAP (1u << 18)

__device__ __forceinline__ unsigned xb_ld(unsigned* p)              { return __hip_atomic_load(p, __ATOMIC_RELAXED, __HIP_MEMORY_SCOPE_AGENT); }
__device__ __forceinline__ unsigned xb_add(unsigned* p, unsigned v) { return __hip_atomic_fetch_add(p, v, __ATOMIC_RELAXED, __HIP_MEMORY_SCOPE_AGENT); }
__device__ __forceinline__ unsigned xb_xcc_id() { return (unsigned)__builtin_amdgcn_s_getreg((3 << 11) | 20) & 0xFu; }
#define XB_SPIN(cond, bar) do { unsigned _sp = 0; while (cond) { __builtin_amdgcn_s_sleep(1); \
    if ((++_sp & 255u) == 0u) { if (xb_ld(&(bar)[XB_TMO])) break; if (_sp > XB_SPIN_CAP) { atomicAdd(&(bar)[XB_TMO], 1u); break; } } } } while (0)

struct XcdBarrier {
    unsigned* bar; unsigned x;
    volatile LAS unsigned* st;
};

__device__ __forceinline__ XcdBarrier xcd_barrier_post(unsigned* bar, volatile LAS unsigned* st) {
    XcdBarrier b; b.bar = bar; b.x = xb_xcc_id(); b.st = st;
    if (threadIdx.x == 0) (void)xb_add(&bar[XB_XCNT(b.x)], 1u);
    return b;
}
__device__ __forceinline__ void xcd_barrier_complete(unsigned* bar, unsigned x, unsigned& nloc, unsigned& nx) {
    const unsigned G = gridDim.x * gridDim.y * gridDim.z;
    unsigned sum, cnt, mine, sp = 0u;
    for (;;) {
        sum = 0u; cnt = 0u; mine = 0u;
#pragma unroll
        for (unsigned j = 0; j < 16; ++j) { const unsigned c = xb_ld(&bar[XB_XCNT(j)]); sum += c; cnt += (c > 0u) ? 1u : 0u; mine = (j == x) ? c : mine; }
        if (sum == G) break;
        __builtin_amdgcn_s_sleep(1);
        if ((++sp & 255u) == 0u) { if (xb_ld(&bar[XB_TMO])) break; if (sp > XB_SPIN_CAP) { atomicAdd(&bar[XB_TMO], 1u); break; } }
    }
    nloc = mine > 0u ? mine : 1u; nx = cnt > 0u ? cnt : 1u;
}

__device__ __forceinline__ void xcd_barrier(const XcdBarrier& b) {
    asm volatile("s_waitcnt vmcnt(0)" ::: "memory");
    __syncthreads();
    if (threadIdx.x == 0) {
        unsigned* bar = b.bar;
        __builtin_amdgcn_s_waitcnt(0);
        unsigned nloc = b.st[0], nx = b.st[1];
        if (nloc == 0u) { xcd_barrier_complete(bar, b.x, nloc, nx); b.st[0] = nloc; b.st[1] = nx; }
        const unsigned old = xb_add(&bar[XB_XSUB(b.x)], 1u);
        const unsigned gen = old / nloc;
        if (old + 1u == (gen + 1u) * nloc) {
            __builtin_amdgcn_fence(__ATOMIC_RELEASE, "agent");
            asm volatile("s_waitcnt vmcnt(0)" ::: "memory");
            const unsigned og = xb_add(&bar[XB_TOP], 1u);
            const unsigned tg = og / nx;
            if (og + 1u == (tg + 1u) * nx) xb_add(&bar[XB_TOPGEN], 1u);
            else XB_SPIN(xb_ld(&bar[XB_TOPGEN]) == tg, bar);
            __builtin_amdgcn_fence(__ATOMIC_ACQUIRE, "agent");
            xb_add(&bar[XB_XGEN(b.x)], 1u);
            asm volatile("s_waitcnt vmcnt(0)" ::: "memory");
        } else {
            XB_SPIN(xb_ld(&bar[XB_XGEN(b.x)]) == gen, bar);
            __builtin_amdgcn_fence(__ATOMIC_ACQUIRE, "agent");
            asm volatile("s_waitcnt vmcnt(0)" ::: "memory");
        }
    }
    __syncthreads();
}

namespace pg8 {
constexpr int BM = 256, BK = 64, HALF = 128, HTB = HALF * BK * 2  , STAGE_BYTES = 8 * HTB, NXCD = 8, WGM = 8;
__host__ __device__ __forceinline__ int lds_byte(int r, int c) { const int st = (r >> 4) * 2 + (c >> 5), rr = r & 15, cc = c & 31, ob = rr * 64 + cc * 2; return st * 1024 + (ob ^ (((ob >> 9) & 1) << 5)); }
__host__ __device__ __forceinline__ void stage_rc(int b, int& R, int& C) { const int st = b / 1024, sb = b % 1024, swz = sb ^ (((sb >> 9) & 1) << 5); R = (st >> 1) * 16 + swz / 64; C = (st & 1) * 32 + (swz % 64) / 2; }
__host__ __device__ __forceinline__ int perm32(int rho) { const int n = rho >> 4, i = rho & 15; return 8 * (i >> 2) + 4 * n + (i & 3); }

struct Unit { const char* A; const char* B; int pm, pn, aux; };

__device__ __forceinline__ bool static_tile(int nM, int nN, int G, int c, int i, int& pm, int& pn) {
    const int nwg = nM * nN; const long L = (long)i * G + c; if (L >= nwg) return false;
    int wgid = (int)L; { const int q = nwg / NXCD, r = nwg % NXCD, xcd = wgid % NXCD, off = wgid / NXCD; wgid = (xcd < r ? xcd * (q + 1) : r * (q + 1) + (xcd - r) * q) + off; }
    const int nig = WGM * nN, gid = wgid / nig, fm = gid * WGM, gsz = (nM - fm) < WGM ? (nM - fm) : WGM;
    pm = fm + ((wgid % nig) % gsz); pn = (wgid % nig) / gsz; return true;
}

template <class Epi, class Sched, bool GATHER>
__device__ __forceinline__ void gemm_run(LAS unsigned char* lds, const int K, const Sched& S, const Epi& E) {
    const int tid = tid_opaque(), wid = __builtin_amdgcn_readfirstlane(tid >> 6), lane = tid & 63, wr = wid >> 2, wc = wid & 3, fr = lane & 15, fq = lane >> 4;
    const int nt = K / BK;
    int Rr[2]; unsigned colb[2], voffB[2];
#pragma unroll
    for (int i = 0; i < 2; ++i) { int R, C; stage_rc(tid * 16 + i * 8192, R, C); const int Rb = Epi::PERM ? ((R & ~31) + perm32(R & 31)) : R;
        Rr[i] = R; colb[i] = (unsigned)C * 2u; voffB[i] = (unsigned)(Rb * K + C) * 2u; }
    const size_t kstep = (size_t)(BK * 2);
    const size_t hstep = (size_t)HALF * K * 2;
    const unsigned ldsw = (unsigned)wid * 1024u;
    const int aoff = lds_byte(wr * 64 + fr, fq * 8), boff = lds_byte(wc * 32 + fr, fq * 8);
#define PG8_SA(b, h) (((b) * 2 + (h)) * HTB)
#define PG8_SB(b, h) ((4 + (b) * 2 + (h)) * HTB)
#define PG8_STAGE(bufoff, gbase, voff) do { _Pragma("unroll") for (int _i = 0; _i < 2; ++_i) \
        __builtin_amdgcn_global_load_lds((const unsigned*)((const char*)(gbase) + (voff)[_i]), (LAS unsigned*)(lds + (bufoff) + ldsw + _i * 8192), 16, 0, 0); } while (0)
#define PG8_LDA(dst, b, h) do { _Pragma("unroll") for (int m = 0; m < 4; ++m) _Pragma("unroll") for (int k = 0; k < 2; ++k) dst[m][k] = *(const LAS bf16x8*)(lds + PG8_SA(b, h) + aoff + m * 2048 + k * 1024); } while (0)
#define PG8_LDB(dst, b, h) do { _Pragma("unroll") for (int n = 0; n < 2; ++n) _Pragma("unroll") for (int k = 0; k < 2; ++k) dst[n][k] = *(const LAS bf16x8*)(lds + PG8_SB(b, h) + boff + n * 2048 + k * 1024); } while (0)
#define PG8_MMA(ai, bj, At, Bt) do { __builtin_amdgcn_s_setprio(1); _Pragma("unroll") for (int m = 0; m < 4; ++m) _Pragma("unroll") for (int n = 0; n < 2; ++n) _Pragma("unroll") for (int k = 0; k < 2; ++k) \
        acc[ai][bj][m][n] = __builtin_amdgcn_mfma_f32_16x16x32_bf16(Bt[n][k], At[m][k], acc[ai][bj][m][n], 0, 0, 0); __builtin_amdgcn_s_setprio(0); } while (0)
#define PG8_WAIT_V(n) asm volatile("s_waitcnt vmcnt(" #n ")" ::: "memory")
#define PG8_WAIT_L(n) asm volatile("s_waitcnt lgkmcnt(" #n ")" ::: "memory")
#define PG8_BAR __builtin_amdgcn_s_barrier()
#define PG8_SCHED __builtin_amdgcn_sched_barrier(0)
#define PG8_AOFF(o, u) do { _Pragma("unroll") for (int _h = 0; _h < 2; ++_h) _Pragma("unroll") for (int _i = 0; _i < 2; ++_i) { \
        const int _r = Rr[_i] + HALF * _h; const unsigned _row = GATHER ? (unsigned)S.arow(u, _r) : (unsigned)_r; o[_h][_i] = _row * (unsigned)(K * 2) + colb[_i]; } } while (0)
    Unit cur, nxt; int ui = 0;
    if (!S.next(0, cur)) return;
    f32x4 acc[2][2][4][2];
#pragma unroll
    for (int a = 0; a < 2; ++a)
#pragma unroll
        for (int b = 0; b < 2; ++b)
#pragma unroll
            for (int m = 0; m < 4; ++m)
#pragma unroll
                for (int n = 0; n < 2; ++n) acc[a][b][m][n] = (f32x4){0.f, 0.f, 0.f, 0.f};
    bf16x8 At[4][2], B0[2][2], B1[2][2];
    unsigned oA[2][2], nOA[2][2];
    const char* cA = cur.A; const char* cB = cur.B;
    PG8_AOFF(oA, cur);
#pragma unroll
    for (int h = 0; h < 2; ++h)
#pragma unroll
        for (int i = 0; i < 2; ++i) nOA[h][i] = oA[h][i];
    PG8_STAGE(PG8_SB(0, 0), cB, voffB); PG8_STAGE(PG8_SB(0, 1), cB + hstep, voffB); PG8_STAGE(PG8_SA(0, 0), cA, oA[0]); PG8_STAGE(PG8_SA(0, 1), cA, oA[1]);
    if (wr == 1) PG8_BAR;
    PG8_WAIT_V(2); PG8_BAR;
    PG8_STAGE(PG8_SB(1, 0), cB + kstep, voffB); PG8_STAGE(PG8_SA(1, 0), cA + kstep, oA[0]); PG8_STAGE(PG8_SB(1, 1), cB + hstep + kstep, voffB);
    PG8_WAIT_V(6); PG8_BAR;
    for (;;) {
        const bool has_next = S.next(ui + 1, nxt);
        const char* nA = has_next ? nxt.A : cA; const char* nB = has_next ? nxt.B : cB;
        if (GATHER) { if (has_next) { PG8_AOFF(nOA, nxt); } }
        for (int t = 0; t < nt; t += 2) {
            const bool last = (t == nt - 2);
            const char* a1 = cA + (size_t)(t + 1) * kstep;
            const char* a2 = last ? nA : cA + (size_t)(t + 2) * kstep; const char* b2 = last ? nB : cB + (size_t)(t + 2) * kstep;
            const char* a3 = a2 + kstep; const char* b3 = b2 + kstep;
            unsigned o2[2][2];
#pragma unroll
            for (int h = 0; h < 2; ++h)
#pragma unroll
                for (int i = 0; i < 2; ++i) o2[h][i] = (GATHER && last) ? nOA[h][i] : oA[h][i];
            PG8_LDB(B0, 0, 0); PG8_LDB(B1, 0, 1); PG8_SCHED; PG8_LDA(At, 0, 0); PG8_STAGE(PG8_SA(1, 1), a1, oA[1]);
            PG8_WAIT_V(8); PG8_WAIT_L(0); PG8_BAR; PG8_MMA(0, 0, At, B0); PG8_MMA(0, 1, At, B1); PG8_BAR; PG8_SCHED;
            PG8_LDA(At, 0, 1); PG8_STAGE(PG8_SB(0, 0), b2, voffB); PG8_STAGE(PG8_SB(0, 1), b2 + hstep, voffB); PG8_STAGE(PG8_SA(0, 0), a2, o2[0]);
            PG8_WAIT_V(8); PG8_WAIT_L(0); PG8_BAR; PG8_MMA(1, 0, At, B0); PG8_MMA(1, 1, At, B1); PG8_BAR; PG8_SCHED;
            PG8_LDB(B0, 1, 0); PG8_LDB(B1, 1, 1); PG8_SCHED; PG8_LDA(At, 1, 0); PG8_STAGE(PG8_SA(0, 1), a2, o2[1]);
            PG8_WAIT_V(8); PG8_WAIT_L(0); PG8_BAR; PG8_MMA(0, 0, At, B0); PG8_MMA(0, 1, At, B1); PG8_BAR; PG8_SCHED;
            PG8_LDA(At, 1, 1); PG8_STAGE(PG8_SB(1, 0), b3, voffB); PG8_STAGE(PG8_SB(1, 1), b3 + hstep, voffB); PG8_STAGE(PG8_SA(1, 0), a3, o2[0]);
            PG8_WAIT_V(8); PG8_WAIT_L(0); PG8_BAR; PG8_MMA(1, 0, At, B0); PG8_MMA(1, 1, At, B1); PG8_BAR; PG8_SCHED;
        }
        if (wr == 0) PG8_BAR;
        const bool keep = E(acc, cur, wr, wc, fr, fq);
        if (!has_next) break;
        if (!keep) {
#pragma unroll
            for (int a = 0; a < 2; ++a)
#pragma unroll
                for (int b = 0; b < 2; ++b)
#pragma unroll
                    for (int m = 0; m < 4; ++m)
#pragma unroll
                        for (int n = 0; n < 2; ++n) acc[a][b][m][n] = (f32x4){0.f, 0.f, 0.f, 0.f};
        }
        cur = nxt; cA = nA; cB = nB; ++ui;
        if (GATHER) {
#pragma unroll
            for (int h = 0; h < 2; ++h)
#pragma unroll
                for (int i = 0; i < 2; ++i) oA[h][i] = nOA[h][i];
        }
        if (wr == 1) PG8_BAR;
    }
    PG8_WAIT_V(0);
    PG8_BAR;
#undef PG8_SA
#undef PG8_SB
#undef PG8_STAGE
#undef PG8_LDA
#undef PG8_LDB
#undef PG8_MMA
#undef PG8_WAIT_V
#undef PG8_WAIT_L
#undef PG8_BAR
#undef PG8_SCHED
#undef PG8_AOFF
}
}
template <class RowMap>
__device__ __forceinline__ void transpose_item(const float* W, int K, int ld, bf16_t* WT, RowMap rowmap, LAS float* scr, int kb, int nb, int lane) {
    const int k0 = 64 * kb, n0 = 32 * nb;
#pragma unroll 8
    for (int i = 0; i < 32; ++i) { const int kk = 2 * i + (lane >> 5); scr[kk * 33 + (lane & 31)] = W[(size_t)(k0 + kk) * ld + n0 + (lane & 31)]; }
    asm volatile("s_waitcnt lgkmcnt(0)" ::: "memory");
    const int c = lane & 7;
#pragma unroll
    for (int j = 0; j < 4; ++j) { const int n = (lane >> 3) + 8 * j; const LAS float* s = scr + (8 * c) * 33 + n;
        u32x4 o; o.x = cvt_pk_bf16(s[0 * 33], s[1 * 33]); o.y = cvt_pk_bf16(s[2 * 33], s[3 * 33]); o.z = cvt_pk_bf16(s[4 * 33], s[5 * 33]); o.w = cvt_pk_bf16(s[6 * 33], s[7 * 33]);
        *(u32x4*)(WT + (size_t)rowmap(n0 + n) * K + k0 + 8 * c) = o; }
    asm volatile("s_waitcnt lgkmcnt(0)" ::: "memory");
}
struct RowId { int off; __device__ __forceinline__ int operator()(int n) const { return off + n; } };
struct RowUp { int which; __device__ __forceinline__ int operator()(int n) const { return 256 * (n >> 7) + 128 * which + (n & 127); } };

__device__ __forceinline__ void p0_prologue(LAS unsigned char* lds, const float* const* in, unsigned char* ws, int G) {
    const int tid = tid_opaque(), lane = tid & 63, wave = __builtin_amdgcn_readfirstlane(tid >> 6);
    const int gw = blockIdx.x * NWAVES + wave, NGW = G * NWAVES;
    LAS float* scr = (LAS float*)(lds + wave * 16384);
    const float* w_in = in[2]; const float* w_da = in[15]; const float* w_ml = in[16]; const float* w_gate = in[17]; const float* w_out = in[19];
    bf16_t* WinT = (bf16_t*)(ws + WS_WIN); bf16_t* WdaT = (bf16_t*)(ws + WS_WDA); bf16_t* WmlT = (bf16_t*)(ws + WS_WML); bf16_t* WoutT = (bf16_t*)(ws + WS_WOUT);
    constexpr int I_IN = 16 * (3584 / 32), I_G = 16 * (2048 / 32), I_DA = 8 * (1024 / 32), I_ML = I_DA, I_OUT = 16 * (1024 / 32);
    constexpr int NITEMS = I_IN + I_G + I_DA + I_ML + I_OUT;
    for (int it = gw; it < NITEMS; it += NGW) {
        int r = it;
        if (r < I_IN) { transpose_item(w_in, 1024, IN_W, WinT, RowId{0}, scr, r / 112, r % 112, lane); continue; } r -= I_IN;
        if (r < I_G) { transpose_item(w_gate, 1024, 2048, WinT, RowId{3584}, scr, r / 64, r % 64, lane); continue; } r -= I_G;
        if (r < I_DA) { transpose_item(w_da, 512, 1024, WdaT, RowId{0}, scr, r / 32, r % 32, lane); continue; } r -= I_DA;
        if (r < I_ML) { transpose_item(w_ml, 512, 1024, WmlT, RowId{0}, scr, r / 32, r % 32, lane); continue; } r -= I_ML;
        transpose_item(w_out, 1024, 1024, WoutT, RowId{0}, scr, r / 32, r % 32, lane);
    }
    __syncthreads();
    LAS float* wif = (LAS float*)lds;
    for (int i = tid; i < 8192; i += NTHREADS) { const int d = i >> 3, j = i & 7; wif[j * 1024 + d] = w_in[(size_t)d * IN_W + 3584 + j]; }
    __syncthreads();
    const float* x = in[0]; const float* g = in[1]; const float* ib = in[12]; const float* fb = in[13];
    bf16_t* HB = (bf16_t*)(ws + WS_HB); float* IFP = (float*)(ws + WS_IFP);
    f32x4 gv[4];
#pragma unroll
    for (int j = 0; j < 4; ++j) gv[j] = *(const f32x4*)(g + lane * 4 + 256 * j);
    for (int row = gw; row < T; row += NGW) {
        const f32x4* xr = (const f32x4*)(x + (size_t)row * D) + lane;
        f32x4 v[4]; float s = 0.f;
#pragma unroll
        for (int j = 0; j < 4; ++j) { v[j] = xr[64 * j]; s += (v[j].x * v[j].x + v[j].y * v[j].y) + (v[j].z * v[j].z + v[j].w * v[j].w); }
        const float rstd = 1.0f / sqrtf(wave_sum(s) * (1.f / D) + NORM_EPS);
        unsigned long long* o8 = (unsigned long long*)(HB + (size_t)row * D) + lane;
#pragma unroll
        for (int j = 0; j < 4; ++j) { v[j] = v[j] * rstd * gv[j];
            o8[64 * j] = (unsigned long long)cvt_pk_bf16(v[j].x, v[j].y) | ((unsigned long long)cvt_pk_bf16(v[j].z, v[j].w) << 32); }
        float dsum[8];
#pragma unroll
        for (int c = 0; c < 8; ++c) { float a = 0.f;
#pragma unroll
            for (int j = 0; j < 4; ++j) { const f32x4 w = *(const LAS f32x4*)(wif + c * 1024 + lane * 4 + 256 * j); a += (v[j].x * w.x + v[j].y * w.y) + (v[j].z * w.z + v[j].w * w.w); }
            dsum[c] = wave_sum(a); }
        if (lane < 8) {
            float val = 0.f;
#pragma unroll
            for (int c = 0; c < 8; ++c) val = (lane == c) ? dsum[c] : val;
            if (lane < 4) val += ib[lane];
            else { const float z = val + fb[lane - 4]; val = fminf(z, 0.f) - log1pf(__expf(-fabsf(z))); }
            IFP[(size_t)row * 8 + lane] = val;
        }
    }
}

__device__ __forceinline__ void moe_weight_convert(LAS unsigned char* lds, const float* const* in, unsigned char* ws, int G) {
    const int tid = tid_opaque(), lane = tid & 63, wave = __builtin_amdgcn_readfirstlane(tid >> 6);
    const int gw = blockIdx.x * NWAVES + wave, NGW = G * NWAVES;
    LAS float* scr = (LAS float*)(lds + wave * 16384);
    const float* w1 = in[25]; const float* w3 = in[26]; const float* w2 = in[27];
    bf16_t* W13 = (bf16_t*)(ws + WS_W13); bf16_t* W2T = (bf16_t*)(ws + WS_W2);
    constexpr int I_UP = 16 * 16;
    constexpr int I_DN = 8 * 32;
    constexpr int NIT = NEXP * (2 * I_UP + I_DN);
    for (int it = gw; it < NIT; it += NGW) {
        const int e = it / (2 * I_UP + I_DN); int r = it % (2 * I_UP + I_DN);
        if (r < I_UP) { transpose_item(w1 + (size_t)e * 1024 * 512, 1024, 512, W13 + (size_t)e * 1024 * 1024, RowUp{0}, scr, r / 16, r % 16, lane); continue; } r -= I_UP;
        if (r < I_UP) { transpose_item(w3 + (size_t)e * 1024 * 512, 1024, 512, W13 + (size_t)e * 1024 * 1024, RowUp{1}, scr, r / 16, r % 16, lane); continue; } r -= I_UP;
        transpose_item(w2 + (size_t)e * 512 * 1024, 512, 1024, W2T + (size_t)e * 1024 * 512, RowId{0}, scr, r / 32, r % 32, lane);
    }
}

__device__ __forceinline__ void da_qk_norm(unsigned char* ws, const float* gq, const float* gk, int G) {
    const int tid = tid_opaque(), lane = tid & 63, wave = __builtin_amdgcn_readfirstlane(tid >> 6);
    const int gw = blockIdx.x * NWAVES + wave, NGW = G * NWAVES;
    bf16_t* P = (bf16_t*)(ws + WS_P);
    const bool isq = lane < 32; const float* gsrc = (isq ? gq : gk) + (lane & 3) * 16; const float extra = isq ? (0.125f * LOG2E) : 1.0f;
    float gn[16];
#pragma unroll
    for (int i = 0; i < 16; ++i) gn[i] = gsrc[i] * extra;
    for (int row = gw; row < T; row += NGW) {
        u32x4* p = (u32x4*)(P + (size_t)row * PW + lane * 16);
        const u32x4 a = p[0], b = p[1];
        float v[16];
        v[0] = bf_lo(a.x); v[1] = bf_hi(a.x); v[2] = bf_lo(a.y); v[3] = bf_hi(a.y); v[4] = bf_lo(a.z); v[5] = bf_hi(a.z); v[6] = bf_lo(a.w); v[7] = bf_hi(a.w);
        v[8] = bf_lo(b.x); v[9] = bf_hi(b.x); v[10] = bf_lo(b.y); v[11] = bf_hi(b.y); v[12] = bf_lo(b.z); v[13] = bf_hi(b.z); v[14] = bf_lo(b.w); v[15] = bf_hi(b.w);
        float s = 0.f;
#pragma unroll
        for (int i = 0; i < 16; ++i) s += v[i] * v[i];
        s += __shfl_xor(s, 1); s += __shfl_xor(s, 2);
        const float rstd = 1.0f / sqrtf(s * (1.f / 64.f) + NORM_EPS);
#pragma unroll
        for (int i = 0; i < 16; ++i) v[i] = v[i] * rstd * gn[i];
        u32x4 oa, ob;
        oa.x = cvt_pk_bf16(v[0], v[1]); oa.y = cvt_pk_bf16(v[2], v[3]); oa.z = cvt_pk_bf16(v[4], v[5]); oa.w = cvt_pk_bf16(v[6], v[7]);
        ob.x = cvt_pk_bf16(v[8], v[9]); ob.y = cvt_pk_bf16(v[10], v[11]); ob.z = cvt_pk_bf16(v[12], v[13]); ob.w = cvt_pk_bf16(v[14], v[15]);
        p[0] = oa; p[1] = ob;
    }
}
typedef short v4i16_t __attribute__((ext_vector_type(4)));
constexpr int AT_KSTR = 1040;
constexpr int AT_KBUF = 16 * AT_KSTR;
constexpr int AT_QSTR = 528, AT_QBUF = 16 * AT_QSTR;
constexpr int AT_KOFF = 0, AT_VOFF = 2 * AT_KBUF, AT_QOFF = AT_VOFF + 2 * 16384;
static_assert(AT_QOFF + 8 * AT_QBUF <= LDS_MISC_OFF, "attention LDS");
__device__ __forceinline__ int crow(int r, int hi) { return (r & 3) + 8 * (r >> 2) + 4 * hi; }
__device__ __forceinline__ int v_off(int row, int ch) { return 2048 * (row >> 3) + 512 * (ch >> 2) + 64 * (row & 7) + 16 * ((ch & 3) ^ ((row >> 2) & 3)); }

__device__ __forceinline__ void attn_unit(LAS unsigned char* lds, const bf16_t* P, bf16_t* YDA, int b, int h, int qb, float lam, float mref, float slope2, const float* gout) {
    const int tid = tid_opaque(), lane = tid & 63, r32 = lane & 31, hh = lane >> 5, wid = __builtin_amdgcn_readfirstlane(tid >> 6);
    const int rowbase = b * SEQ;
    const int q0 = qb * 256 + wid * 32;
    const int qpos = q0 + r32;
    LAS unsigned char* Qw = lds + AT_QOFF + wid * AT_QBUF;
    const __amdgpu_buffer_rsrc_t prs = __builtin_amdgcn_make_buffer_rsrc((void*)P, 0, (int)0x7fffffff, 0x00020000);
    const int pbase = (rowbase * PW + h * 128) * 2;
    { const int qo = ((lane >> 4) * PW + PC_Q + (lane & 15) * 8) * 2;
#pragma unroll
      for (int i = 0; i < 8; ++i) { const int r = (lane >> 4) + 4 * i; const u32x4 v = __builtin_amdgcn_raw_buffer_load_b128(prs, qo, pbase + (q0 + 4 * i) * PW * 2, 0);
          *(LAS u32x4*)(Qw + (lane & 15) * AT_QSTR + r * 16) = v; } }
    const LAS unsigned char* qrd = Qw + hh * AT_QSTR + r32 * 16;
    f32x16 o1[4], o2[4];
#pragma unroll
    for (int t = 0; t < 4; ++t) { o1[t] = f32x16{}; o2[t] = f32x16{}; }
    float l1 = 0.f, l2 = 0.f;
    const int ntiles = 4 * qb + 4;
    const int sch = tid & 15;
    unsigned kdst[2], vdst[2]; int goff[2];
#pragma unroll
    for (int i = 0; i < 2; ++i) { const int r = (tid >> 4) + 32 * i; goff[i] = (r * PW + PC_K + sch * 8) * 2;
        kdst[i] = (unsigned)(sch * AT_KSTR + r * 16);
        vdst[i] = (unsigned)v_off(r, sch); }
    u32x4 kreg[2], vreg[2];
#define AT_LOADT(kt) do { const int _so = pbase + (kt) * 64 * PW * 2; _Pragma("unroll") for (int _i = 0; _i < 2; ++_i) { \
        kreg[_i] = __builtin_amdgcn_raw_buffer_load_b128(prs, goff[_i], _so, 0); vreg[_i] = __builtin_amdgcn_raw_buffer_load_b128(prs, goff[_i] + (PC_V - PC_K) * 2, _so, 0); } } while (0)
#define AT_WRITET(buf) do { _Pragma("unroll") for (int _i = 0; _i < 2; ++_i) { \
        *(LAS u32x4*)(lds + AT_KOFF + (buf) * AT_KBUF + kdst[_i]) = kreg[_i]; *(LAS u32x4*)(lds + AT_VOFF + (buf) * 16384 + vdst[_i]) = vreg[_i]; } } while (0)
    AT_LOADT(ntiles - 1); AT_WRITET(0); __syncthreads();
    const int tg = lane >> 4, tq = (lane >> 2) & 3, tp = lane & 3;
    const int vlo = 64 * (4 * hh + tq) + 16 * ((2 * (tg & 1) + (tp >> 1)) ^ hh) + 8 * (tp & 1);
    const int vhi = 64 * (4 * hh + tq) + 16 * ((2 * (tg & 1) + (tp >> 1)) ^ (hh + 2)) + 8 * (tp & 1);
    const int klane = hh * AT_KSTR + r32 * 16;
    for (int it = 0; it < ntiles; ++it) {
        const int kt = ntiles - 1 - it, cur = it & 1;
        if (it + 1 < ntiles) AT_LOADT(kt - 1);
        const int kb0 = kt * 64;
        const LAS unsigned char* Kb = lds + AT_KOFF + cur * AT_KBUF + klane;
        const LAS unsigned char* Vlo = lds + AT_VOFF + cur * 16384 + vlo;
        const LAS unsigned char* Vhi = lds + AT_VOFF + cur * 16384 + vhi;
#pragma unroll
        for (int sb = 0; sb < 2; ++sb) {
            const int kb = kb0 + 32 * sb;
            if (kb <= q0 + 31) {
                const float base = slope2 * (float)(kb + 4 * hh - qpos) - mref;
                bf16x8 pf1[2], pf2[2];
#pragma unroll
                for (int mp = 0; mp < 2; ++mp) {
                    f32x16 sc;
#pragma unroll
                    for (int r = 0; r < 16; ++r) sc[r] = __builtin_fmaf(slope2, (float)((r & 3) + 8 * (r >> 2)), base);
#pragma unroll
                    for (int dd = 0; dd < 4; ++dd) {
                        const bf16x8 ka = *(const LAS bf16x8*)(Kb + (mp * 8 + dd * 2) * AT_KSTR + sb * 512);
                        const bf16x8 qa = *(const LAS bf16x8*)(qrd + (mp * 8 + dd * 2) * AT_QSTR);
                        sc = __builtin_amdgcn_mfma_f32_32x32x16_bf16(ka, qa, sc, 0, 0, 0);
                    }
                    if (kb + 31 > q0) {
#pragma unroll
                        for (int r = 0; r < 16; ++r) { const bool dead = (kb + crow(r, hh)) > qpos; sc[r] = dead ? -INFINITY : sc[r]; }
                    }
                    float ls = 0.f;
#pragma unroll
                    for (int r = 0; r < 16; ++r) { sc[r] = __builtin_amdgcn_exp2f(sc[r]); ls += sc[r]; }
#pragma unroll
                    for (int s = 0; s < 2; ++s) {
                        u32x4 w;
                        w.x = cvt_pk_bf16(sc[8 * s + 0], sc[8 * s + 1]); w.y = cvt_pk_bf16(sc[8 * s + 2], sc[8 * s + 3]); w.z = cvt_pk_bf16(sc[8 * s + 4], sc[8 * s + 5]); w.w = cvt_pk_bf16(sc[8 * s + 6], sc[8 * s + 7]);
                        if (mp == 0) pf1[s] = __builtin_bit_cast(bf16x8, w); else pf2[s] = __builtin_bit_cast(bf16x8, w);
                    }
                    if (mp == 0) l1 += ls; else l2 += ls;
                }
#pragma unroll
                for (int s = 0; s < 2; ++s) {
#pragma unroll
                    for (int t = 0; t < 4; ++t) {
                        const s16x4 lo = __builtin_bit_cast(s16x4, __builtin_amdgcn_ds_read_tr16_b64_v4i16((LAS v4i16_t*)(Vlo + 2048 * (4 * sb + 2 * s) + 512 * t)));
                        const s16x4 hi = __builtin_bit_cast(s16x4, __builtin_amdgcn_ds_read_tr16_b64_v4i16((LAS v4i16_t*)(Vhi + 2048 * (4 * sb + 2 * s + 1) + 512 * t)));
                        const bf16x8 vf = (bf16x8){lo[0], lo[1], lo[2], lo[3], hi[0], hi[1], hi[2], hi[3]};
                        o1[t] = __builtin_amdgcn_mfma_f32_32x32x16_bf16(vf, pf1[s], o1[t], 0, 0, 0);
                        o2[t] = __builtin_amdgcn_mfma_f32_32x32x16_bf16(vf, pf2[s], o2[t], 0, 0, 0);
                    }
                }
            }
        }
        if (it + 1 < ntiles) AT_WRITET(cur ^ 1);
        __syncthreads();
    }
#undef AT_LOADT
#undef AT_WRITET
    l1 += __shfl_xor(l1, 32); l2 += __shfl_xor(l2, 32);
    const float inv1 = 1.0f / l1, c2 = lam / l2;
    float ss = 0.f;
#pragma unroll
    for (int t = 0; t < 4; ++t)
#pragma unroll
        for (int r = 0; r < 16; ++r) { const float v = o1[t][r] * inv1 - o2[t][r] * c2; o1[t][r] = v; ss += v * v; }
    ss += __shfl_xor(ss, 32);
    const float rstd = 0.8f / sqrtf(ss * (1.f / 128.f) + NORM_EPS);
    bf16_t* yrow = YDA + (size_t)(rowbase + qpos) * 512 + h * 128 + 4 * hh;
#pragma unroll
    for (int t = 0; t < 4; ++t)
#pragma unroll
        for (int g4 = 0; g4 < 4; ++g4) {
            const f32x4 gv = *(const f32x4*)(gout + 32 * t + 8 * g4 + 4 * hh);
            u32x2 w; w.x = cvt_pk_bf16(o1[t][4 * g4 + 0] * rstd * gv.x, o1[t][4 * g4 + 1] * rstd * gv.y); w.y = cvt_pk_bf16(o1[t][4 * g4 + 2] * rstd * gv.z, o1[t][4 * g4 + 3] * rstd * gv.w);
            *(u32x2*)(yrow + 32 * t + 8 * g4) = w;
        }
}

__device__ __forceinline__ void attn_phase(LAS unsigned char* lds, const float* const* in, unsigned char* ws, int G) {
    const bf16_t* P = (const bf16_t*)(ws + WS_P); bf16_t* YDA = (bf16_t*)(ws + WS_YDA);
    const float* gq = in[3]; const float* gk = in[4]; const float* lq1 = in[5]; const float* lk1 = in[6]; const float* lq2 = in[7]; const float* lk2 = in[8]; const float* gout = in[9];
    float mq = 0.f, mk = 0.f, a1 = 0.f, a2 = 0.f;
    for (int i = 0; i < 64; ++i) { mq = fmaxf(mq, fabsf(gq[i])); mk = fmaxf(mk, fabsf(gk[i])); a1 += lq1[i] * lk1[i]; a2 += lq2[i] * lk2[i]; }
    const float lam = __expf(a1) - __expf(a2) + 0.2f;
    const float mref = 8.0f * mq * mk * LOG2E * 1.02f + 0.25f;
    { const int w = blockIdx.x;
        const int bh = (w & 7) * 4 + ((w >> 3) & 3), j = w >> 5;
        const int b = bh >> 2, h = bh & 3;
        const float slope2 = exp2f(-2.0f * (float)(h + 1)) * LOG2E;
#pragma unroll 1
        for (int u2 = 0; u2 < 2; ++u2) attn_unit(lds, P, YDA, b, h, u2 ? j : 15 - j, lam, mref, slope2, gout);
    }
}
constexpr int ML_L = 256, ML_NC = SEQ / ML_L, ML_UNITS = NBATCH * 4 * ML_NC;
constexpr size_t MO_U = 0;
constexpr size_t MO_NL = MO_U + (size_t)ML_UNITS * 16384 * 4;
constexpr size_t MO_GU = MO_NL + (size_t)ML_UNITS * 128 * 4;
constexpr size_t MO_C = MO_GU + (size_t)ML_UNITS * 2 * 4;
constexpr size_t MO_N = MO_C + (size_t)ML_UNITS * 16384 * 2;
constexpr size_t MO_M = MO_N + (size_t)ML_UNITS * 128 * 4;
constexpr size_t MO_END = MO_M + (size_t)ML_UNITS * 4;
static_assert(MO_END <= (size_t)T * D * 4, "mLSTM scratch must fit the output buffer");

__device__ __forceinline__ void ml_conv_phase(unsigned char* ws, const float* cw, const float* cb, int G) {
    const int tid = tid_opaque();
    const bf16_t* P = (const bf16_t*)(ws + WS_P); bf16_t* MLQK = (bf16_t*)(ws + WS_MLQK);
    for (int i = blockIdx.x * NTHREADS + tid; i < T * 128; i += G * NTHREADS) {
        const int t = i >> 7, c8 = i & 127, pos = t & (SEQ - 1);
        float acc[8];
#pragma unroll
        for (int e = 0; e < 8; ++e) acc[e] = cb[c8 * 8 + e];
#pragma unroll
        for (int j = 0; j < 4; ++j) {
            if (pos - 3 + j >= 0) {
                const u32x4 u = *(const u32x4*)(P + (size_t)(t - 3 + j) * PW + PC_MQ + c8 * 8);
                const f32x4 w0 = *(const f32x4*)(cw + j * 1024 + c8 * 8), w1 = *(const f32x4*)(cw + j * 1024 + c8 * 8 + 4);
                acc[0] += bf_lo(u.x) * w0.x; acc[1] += bf_hi(u.x) * w0.y; acc[2] += bf_lo(u.y) * w0.z; acc[3] += bf_hi(u.y) * w0.w;
                acc[4] += bf_lo(u.z) * w1.x; acc[5] += bf_hi(u.z) * w1.y; acc[6] += bf_lo(u.w) * w1.z; acc[7] += bf_hi(u.w) * w1.w;
            }
        }
        const float sc = (c8 < 64) ? 0.08838834764831845f : 1.0f;
#pragma unroll
        for (int e = 0; e < 8; ++e) acc[e] = acc[e] * fast_sigmoid(acc[e]) * sc;
        u32x4 o; o.x = cvt_pk_bf16(acc[0], acc[1]); o.y = cvt_pk_bf16(acc[2], acc[3]); o.z = cvt_pk_bf16(acc[4], acc[5]); o.w = cvt_pk_bf16(acc[6], acc[7]);
        *(u32x4*)(MLQK + (size_t)t * 1024 + c8 * 8) = o;
    }
}

__device__ __forceinline__ void ml_gate_scan(const float* IFP, int t0, int h, int lane, LAS float* ga, LAS float* gz, LAS float* gp) {
    float f[4], iv[4];
#pragma unroll
    for (int j = 0; j < 4; ++j) { const float* r = IFP + (size_t)(t0 + 4 * lane + j) * 8; iv[j] = r[h]; f[j] = r[4 + h]; }
    float c[4]; c[0] = f[0]; c[1] = c[0] + f[1]; c[2] = c[1] + f[2]; c[3] = c[2] + f[3];
    float incl = c[3];
#pragma unroll
    for (int o = 1; o < 64; o <<= 1) { const float v = __shfl_up(incl, o); if (lane >= o) incl += v; }
    const float excl = incl - c[3];
    float a[4], z[4], p[4];
#pragma unroll
    for (int j = 0; j < 4; ++j) { a[j] = excl + c[j]; z[j] = iv[j] - a[j]; }
    p[0] = z[0]; p[1] = fmaxf(p[0], z[1]); p[2] = fmaxf(p[1], z[2]); p[3] = fmaxf(p[2], z[3]);
    float pin = p[3];
#pragma unroll
    for (int o = 1; o < 64; o <<= 1) { const float v = __shfl_up(pin, o); if (lane >= o) pin = fmaxf(pin, v); }
    float pex = __shfl_up(pin, 1); if (lane == 0) pex = -INFINITY;
    *(LAS f32x4*)(ga + 4 * lane) = (f32x4){a[0], a[1], a[2], a[3]};
    *(LAS f32x4*)(gz + 4 * lane) = (f32x4){z[0], z[1], z[2], z[3]};
    *(LAS f32x4*)(gp + 4 * lane) = (f32x4){fmaxf(pex, p[0]), fmaxf(pex, p[1]), fmaxf(pex, p[2]), fmaxf(pex, p[3])};
}

constexpr int MLL_K = 0;
constexpr int MLL_V = 2 * AT_KBUF;
constexpr int MLL_C = MLL_V + 2 * 16384;
constexpr int MLL_CSTR = 160 * 16 + 16, MLL_CBYTES = 16 * MLL_CSTR;
constexpr int MLL_G = MLL_C + MLL_CBYTES;
constexpr int MLL_END = MLL_G + 3 * 1024;
static_assert(MLL_END <= LDS_MISC_OFF, "mLSTM LDS");

__device__ __forceinline__ void ml_state_unit(LAS unsigned char* lds, unsigned char* ws, unsigned char* mo, int unit) {
    const int tid = tid_opaque(), lane = tid & 63, r32 = lane & 31, hh = lane >> 5, wid = __builtin_amdgcn_readfirstlane(tid >> 6);
    const int bh = unit >> 4, c = unit & 15, b = bh >> 2, h = bh & 3, t0 = b * SEQ + c * ML_L;
    const float* IFP = (const float*)(ws + WS_IFP); const bf16_t* P = (const bf16_t*)(ws + WS_P); const bf16_t* MLQK = (const bf16_t*)(ws + WS_MLQK);
    LAS float* ga = (LAS float*)(lds + MLL_G); LAS float* gz = ga + 256; LAS float* gp = gz + 256;
    if (wid == 0) ml_gate_scan(IFP, t0, h, lane, ga, gz, gp);
    __syncthreads();
    const float g = ga[255], pmL = gp[255];
    if (tid == 0) { float* gu = (float*)(mo + MO_GU) + unit * 2; gu[0] = g; gu[1] = g + pmL; }
    const int et = wid & 3, dt0 = 2 * (wid >> 2);
    f32x16 acc0 = f32x16{}, acc1 = f32x16{}, accn0 = f32x16{}, accn1 = f32x16{};
    const int sch = tid & 15;
    const int tg = lane >> 4, tq = (lane >> 2) & 3, tp = lane & 3;
    const int vlo = 64 * (4 * hh + tq) + 16 * ((2 * (tg & 1) + (tp >> 1)) ^ hh) + 8 * (tp & 1);
    const int vhi = 64 * (4 * hh + tq) + 16 * ((2 * (tg & 1) + (tp >> 1)) ^ (hh + 2)) + 8 * (tp & 1);
    const bf16x8 ones = (bf16x8){0x3F80, 0x3F80, 0x3F80, 0x3F80, 0x3F80, 0x3F80, 0x3F80, 0x3F80};
    for (int kt = 0; kt < 4; ++kt) {
        u32x4 kreg[2], vreg[2];
#pragma unroll
        for (int i = 0; i < 2; ++i) { const int r = (tid >> 4) + 32 * i; const size_t t = (size_t)(t0 + kt * 64 + r);
            kreg[i] = *(const u32x4*)(MLQK + t * 1024 + 512 + h * 128 + sch * 8); vreg[i] = *(const u32x4*)(P + t * PW + PC_MV + h * 128 + sch * 8); }
        __syncthreads();
#pragma unroll
        for (int i = 0; i < 2; ++i) { const int r = (tid >> 4) + 32 * i; const float w = __builtin_amdgcn_exp2f((gz[kt * 64 + r] - pmL) * LOG2E);
            u32x4 k = kreg[i];
            k.x = cvt_pk_bf16(bf_lo(k.x) * w, bf_hi(k.x) * w); k.y = cvt_pk_bf16(bf_lo(k.y) * w, bf_hi(k.y) * w); k.z = cvt_pk_bf16(bf_lo(k.z) * w, bf_hi(k.z) * w); k.w = cvt_pk_bf16(bf_lo(k.w) * w, bf_hi(k.w) * w);
            *(LAS u32x4*)(lds + MLL_K + v_off(r, sch)) = k; *(LAS u32x4*)(lds + MLL_V + v_off(r, sch)) = vreg[i]; }
        __syncthreads();
#pragma unroll
        for (int ks = 0; ks < 4; ++ks) {
            const int sub = 2048 * (2 * ks);
            const s16x4 vl = __builtin_bit_cast(s16x4, __builtin_amdgcn_ds_read_tr16_b64_v4i16((LAS v4i16_t*)(lds + MLL_V + vlo + sub + 512 * et)));
            const s16x4 vh = __builtin_bit_cast(s16x4, __builtin_amdgcn_ds_read_tr16_b64_v4i16((LAS v4i16_t*)(lds + MLL_V + vhi + sub + 2048 + 512 * et)));
            const bf16x8 vf = (bf16x8){vl[0], vl[1], vl[2], vl[3], vh[0], vh[1], vh[2], vh[3]};
            const s16x4 al = __builtin_bit_cast(s16x4, __builtin_amdgcn_ds_read_tr16_b64_v4i16((LAS v4i16_t*)(lds + MLL_K + vlo + sub + 512 * dt0)));
            const s16x4 ah = __builtin_bit_cast(s16x4, __builtin_amdgcn_ds_read_tr16_b64_v4i16((LAS v4i16_t*)(lds + MLL_K + vhi + sub + 2048 + 512 * dt0)));
            const bf16x8 af = (bf16x8){al[0], al[1], al[2], al[3], ah[0], ah[1], ah[2], ah[3]};
            const s16x4 bl = __builtin_bit_cast(s16x4, __builtin_amdgcn_ds_read_tr16_b64_v4i16((LAS v4i16_t*)(lds + MLL_K + vlo + sub + 512 * (dt0 + 1))));
            const s16x4 bhv = __builtin_bit_cast(s16x4, __builtin_amdgcn_ds_read_tr16_b64_v4i16((LAS v4i16_t*)(lds + MLL_K + vhi + sub + 2048 + 512 * (dt0 + 1))));
            const bf16x8 bf = (bf16x8){bl[0], bl[1], bl[2], bl[3], bhv[0], bhv[1], bhv[2], bhv[3]};
            acc0 = __builtin_amdgcn_mfma_f32_32x32x16_bf16(af, vf, acc0, 0, 0, 0);
            acc1 = __builtin_amdgcn_mfma_f32_32x32x16_bf16(bf, vf, acc1, 0, 0, 0);
            if (et == 0) { accn0 = __builtin_amdgcn_mfma_f32_32x32x16_bf16(af, ones, accn0, 0, 0, 0); accn1 = __builtin_amdgcn_mfma_f32_32x32x16_bf16(bf, ones, accn1, 0, 0, 0); }
        }
    }
    float* U = (float*)(mo + MO_U) + (size_t)unit * 16384 + (size_t)(32 * et + r32) * 128;
#pragma unroll
    for (int g4 = 0; g4 < 4; ++g4) {
        *(f32x4*)(U + 32 * dt0 + 8 * g4 + 4 * hh) = (f32x4){acc0[4 * g4], acc0[4 * g4 + 1], acc0[4 * g4 + 2], acc0[4 * g4 + 3]};
        *(f32x4*)(U + 32 * (dt0 + 1) + 8 * g4 + 4 * hh) = (f32x4){acc1[4 * g4], acc1[4 * g4 + 1], acc1[4 * g4 + 2], acc1[4 * g4 + 3]};
    }
    if (et == 0 && r32 == 0) {
        float* NL = (float*)(mo + MO_NL) + (size_t)unit * 128;
#pragma unroll
        for (int g4 = 0; g4 < 4; ++g4) {
            *(f32x4*)(NL + 32 * dt0 + 8 * g4 + 4 * hh) = (f32x4){accn0[4 * g4], accn0[4 * g4 + 1], accn0[4 * g4 + 2], accn0[4 * g4 + 3]};
            *(f32x4*)(NL + 32 * (dt0 + 1) + 8 * g4 + 4 * hh) = (f32x4){accn1[4 * g4], accn1[4 * g4 + 1], accn1[4 * g4 + 2], accn1[4 * g4 + 3]};
        }
    }
    __syncthreads();
}

__device__ __forceinline__ void ml_scan_phase(unsigned char* mo, int G) {
    const int tid = tid_opaque();
    const float* GU = (const float*)(mo + MO_GU);
    for (int i = blockIdx.x * NTHREADS + tid; i < 32 * 4096; i += G * NTHREADS) {
        const int bh = i >> 12, e4 = i & 4095;
        const float* U = (const float*)(mo + MO_U) + (size_t)bh * 16 * 16384 + e4 * 4;
        bf16_t* C = (bf16_t*)(mo + MO_C) + (size_t)bh * 16 * 16384 + e4 * 4;
        f32x4 st = (f32x4){0.f, 0.f, 0.f, 0.f}; float m = 0.f;
#pragma unroll 5
        for (int c = 0; c < 15; ++c) {
            const float g = GU[(bh * 16 + c) * 2], u = GU[(bh * 16 + c) * 2 + 1];
            const float mn = fmaxf(g + m, u), dec = __expf(g + m - mn), sc = __expf(u - mn);
            const f32x4 uv = *(const f32x4*)(U + (size_t)c * 16384);
            st = st * dec + uv * sc; m = mn;
            u32x2 o; o.x = cvt_pk_bf16(st.x, st.y); o.y = cvt_pk_bf16(st.z, st.w);
            *(u32x2*)(C + (size_t)(c + 1) * 16384) = o;
        }
    }
    for (int i = blockIdx.x * NTHREADS + tid; i < 32 * 32; i += G * NTHREADS) {
        const int bh = i >> 5, d4 = i & 31;
        const float* NL = (const float*)(mo + MO_NL) + (size_t)bh * 16 * 128 + d4 * 4;
        float* N = (float*)(mo + MO_N) + (size_t)bh * 16 * 128 + d4 * 4; float* M = (float*)(mo + MO_M) + bh * 16;
        f32x4 st = (f32x4){0.f, 0.f, 0.f, 0.f}; float m = 0.f;
        if (d4 == 0) M[0] = 0.f;
        for (int c = 0; c < 15; ++c) {
            const float g = GU[(bh * 16 + c) * 2], u = GU[(bh * 16 + c) * 2 + 1];
            const float mn = fmaxf(g + m, u), dec = __expf(g + m - mn), sc = __expf(u - mn);
            const f32x4 uv = *(const f32x4*)(NL + (size_t)c * 128);
            st = st * dec + uv * sc; m = mn;
            *(f32x4*)(N + (size_t)(c + 1) * 128) = st;
            if (d4 == 0) M[c + 1] = m;
        }
    }
}

__device__ __forceinline__ void ml_out_unit(LAS unsigned char* lds, unsigned char* ws, const unsigned char* mo, const float* gnorm, int unit) {
    const int tid = tid_opaque(), lane = tid & 63, r32 = lane & 31, hh = lane >> 5, wid = __builtin_amdgcn_readfirstlane(tid >> 6);
    const int bh = unit >> 4, c = unit & 15, b = bh >> 2, h = bh & 3, t0 = b * SEQ + c * ML_L;
    const float* IFP = (const float*)(ws + WS_IFP); const bf16_t* P = (const bf16_t*)(ws + WS_P); const bf16_t* MLQK = (const bf16_t*)(ws + WS_MLQK);
    bf16_t* YML = (bf16_t*)(ws + WS_YML);
    LAS float* ga = (LAS float*)(lds + MLL_G); LAS float* gz = ga + 256; LAS float* gp = gz + 256;
    if (wid == 0) ml_gate_scan(IFP, t0, h, lane, ga, gz, gp);
    {
        const bf16_t* Cg = (const bf16_t*)(mo + MO_C) + (size_t)unit * 16384; const float* Ng = (const float*)(mo + MO_N) + (size_t)unit * 128;
        for (int i = tid; i < 160 * 16; i += NTHREADS) { const int row = i >> 4, ch = i & 15;
            u32x4 v = (u32x4){0u, 0u, 0u, 0u};
            if (c > 0) {
                if (row < 128) v = *(const u32x4*)(Cg + row * 128 + ch * 8);
                else if (row == 128) { const f32x4 n0 = *(const f32x4*)(Ng + ch * 8), n1 = *(const f32x4*)(Ng + ch * 8 + 4);
                    v.x = cvt_pk_bf16(n0.x, n0.y); v.y = cvt_pk_bf16(n0.z, n0.w); v.z = cvt_pk_bf16(n1.x, n1.y); v.w = cvt_pk_bf16(n1.z, n1.w); }
            }
            *(LAS u32x4*)(lds + MLL_C + ch * MLL_CSTR + row * 16) = v; }
    }
    const float m_prev = (c > 0) ? ((const float*)(mo + MO_M))[unit] : 0.f;
    const int lq = 32 * wid + r32;
    bf16x8 qf[8];
    { const bf16_t* qp = MLQK + (size_t)(t0 + lq) * 1024 + h * 128 + hh * 8;
#pragma unroll
      for (int dd = 0; dd < 8; ++dd) qf[dd] = *(const bf16x8*)(qp + dd * 16); }
    __syncthreads();
    const float a_l = ga[lq], M_l = fmaxf(gp[lq], m_prev);
    const float w_inter = __expf(m_prev - M_l);
    f32x16 o[4]; f32x16 o4 = f32x16{};
#pragma unroll
    for (int et = 0; et < 4; ++et) o[et] = f32x16{};
    const LAS unsigned char* crd = lds + MLL_C + hh * MLL_CSTR + r32 * 16;
#pragma unroll
    for (int dd = 0; dd < 8; ++dd) {
#pragma unroll
        for (int et = 0; et < 4; ++et) { const bf16x8 cf = *(const LAS bf16x8*)(crd + (dd * 2) * MLL_CSTR + et * 512); o[et] = __builtin_amdgcn_mfma_f32_32x32x16_bf16(cf, qf[dd], o[et], 0, 0, 0); }
        const bf16x8 nf = *(const LAS bf16x8*)(crd + (dd * 2) * MLL_CSTR + 4 * 512); o4 = __builtin_amdgcn_mfma_f32_32x32x16_bf16(nf, qf[dd], o4, 0, 0, 0);
    }
    const float dinter = __shfl(o4[0], r32);
#pragma unroll
    for (int et = 0; et < 4; ++et)
#pragma unroll
        for (int r = 0; r < 16; ++r) o[et][r] *= w_inter;
    const int sch = tid & 15;
    const int tg = lane >> 4, tq = (lane >> 2) & 3, tp = lane & 3;
    const int vlo = 64 * (4 * hh + tq) + 16 * ((2 * (tg & 1) + (tp >> 1)) ^ hh) + 8 * (tp & 1);
    const int vhi = 64 * (4 * hh + tq) + 16 * ((2 * (tg & 1) + (tp >> 1)) ^ (hh + 2)) + 8 * (tp & 1);
    const int klane = hh * AT_KSTR + r32 * 16;
    float dintra = 0.f;
    for (int kt = 0; kt < 4; ++kt) {
        u32x4 kreg[2], vreg[2];
#pragma unroll
        for (int i = 0; i < 2; ++i) { const int r = (tid >> 4) + 32 * i; const size_t t = (size_t)(t0 + kt * 64 + r);
            kreg[i] = *(const u32x4*)(MLQK + t * 1024 + 512 + h * 128 + sch * 8); vreg[i] = *(const u32x4*)(P + t * PW + PC_MV + h * 128 + sch * 8); }
        __syncthreads();
#pragma unroll
        for (int i = 0; i < 2; ++i) { const int r = (tid >> 4) + 32 * i;
            *(LAS u32x4*)(lds + MLL_K + sch * AT_KSTR + r * 16) = kreg[i]; *(LAS u32x4*)(lds + MLL_V + v_off(r, sch)) = vreg[i]; }
        __syncthreads();
#pragma unroll
        for (int sb = 0; sb < 2; ++sb) {
            const int kb = kt * 64 + 32 * sb;
            if (kb <= 32 * wid + 31) {
                f32x16 sc = f32x16{};
#pragma unroll
                for (int dd = 0; dd < 8; ++dd) { const bf16x8 ka = *(const LAS bf16x8*)(lds + MLL_K + klane + (dd * 2) * AT_KSTR + sb * 512); sc = __builtin_amdgcn_mfma_f32_32x32x16_bf16(ka, qf[dd], sc, 0, 0, 0); }
#pragma unroll
                for (int g4 = 0; g4 < 4; ++g4) { const f32x4 zv = *(const LAS f32x4*)(gz + kb + 8 * g4 + 4 * hh);
#pragma unroll
                    for (int e = 0; e < 4; ++e) { const int s = kb + 8 * g4 + 4 * hh + e; const float wgt = (s <= lq) ? __builtin_amdgcn_exp2f((zv[e] - M_l) * LOG2E) : 0.f; sc[4 * g4 + e] *= wgt; dintra += sc[4 * g4 + e]; } }
                bf16x8 pf[2];
#pragma unroll
                for (int s = 0; s < 2; ++s) { u32x4 w;
                    w.x = cvt_pk_bf16(sc[8 * s + 0], sc[8 * s + 1]); w.y = cvt_pk_bf16(sc[8 * s + 2], sc[8 * s + 3]); w.z = cvt_pk_bf16(sc[8 * s + 4], sc[8 * s + 5]); w.w = cvt_pk_bf16(sc[8 * s + 6], sc[8 * s + 7]);
                    pf[s] = __builtin_bit_cast(bf16x8, w); }
#pragma unroll
                for (int s = 0; s < 2; ++s)
#pragma unroll
                    for (int et = 0; et < 4; ++et) {
                        const s16x4 lo = __builtin_bit_cast(s16x4, __builtin_amdgcn_ds_read_tr16_b64_v4i16((LAS v4i16_t*)(lds + MLL_V + vlo + 2048 * (4 * sb + 2 * s) + 512 * et)));
                        const s16x4 hi = __builtin_bit_cast(s16x4, __builtin_amdgcn_ds_read_tr16_b64_v4i16((LAS v4i16_t*)(lds + MLL_V + vhi + 2048 * (4 * sb + 2 * s + 1) + 512 * et)));
                        const bf16x8 vf = (bf16x8){lo[0], lo[1], lo[2], lo[3], hi[0], hi[1], hi[2], hi[3]};
                        o[et] = __builtin_amdgcn_mfma_f32_32x32x16_bf16(vf, pf[s], o[et], 0, 0, 0);
                    }
            }
        }
    }
    dintra += __shfl_xor(dintra, 32);
    const float den = dintra + w_inter * dinter;
    const float hsc = 1.0f / fmaxf(fabsf(den), __expf(-(a_l + M_l)));
    float ss = 0.f;
#pragma unroll
    for (int et = 0; et < 4; ++et)
#pragma unroll
        for (int r = 0; r < 16; ++r) { o[et][r] *= hsc; ss += o[et][r] * o[et][r]; }
    ss += __shfl_xor(ss, 32);
    const float rstd = 1.0f / sqrtf(ss * (1.f / 128.f) + NORM_EPS);
    const size_t tok = (size_t)(t0 + lq);
#pragma unroll
    for (int et = 0; et < 4; ++et)
#pragma unroll
        for (int g4 = 0; g4 < 4; ++g4) {
            const int e0 = 32 * et + 8 * g4 + 4 * hh;
            const f32x4 gv = *(const f32x4*)(gnorm + h * 128 + e0);
            const u32x2 og = *(const u32x2*)(P + tok * PW + PC_MO + h * 128 + e0);
            u32x2 w; w.x = cvt_pk_bf16(o[et][4 * g4 + 0] * rstd * gv.x * bf_lo(og.x), o[et][4 * g4 + 1] * rstd * gv.y * bf_hi(og.x));
            w.y = cvt_pk_bf16(o[et][4 * g4 + 2] * rstd * gv.z * bf_lo(og.y), o[et][4 * g4 + 3] * rstd * gv.w * bf_hi(og.y));
            *(u32x2*)(YML + tok * 512 + h * 128 + e0) = w;
        }
    __syncthreads();
}
struct SchedStatic {
    const char* A; const char* B; int nM, nN, G, c; size_t abytes, bbytes;
    __device__ __forceinline__ bool next(int i, pg8::Unit& u) const {
        int pm, pn; if (!pg8::static_tile(nM, nN, G, c, i, pm, pn)) return false;
        u.pm = pm; u.pn = pn; u.aux = 0; u.A = A + (size_t)pm * abytes; u.B = B + (size_t)pn * bbytes; return true; }
    __device__ __forceinline__ int arow(const pg8::Unit&, int r) const { return r; }
};
template <bool TWO> struct SchedPair {
    const char* A0; const char* A1; const char* B0; const char* B1; int nM, nN, G, c; size_t abytes, bbytes;
    __device__ __forceinline__ bool next(int i, pg8::Unit& u) const {
        const int p = TWO ? (i >> 1) : i, which = TWO ? (i & 1) : 0;
        int pm, pn; if (!pg8::static_tile(nM, nN, G, c, p, pm, pn)) return false;
        u.pm = pm; u.pn = pn; u.aux = which; u.A = (which ? A1 : A0) + (size_t)pm * abytes; u.B = (which ? B1 : B0) + (size_t)pn * bbytes; return true; }
    __device__ __forceinline__ int arow(const pg8::Unit&, int r) const { return r; }
};

struct EpiProj {
    static constexpr bool PERM = true;
    bf16_t* P; const float* bgate;
    __device__ __forceinline__ bool operator()(f32x4 (&acc)[2][2][4][2], const pg8::Unit& u, int wr, int wc, int fr, int fq) const {
        const int row0 = u.pm * 256 + wr * 64 + fr, col0 = u.pn * 256 + wc * 32 + 8 * fq;
        const int mode = u.pn < 12 ? 0 : (u.pn < 14 ? 1 : 2);
        f32x4 bv[2][2];
#pragma unroll
        for (int bj = 0; bj < 2; ++bj)
#pragma unroll
            for (int n = 0; n < 2; ++n) bv[bj][n] = (mode == 2) ? *(const f32x4*)(bgate + (col0 - PC_G) + bj * 128 + 4 * n) : (f32x4){0.f, 0.f, 0.f, 0.f};
#pragma unroll
        for (int ai = 0; ai < 2; ++ai)
#pragma unroll
            for (int m = 0; m < 4; ++m) { bf16_t* rowp = P + (size_t)(row0 + ai * 128 + m * 16) * PW + col0;
#pragma unroll
                for (int bj = 0; bj < 2; ++bj) { f32x4 v0 = acc[ai][bj][m][0] + bv[bj][0], v1 = acc[ai][bj][m][1] + bv[bj][1];
                    if (mode != 0) {
#pragma unroll
                        for (int j = 0; j < 4; ++j) { v0[j] = fast_sigmoid(v0[j]); v1[j] = fast_sigmoid(v1[j]); } }
                    u32x4 w; w.x = cvt_pk_bf16(v0[0], v0[1]); w.y = cvt_pk_bf16(v0[2], v0[3]); w.z = cvt_pk_bf16(v1[0], v1[1]); w.w = cvt_pk_bf16(v1[2], v1[3]);
                    *(u32x4*)(rowp + bj * 128) = w; } }
        return false;
    }
};

template <bool TWO> struct EpiMixed {
    static constexpr bool PERM = true;
    const bf16_t* P; bf16_t* MIX;
    __device__ __forceinline__ bool operator()(f32x4 (&acc)[2][2][4][2], const pg8::Unit& u, int wr, int wc, int fr, int fq) const {
        const int row0 = u.pm * 256 + wr * 64 + fr, col0 = u.pn * 256 + wc * 32 + 8 * fq;
        const bool first = TWO && (u.aux == 0);
#pragma unroll
        for (int ai = 0; ai < 2; ++ai)
#pragma unroll
            for (int m = 0; m < 4; ++m) { const int row = row0 + ai * 128 + m * 16; const bf16_t* gp = P + (size_t)row * PW + PC_G + col0;
#pragma unroll
                for (int bj = 0; bj < 2; ++bj) {
                    const u32x4 ga = *(const u32x4*)(gp + bj * 128);
                    float g1[8] = {bf_lo(ga.x), bf_hi(ga.x), bf_lo(ga.y), bf_hi(ga.y), bf_lo(ga.z), bf_hi(ga.z), bf_lo(ga.w), bf_hi(ga.w)};
                    if (!TWO) {
                        f32x4 v0 = acc[ai][bj][m][0], v1 = acc[ai][bj][m][1];
#pragma unroll
                        for (int j = 0; j < 4; ++j) { v0[j] *= g1[j]; v1[j] *= g1[4 + j]; }
                        u32x4 w; w.x = cvt_pk_bf16(v0[0], v0[1]); w.y = cvt_pk_bf16(v0[2], v0[3]); w.z = cvt_pk_bf16(v1[0], v1[1]); w.w = cvt_pk_bf16(v1[2], v1[3]);
                        *(u32x4*)(MIX + (size_t)row * 1024 + col0 + bj * 128) = w;
                    } else {
                        const u32x4 gb = *(const u32x4*)(gp + 1024 + bj * 128);
                        float g2[8] = {bf_lo(gb.x), bf_hi(gb.x), bf_lo(gb.y), bf_hi(gb.y), bf_lo(gb.z), bf_hi(gb.z), bf_lo(gb.w), bf_hi(gb.w)};
                        if (first) {
#pragma unroll
                            for (int j = 0; j < 4; ++j) { acc[ai][bj][m][0][j] *= g1[j] * __builtin_amdgcn_rcpf(fmaxf(g2[j], 1e-30f)); acc[ai][bj][m][1][j] *= g1[4 + j] * __builtin_amdgcn_rcpf(fmaxf(g2[4 + j], 1e-30f)); }
                        } else {
                            f32x4 v0 = acc[ai][bj][m][0], v1 = acc[ai][bj][m][1];
#pragma unroll
                            for (int j = 0; j < 4; ++j) { v0[j] *= g2[j]; v1[j] *= g2[4 + j]; }
                            u32x4 w; w.x = cvt_pk_bf16(v0[0], v0[1]); w.y = cvt_pk_bf16(v0[2], v0[3]); w.z = cvt_pk_bf16(v1[0], v1[1]); w.w = cvt_pk_bf16(v1[2], v1[3]);
                            *(u32x4*)(MIX + (size_t)row * 1024 + col0 + bj * 128) = w;
                        }
                    }
                } }
        return first;
    }
};

struct EpiWout {
    static constexpr bool PERM = false;
    const float* x; float* out;
    __device__ __forceinline__ bool operator()(f32x4 (&acc)[2][2][4][2], const pg8::Unit& u, int wr, int wc, int fr, int fq) const {
        const int row0 = u.pm * 256 + wr * 64 + fr, col0 = u.pn * 256 + wc * 32 + 4 * fq;
#pragma unroll
        for (int ai = 0; ai < 2; ++ai)
#pragma unroll
            for (int m = 0; m < 4; ++m) { const size_t ro = (size_t)(row0 + ai * 128 + m * 16) * D + col0;
#pragma unroll
                for (int bj = 0; bj < 2; ++bj)
#pragma unroll
                    for (int n = 0; n < 2; ++n) { const f32x4 xv = *(const f32x4*)(x + ro + bj * 128 + n * 16); *(f32x4*)(out + ro + bj * 128 + n * 16) = xv + acc[ai][bj][m][n]; } }
        return false;
    }
};
constexpr size_t WS_TILEE = WS_WGCNT + (size_t)256 * 64 * 4;
constexpr size_t WS_NT = WS_TILEE + 384 * 4;
static_assert(WS_NT + 16 <= WS_END, "MoE tables must fit the P region");
__device__ __forceinline__ int ld_i32(const int* p) { return (int)__hip_atomic_load((const unsigned*)p, __ATOMIC_RELAXED, __HIP_MEMORY_SCOPE_AGENT); }

constexpr int RT_LG = 36 * 1024 * 4;
constexpr int RT_HIST = RT_LG + 8 * 4 * 36 * 4;
static_assert(RT_HIST + 256 <= LDS_MISC_OFF, "router LDS");

__device__ __forceinline__ void router_phase(LAS unsigned char* lds, const float* const* in, unsigned char* ws, const float* x1, int G) {
    moe_weight_convert(lds, in, ws, G);
    __syncthreads();
    const int tid = tid_opaque(), lane = tid & 63, wave = __builtin_amdgcn_readfirstlane(tid >> 6);
    const int gw = blockIdx.x * NWAVES + wave, NGW = G * NWAVES;
    const float* gn = in[20]; const float* w_group = in[21]; const float* b_group = in[22]; const float* w_router = in[23]; const float* b_router = in[24];
    LAS float* wr = (LAS float*)lds;
    for (int i = tid; i < 4096; i += NTHREADS) { const int d = i >> 2, j = i & 3; wr[j * 1024 + d] = w_group[i]; }
    for (int i = tid; i < 32768; i += NTHREADS) { const int d = i >> 5, j = i & 31; wr[(4 + j) * 1024 + d] = w_router[i]; }
    LAS float* lg = (LAS float*)(lds + RT_LG) + wave * (4 * 36);
    LAS int* hist = (LAS int*)(lds + RT_HIST);
    if (tid < 64) hist[tid] = 0;
    __syncthreads();
    bf16_t* HN = (bf16_t*)(ws + WS_HN); int* TEID = (int*)(ws + WS_TEID); float* TGATE = (float*)(ws + WS_TGATE);
    f32x4 gv[4];
#pragma unroll
    for (int j = 0; j < 4; ++j) gv[j] = *(const f32x4*)(gn + lane * 4 + 256 * j);
    for (int row0 = gw * 4; row0 < T; row0 += NGW * 4) {
        f32x4 v[4][4];
#pragma unroll
        for (int r = 0; r < 4; ++r) {
            const f32x4* xr = (const f32x4*)(x1 + (size_t)(row0 + r) * D) + lane; float s = 0.f;
#pragma unroll
            for (int j = 0; j < 4; ++j) { v[r][j] = xr[64 * j]; s += (v[r][j].x * v[r][j].x + v[r][j].y * v[r][j].y) + (v[r][j].z * v[r][j].z + v[r][j].w * v[r][j].w); }
            const float rstd = 1.0f / sqrtf(wave_sum(s) * (1.f / D) + NORM_EPS);
            unsigned long long* o8 = (unsigned long long*)(HN + (size_t)(row0 + r) * D) + lane;
#pragma unroll
            for (int j = 0; j < 4; ++j) { v[r][j] = v[r][j] * rstd * gv[j];
                o8[64 * j] = (unsigned long long)cvt_pk_bf16(v[r][j].x, v[r][j].y) | ((unsigned long long)cvt_pk_bf16(v[r][j].z, v[r][j].w) << 32); }
        }
        float res[4] = {0.f, 0.f, 0.f, 0.f};
#pragma unroll 2
        for (int col = 0; col < 36; ++col) {
            f32x4 w[4];
#pragma unroll
            for (int j = 0; j < 4; ++j) w[j] = *(const LAS f32x4*)(wr + col * 1024 + lane * 4 + 256 * j);
#pragma unroll
            for (int r = 0; r < 4; ++r) { float a = 0.f;
#pragma unroll
                for (int j = 0; j < 4; ++j) a += (v[r][j].x * w[j].x + v[r][j].y * w[j].y) + (v[r][j].z * w[j].z + v[r][j].w * w[j].w);
                a = wave_sum(a); res[r] = (lane == col) ? a : res[r]; }
        }
        if (lane < 36) {
#pragma unroll
            for (int r = 0; r < 4; ++r) lg[r * 36 + lane] = res[r];
        }
        asm volatile("s_waitcnt lgkmcnt(0)" ::: "memory");
        if (lane < 4) {
            const LAS float* L = lg + lane * 36;
            float gl[4]; int gi = 0; float gm = -INFINITY;
#pragma unroll
            for (int i = 0; i < 4; ++i) { gl[i] = L[i] + b_group[i]; if (gl[i] > gm) { gm = gl[i]; gi = i; } }
            float gs = 0.f;
#pragma unroll
            for (int i = 0; i < 4; ++i) gs += __expf(gl[i] - gm);
            const float gtop = 1.0f / gs;
            float l1 = -INFINITY, l2 = -INFINITY; int e1 = 0, e2 = 0;
            for (int i = 0; i < 8; ++i) { const float l = L[4 + gi * 8 + i] + b_router[gi * 8 + i];
                if (l > l1) { l2 = l1; e2 = e1; l1 = l; e1 = i; } else if (l > l2) { l2 = l; e2 = i; } }
            const float p2 = __expf(l2 - l1), w1 = 1.0f / (1.0f + p2), w2 = p2 * w1;
            const int t = row0 + lane;
            TEID[t * 2] = gi * 8 + e1; TEID[t * 2 + 1] = gi * 8 + e2; TGATE[t * 2] = gtop * w1; TGATE[t * 2 + 1] = gtop * w2;
            __hip_atomic_fetch_add(&hist[gi * 8 + e1], 1, __ATOMIC_RELAXED, __HIP_MEMORY_SCOPE_WORKGROUP); __hip_atomic_fetch_add(&hist[32 + gi * 8 + e2], 1, __ATOMIC_RELAXED, __HIP_MEMORY_SCOPE_WORKGROUP);
        }
        asm volatile("s_waitcnt lgkmcnt(0)" ::: "memory");
    }
    __syncthreads();
    if (tid < 64) ((int*)(ws + WS_WGCNT))[blockIdx.x * 64 + tid] = hist[tid];
}

__device__ __forceinline__ void moe_plan_phase(LAS unsigned char* lds, unsigned char* ws, int G) {
    const int tid = tid_opaque();
    LAS int* tot = (LAS int*)lds; LAS int* pre = tot + 64; LAS int* base = pre + 64; LAS int* lcnt = base + 64;
    const int* WGCNT = (const int*)(ws + WS_WGCNT);
    if (tid < 64) { int t = 0, p = 0;
        for (int w = 0; w < 256; ++w) { const int v = ld_i32(WGCNT + w * 64 + tid); t += v; if (w < (int)blockIdx.x) p += v; }
        tot[tid] = t; pre[tid] = p; lcnt[tid] = 0; }
    __syncthreads();
    if (tid == 0) { int run = 0; for (int j = 0; j < 64; ++j) { base[j] = run; run += ((tot[j] + 255) >> 8) << 8; } }
    __syncthreads();
    int* RTOK = (int*)(ws + WS_RTOK); float* RGATE = (float*)(ws + WS_RGATE);
    if (tid < 256) {
        const int k = tid & 1, ts = tid >> 1, i = ts >> 5, wv = (ts >> 2) & 7, r = ts & 3;
        const int t = ((int)blockIdx.x * 8 + wv) * 4 + r + G * NWAVES * 4 * i;
        const int e = ld_i32((const int*)(ws + WS_TEID) + t * 2 + k); const float g = __uint_as_float((unsigned)ld_i32((const int*)(ws + WS_TGATE) + t * 2 + k));
        const int j = k * 32 + e; const int rk = __hip_atomic_fetch_add(&lcnt[j], 1, __ATOMIC_RELAXED, __HIP_MEMORY_SCOPE_WORKGROUP);
        const int slot = base[j] + pre[j] + rk;
        RTOK[slot] = t; RGATE[slot] = g;
    }
    if (blockIdx.x < 64) { const int j = blockIdx.x; const int s0 = base[j] + tot[j], s1 = base[j] + (((tot[j] + 255) >> 8) << 8);
        for (int s = s0 + tid; s < s1; s += NTHREADS) { RTOK[s] = -1; RGATE[s] = 0.f; } }
    if (blockIdx.x == 0 && tid == 0) { int* TE = (int*)(ws + WS_TILEE); int* NT = (int*)(ws + WS_NT); int tau = 0;
        for (int j = 0; j < 64; ++j) { const int n = (tot[j] + 255) >> 8; for (int q = 0; q < n; ++q) TE[tau++] = j & 31; if (j == 31) NT[0] = tau; }
        NT[1] = tau; }
    __syncthreads();
}

struct SchedUp {
    const char* HN; const char* W13; const int* RTOK; const int* TE; int ntiles, G, c;
    __device__ __forceinline__ bool next(int i, pg8::Unit& u) const {
        const int L = i * G + c; if (L >= ntiles * 4) return false;
        const int tau = L >> 2, pn = L & 3, e = ld_i32(TE + tau);
        u.pm = tau; u.pn = pn; u.aux = e; u.A = HN; u.B = W13 + (size_t)e * (1024 * 1024 * 2) + (size_t)pn * (256 * 1024 * 2); return true; }
    __device__ __forceinline__ int arow(const pg8::Unit& u, int r) const { const int t = ld_i32(RTOK + u.pm * 256 + r); return t < 0 ? 0 : t; }
};
struct EpiUp {
    static constexpr bool PERM = true;
    bf16_t* HID;
    __device__ __forceinline__ bool operator()(f32x4 (&acc)[2][2][4][2], const pg8::Unit& u, int wr, int wc, int fr, int fq) const {
        const int row0 = u.pm * 256 + wr * 64 + fr, col0 = u.pn * 128 + wc * 32 + 8 * fq;
#pragma unroll
        for (int ai = 0; ai < 2; ++ai)
#pragma unroll
            for (int m = 0; m < 4; ++m) {
                float hv[8];
#pragma unroll
                for (int n = 0; n < 2; ++n)
#pragma unroll
                    for (int j = 0; j < 4; ++j) { const float a = acc[ai][0][m][n][j]; hv[4 * n + j] = a * fast_sigmoid(a) * acc[ai][1][m][n][j]; }
                u32x4 w; w.x = cvt_pk_bf16(hv[0], hv[1]); w.y = cvt_pk_bf16(hv[2], hv[3]); w.z = cvt_pk_bf16(hv[4], hv[5]); w.w = cvt_pk_bf16(hv[6], hv[7]);
                *(u32x4*)(HID + (size_t)(row0 + ai * 128 + m * 16) * 512 + col0) = w;
            }
        return false;
    }
};
struct SchedDown {
    const char* HID; const char* W2T; const int* TE; int t0, t1, G, c;
    __device__ __forceinline__ bool next(int i, pg8::Unit& u) const {
        const int L = i * G + c; if (L >= (t1 - t0) * 4) return false;
        const int tau = t0 + (L >> 2), pn = L & 3, e = ld_i32(TE + tau);
        u.pm = tau; u.pn = pn; u.aux = e; u.A = HID + (size_t)tau * (256 * 512 * 2); u.B = W2T + (size_t)e * (1024 * 512 * 2) + (size_t)pn * (256 * 512 * 2); return true; }
    __device__ __forceinline__ int arow(const pg8::Unit&, int r) const { return r; }
};
struct EpiDown {
    static constexpr bool PERM = false;
    const int* RTOK; const float* RGATE; float* out;
    __device__ __forceinline__ bool operator()(f32x4 (&acc)[2][2][4][2], const pg8::Unit& u, int wr, int wc, int fr, int fq) const {
        const int row0 = u.pm * 256 + wr * 64 + fr, col0 = u.pn * 256 + wc * 32 + 4 * fq;
#pragma unroll
        for (int ai = 0; ai < 2; ++ai)
#pragma unroll
            for (int m = 0; m < 4; ++m) { const int slot = row0 + ai * 128 + m * 16; const int tok = ld_i32(RTOK + slot);
                if (tok >= 0) { const float g = __uint_as_float((unsigned)ld_i32((const int*)RGATE + slot)); float* op = out + (size_t)tok * D + col0;
#pragma unroll
                    for (int bj = 0; bj < 2; ++bj)
#pragma unroll
                        for (int n = 0; n < 2; ++n) { f32x4* q = (f32x4*)(op + bj * 128 + n * 16); *q = *q + acc[ai][bj][m][n] * g; } } }
        return false;
    }
};
struct Args { const float* in[28]; float* out; unsigned char* ws; };

__global__ void __launch_bounds__(NTHREADS, 2) fwd(Args a) {
    extern __shared__ __attribute__((aligned(16))) unsigned char lds_raw[];
    LAS unsigned char* lds = (LAS unsigned char*)lds_raw;
    const int tid = threadIdx.x; const int G = (int)gridDim.x;
    volatile LAS unsigned* misc = (volatile LAS unsigned*)(lds + LDS_MISC_OFF);
    if (tid < 64) misc[tid] = 0u;
    __syncthreads();
    unsigned* ctl = (unsigned*)(a.ws + WS_CTL);
    XcdBarrier bar = xcd_barrier_post(ctl + CW_BAR, misc);
    unsigned char* ws = a.ws;

    p0_prologue(lds, a.in, ws, G);
    xcd_barrier(bar);
    {
        SchedStatic S{(const char*)(ws + WS_HB), (const char*)(ws + WS_WIN), 128, 22, G, (int)blockIdx.x, (size_t)256 * 1024 * 2, (size_t)256 * 1024 * 2};
        EpiProj E{(bf16_t*)(ws + WS_P), a.in[18]};
        pg8::gemm_run<EpiProj, SchedStatic, false>(lds, 1024, S, E);
    }
    xcd_barrier(bar);
    da_qk_norm(ws, a.in[3], a.in[4], G);
    ml_conv_phase(ws, a.in[10], a.in[11], G);
    xcd_barrier(bar);
    unsigned char* mo = (unsigned char*)a.out;
    for (int u = blockIdx.x; u < ML_UNITS; u += G) ml_state_unit(lds, ws, mo, u);
    xcd_barrier(bar);
    ml_scan_phase(mo, G);
    xcd_barrier(bar);
    attn_phase(lds, a.in, ws, G);
    __syncthreads();
    for (int u = blockIdx.x; u < ML_UNITS; u += G) ml_out_unit(lds, ws, mo, a.in[14], u);
    xcd_barrier(bar);
    {
        SchedPair<true> S{(const char*)(ws + WS_YDA), (const char*)(ws + WS_YML), (const char*)(ws + WS_WDA), (const char*)(ws + WS_WML), 128, 4, G, (int)blockIdx.x, (size_t)256 * 512 * 2, (size_t)256 * 512 * 2};
        EpiMixed<true> E{(const bf16_t*)(ws + WS_P), (bf16_t*)(ws + WS_MIX)};
        pg8::gemm_run<EpiMixed<true>, SchedPair<true>, false>(lds, 512, S, E);
    }
    xcd_barrier(bar);
    {
        SchedStatic S{(const char*)(ws + WS_MIX), (const char*)(ws + WS_WOUT), 128, 4, G, (int)blockIdx.x, (size_t)256 * 1024 * 2, (size_t)256 * 1024 * 2};
        EpiWout E{a.in[0], a.out};
        pg8::gemm_run<EpiWout, SchedStatic, false>(lds, 1024, S, E);
    }
    xcd_barrier(bar);
    router_phase(lds, a.in, ws, a.out, G);
    xcd_barrier(bar);
    moe_plan_phase(lds, ws, G);
    xcd_barrier(bar);
    const int nt0 = ld_i32((const int*)(ws + WS_NT)), nt1 = ld_i32((const int*)(ws + WS_NT) + 1);
    {
        SchedUp S{(const char*)(ws + WS_HN), (const char*)(ws + WS_W13), (const int*)(ws + WS_RTOK), (const int*)(ws + WS_TILEE), nt1, G, (int)blockIdx.x};
        EpiUp E{(bf16_t*)(ws + WS_HID)};
        pg8::gemm_run<EpiUp, SchedUp, true>(lds, 1024, S, E);
    }
    xcd_barrier(bar);
    {
        SchedDown S{(const char*)(ws + WS_HID), (const char*)(ws + WS_W2), (const int*)(ws + WS_TILEE), 0, nt0, G, (int)blockIdx.x};
        EpiDown E{(const int*)(ws + WS_RTOK), (const float*)(ws + WS_RGATE), a.out};
        pg8::gemm_run<EpiDown, SchedDown, false>(lds, 512, S, E);
    }
    xcd_barrier(bar);
    {
        SchedDown S{(const char*)(ws + WS_HID), (const char*)(ws + WS_W2), (const int*)(ws + WS_TILEE), nt0, nt1, G, (int)blockIdx.x};
        EpiDown E{(const int*)(ws + WS_RTOK), (const float*)(ws + WS_RGATE), a.out};
        pg8::gemm_run<EpiDown, SchedDown, false>(lds, 512, S, E);
    }
}

extern "C" void kernel_launch(void* const* d_in, const int* in_sizes, int n_in, void* d_out, int out_size, void* d_ws, size_t ws_size, hipStream_t stream) {
    static int grid = 0;
    if (grid == 0) {
        if (n_in != 28 || out_size != T * D || ws_size < WS_END) { fprintf(stderr, "kernel_launch: unexpected shapes (n_in %d, out %d, ws %zu, need %zu)\n", n_in, out_size, ws_size, (size_t)WS_END); grid = -1; return; }
        int dev = 0, cus = 0, per_cu = 0;
        if (hipGetDevice(&dev) != hipSuccess || hipDeviceGetAttribute(&cus, hipDeviceAttributeMultiprocessorCount, dev) != hipSuccess) { grid = -1; return; }
        if (hipFuncSetAttribute((const void*)fwd, hipFuncAttributeMaxDynamicSharedMemorySize, LDS_BYTES) != hipSuccess) { fprintf(stderr, "kernel_launch: hipFuncSetAttribute failed\n"); grid = -1; return; }
        if (hipOccupancyMaxActiveBlocksPerMultiprocessor(&per_cu, (const void*)fwd, NTHREADS, LDS_BYTES) != hipSuccess || per_cu < 1) { fprintf(stderr, "kernel_launch: occupancy query reports %d\n", per_cu); }
        (void)hipGetLastError();
        grid = cus;
        if (grid != 256) { fprintf(stderr, "kernel_launch: built for a 256-CU device (got %d)\n", cus); grid = -1; return; }
    }
    if (grid < 0) return;
    if (hipMemsetAsync((char*)d_ws + WS_CTL, 0, CTL_BYTES, stream) != hipSuccess) return;
    Args a{};
    for (int i = 0; i < 28; ++i) a.in[i] = (const float*)d_in[i];
    a.out = (float*)d_out; a.ws = (unsigned char*)d_ws;
    hipLaunchKernelGGL(fwd, dim3(grid), dim3(NTHREADS), LDS_BYTES, stream, a);
}
```

```cpp
#include <hip/hip_runtime.h>
#include <cstdio>
#include <cstdint>

#define LAS __attribute__((address_space(3)))
typedef unsigned short bf16_t;
typedef short bf16x8 __attribute__((ext_vector_type(8)));
typedef short s16x4 __attribute__((ext_vector_type(4)));
typedef float f32x2 __attribute__((ext_vector_type(2)));
typedef float f32x4 __attribute__((ext_vector_type(4)));
typedef float f32x16 __attribute__((ext_vector_type(16)));
typedef unsigned u32x2 __attribute__((ext_vector_type(2)));
typedef unsigned u32x4 __attribute__((ext_vector_type(4)));

constexpr int T = 32768, D = 1024, SEQ = 4096, NBATCH = 8;
constexpr int PW = 5632;
constexpr int IN_W = 3592;
constexpr int PC_Q = 0, PC_K = 512, PC_V = 1024, PC_MQ = 1536, PC_MK = 2048, PC_MV = 2560, PC_MO = 3072, PC_G = 3584;
constexpr int NEXP = 32, FF = 512;
constexpr float NORM_EPS = 1e-6f;
constexpr float LOG2E = 1.4426950408889634f;
constexpr int NTHREADS = 512, NWAVES = 8;

constexpr size_t WS_CTL = 0, CTL_BYTES = 65536;
constexpr size_t WS_WIN = WS_CTL + CTL_BYTES;
constexpr size_t WS_WDA = WS_WIN + (size_t)PW * 1024 * 2;
constexpr size_t WS_WML = WS_WDA + (size_t)1024 * 512 * 2;
constexpr size_t WS_WOUT = WS_WML + (size_t)1024 * 512 * 2;
constexpr size_t WS_IFP = WS_WOUT + (size_t)1024 * 1024 * 2;
constexpr size_t WS_HB = WS_IFP + (size_t)T * 8 * 4;
constexpr size_t WS_MLQK = WS_HB + (size_t)T * 1024 * 2;
constexpr size_t WS_P = WS_MLQK + (size_t)T * 1024 * 2;
constexpr size_t WS_END = WS_P + (size_t)T * PW * 2;
constexpr size_t WS_YDA = WS_HB;
constexpr size_t WS_YML = WS_HB + (size_t)T * 512 * 2;
constexpr size_t WS_MIX = WS_MLQK;
constexpr size_t WS_HN = WS_HB;
constexpr int MOE_ROWS = 65536 + 64 * 256;
constexpr size_t WS_W13 = WS_P;
constexpr size_t WS_W2 = WS_W13 + (size_t)NEXP * 1024 * 1024 * 2;
constexpr size_t WS_HID = WS_W2 + (size_t)NEXP * 1024 * 512 * 2;
constexpr size_t WS_RTOK = WS_HID + (size_t)MOE_ROWS * 512 * 2;
constexpr size_t WS_RGATE = WS_RTOK + (size_t)MOE_ROWS * 4;
constexpr size_t WS_TEID = WS_RGATE + (size_t)MOE_ROWS * 4;
constexpr size_t WS_TGATE = WS_TEID + (size_t)T * 2 * 4;
constexpr size_t WS_WGCNT = WS_TGATE + (size_t)T * 2 * 4;
constexpr size_t WS_MOE_END = WS_WGCNT + (size_t)256 * 64 * 4;
static_assert(WS_MOE_END <= WS_END, "MoE overlay must fit the P region");
constexpr int CW_BAR = 0;
constexpr int CW_MISC = 4096;

constexpr int LDS_BYTES = 160 * 1024;
constexpr int LDS_MISC_OFF = LDS_BYTES - 256;

__device__ __forceinline__ unsigned cvt_pk_bf16(float lo, float hi) { unsigned r; asm volatile("v_cvt_pk_bf16_f32 %0, %1, %2" : "=v"(r) : "v"(lo), "v"(hi)); return r; }
__device__ __forceinline__ float bf_lo(unsigned w) { return __uint_as_float(w << 16); }
__device__ __forceinline__ float bf_hi(unsigned w) { return __uint_as_float(w & 0xffff0000u); }
__device__ __forceinline__ float bf2f(bf16_t b) { return __uint_as_float(((unsigned)b) << 16); }
__device__ __forceinline__ float fast_sigmoid(float x) { return __builtin_amdgcn_rcpf(1.0f + __builtin_amdgcn_exp2f(-LOG2E * x)); }
__device__ __forceinline__ float wave_sum(float v) {
#pragma unroll
    for (int o = 1; o < 64; o <<= 1) v += __shfl_xor(v, o);
    return v;
}
__device__ __forceinline__ int tid_opaque() { int t = (int)threadIdx.x; asm volatile("" : "+v"(t)); return t; }
#define XB_TMO      128
#define XB_XCNT(j)  (256  + 64 * (j))
#define XB_XSUB(j)  (1280 + 64 * (j))
#define XB_XGEN(j)  (2304 + 64 * (j))
#define XB_TOP      3328
#define XB_TOPGEN   3392
#define XCD_BAR_WORDS 3456
#define XB_SPIN_CAP (1u << 18)

__device__ __forceinline__ unsigned xb_ld(unsigned* p)              { return __hip_atomic_load(p, __ATOMIC_RELAXED, __HIP_MEMORY_SCOPE_AGENT); }
__device__ __forceinline__ unsigned xb_add(unsigned* p, unsigned v) { return __hip_atomic_fetch_add(p, v, __ATOMIC_RELAXED, __HIP_MEMORY_SCOPE_AGENT); }
__device__ __forceinline__ unsigned xb_xcc_id() { return (unsigned)__builtin_amdgcn_s_getreg((3 << 11) | 20) & 0xFu; }
#define XB_SPIN(cond, bar) do { unsigned _sp = 0; while (cond) { __builtin_amdgcn_s_sleep(1); \
    if ((++_sp & 255u) == 0u) { if (xb_ld(&(bar)[XB_TMO])) break; if (_sp > XB_SPIN_CAP) { atomicAdd(&(bar)[XB_TMO], 1u); break; } } } } while (0)

struct XcdBarrier {
    unsigned* bar; unsigned x;
    volatile LAS unsigned* st;
};

__device__ __forceinline__ XcdBarrier xcd_barrier_post(unsigned* bar, volatile LAS unsigned* st) {
    XcdBarrier b; b.bar = bar; b.x = xb_xcc_id(); b.st = st;
    if (threadIdx.x == 0) (void)xb_add(&bar[XB_XCNT(b.x)], 1u);
    return b;
}
__device__ __forceinline__ void xcd_barrier_complete(unsigned* bar, unsigned x, unsigned& nloc, unsigned& nx) {
    const unsigned G = gridDim.x * gridDim.y * gridDim.z;
    unsigned sum, cnt, mine, sp = 0u;
    for (;;) {
        sum = 0u; cnt = 0u; mine = 0u;
#pragma unroll
        for (unsigned j = 0; j < 16; ++j) { const unsigned c = xb_ld(&bar[XB_XCNT(j)]); sum += c; cnt += (c > 0u) ? 1u : 0u; mine = (j == x) ? c : mine; }
        if (sum == G) break;
        __builtin_amdgcn_s_sleep(1);
        if ((++sp & 255u) == 0u) { if (xb_ld(&bar[XB_TMO])) break; if (sp > XB_SPIN_CAP) { atomicAdd(&bar[XB_TMO], 1u); break; } }
    }
    nloc = mine > 0u ? mine : 1u; nx = cnt > 0u ? cnt : 1u;
}

__device__ __forceinline__ void xcd_barrier(const XcdBarrier& b) {
    asm volatile("s_waitcnt vmcnt(0)" ::: "memory");
    __syncthreads();
    if (threadIdx.x == 0) {
        unsigned* bar = b.bar;
        __builtin_amdgcn_s_waitcnt(0);
        unsigned nloc = b.st[0], nx = b.st[1];
        if (nloc == 0u) { xcd_barrier_complete(bar, b.x, nloc, nx); b.st[0] = nloc; b.st[1] = nx; }
        const unsigned old = xb_add(&bar[XB_XSUB(b.x)], 1u);
        const unsigned gen = old / nloc;
        if (old + 1u == (gen + 1u) * nloc) {
            __builtin_amdgcn_fence(__ATOMIC_RELEASE, "agent");
            asm volatile("s_waitcnt vmcnt(0)" ::: "memory");
            const unsigned og = xb_add(&bar[XB_TOP], 1u);
            const unsigned tg = og / nx;
            if (og + 1u == (tg + 1u) * nx) xb_add(&bar[XB_TOPGEN], 1u);
            else XB_SPIN(xb_ld(&bar[XB_TOPGEN]) == tg, bar);
            __builtin_amdgcn_fence(__ATOMIC_ACQUIRE, "agent");
            xb_add(&bar[XB_XGEN(b.x)], 1u);
            asm volatile("s_waitcnt vmcnt(0)" ::: "memory");
        } else {
            XB_SPIN(xb_ld(&bar[XB_XGEN(b.x)]) == gen, bar);
            __builtin_amdgcn_fence(__ATOMIC_ACQUIRE, "agent");
            asm volatile("s_waitcnt vmcnt(0)" ::: "memory");
        }
    }
    __syncthreads();
}

namespace pg8 {
constexpr int BM = 256, BK = 64, HALF = 128, HTB = HALF * BK * 2  , STAGE_BYTES = 8 * HTB, NXCD = 8, WGM = 8;
__host__ __device__ __forceinline__ int lds_byte(int r, int c) { const int st = (r >> 4) * 2 + (c >> 5), rr = r & 15, cc = c & 31, ob = rr * 64 + cc * 2; return st * 1024 + (ob ^ (((ob >> 9) & 1) << 5)); }
__host__ __device__ __forceinline__ void stage_rc(int b, int& R, int& C) { const int st = b / 1024, sb = b % 1024, swz = sb ^ (((sb >> 9) & 1) << 5); R = (st >> 1) * 16 + swz / 64; C = (st & 1) * 32 + (swz % 64) / 2; }
__host__ __device__ __forceinline__ int perm32(int rho) { const int n = rho >> 4, i = rho & 15; return 8 * (i >> 2) + 4 * n + (i & 3); }

__host__ __device__ __forceinline__ int perm_rows(int R) { return (R & ~31) + perm32(R & 31); }
struct Unit { const char* A; const char* B; int pm, pn, aux; };

__device__ __forceinline__ bool static_tile(int nM, int nN, int G, int c, int i, int& pm, int& pn) {
    const int nwg = nM * nN; const long L = (long)i * G + c; if (L >= nwg) return false;
    int wgid = (int)L; { const int q = nwg / NXCD, r = nwg % NXCD, xcd = wgid % NXCD, off = wgid / NXCD; wgid = (xcd < r ? xcd * (q + 1) : r * (q + 1) + (xcd - r) * q) + off; }
    const int nig = WGM * nN, gid = wgid / nig, fm = gid * WGM, gsz = (nM - fm) < WGM ? (nM - fm) : WGM;
    pm = fm + ((wgid % nig) % gsz); pn = (wgid % nig) / gsz; return true;
}

template <class Epi, class Sched, bool GATHER>
__device__ __forceinline__ void gemm_run(LAS unsigned char* lds, const int K, const Sched& S, const Epi& E) {
    const int tid = tid_opaque(), wid = __builtin_amdgcn_readfirstlane(tid >> 6), lane = tid & 63, wr = wid >> 2, wc = wid & 3, fr = lane & 15, fq = lane >> 4;
    const int nt = K / BK;
    int Rr[2]; unsigned colb[2], voffB[2];
#pragma unroll
    for (int i = 0; i < 2; ++i) { int R, C; stage_rc(tid * 16 + i * 8192, R, C); const int Rb = Epi::brow(R);
        Rr[i] = R; colb[i] = (unsigned)C * 2u; voffB[i] = (unsigned)(Rb * K + C) * 2u; }
    const size_t kstep = (size_t)(BK * 2);
    const size_t hstep = (size_t)Epi::BHALF * K * 2;
    const unsigned ldsw = (unsigned)wid * 1024u;
    const int aoff = lds_byte(wr * 64 + fr, fq * 8), boff = lds_byte(wc * 32 + fr, fq * 8);
#define PG8_SA(b, h) (((b) * 2 + (h)) * HTB)
#define PG8_SB(b, h) ((4 + (b) * 2 + (h)) * HTB)
#define PG8_STAGE(bufoff, gbase, voff) do { _Pragma("unroll") for (int _i = 0; _i < 2; ++_i) \
        __builtin_amdgcn_global_load_lds((const unsigned*)((const char*)(gbase) + (voff)[_i]), (LAS unsigned*)(lds + (bufoff) + ldsw + _i * 8192), 16, 0, 0); } while (0)
#define PG8_LDA(dst, b, h) do { _Pragma("unroll") for (int m = 0; m < 4; ++m) _Pragma("unroll") for (int k = 0; k < 2; ++k) dst[m][k] = *(const LAS bf16x8*)(lds + PG8_SA(b, h) + aoff + m * 2048 + k * 1024); } while (0)
#define PG8_LDB(dst, b, h) do { _Pragma("unroll") for (int n = 0; n < 2; ++n) _Pragma("unroll") for (int k = 0; k < 2; ++k) dst[n][k] = *(const LAS bf16x8*)(lds + PG8_SB(b, h) + boff + n * 2048 + k * 1024); } while (0)
#define PG8_MMA(ai, bj, At, Bt) do { __builtin_amdgcn_s_setprio(1); _Pragma("unroll") for (int m = 0; m < 4; ++m) _Pragma("unroll") for (int n = 0; n < 2; ++n) _Pragma("unroll") for (int k = 0; k < 2; ++k) \
        acc[ai][bj][m][n] = __builtin_amdgcn_mfma_f32_16x16x32_bf16(Bt[n][k], At[m][k], acc[ai][bj][m][n], 0, 0, 0); __builtin_amdgcn_s_setprio(0); } while (0)
#define PG8_WAIT_V(n) asm volatile("s_waitcnt vmcnt(" #n ")" ::: "memory")
#define PG8_WAIT_L(n) asm volatile("s_waitcnt lgkmcnt(" #n ")" ::: "memory")
#define PG8_BAR __builtin_amdgcn_s_barrier()
#define PG8_SCHED __builtin_amdgcn_sched_barrier(0)
#define PG8_AOFF(o, u) do { _Pragma("unroll") for (int _h = 0; _h < 2; ++_h) _Pragma("unroll") for (int _i = 0; _i < 2; ++_i) { \
        const int _r = Rr[_i] + HALF * _h; const unsigned _row = GATHER ? (unsigned)S.arow(u, _r) : (unsigned)_r; o[_h][_i] = _row * (unsigned)(K * 2) + colb[_i]; } } while (0)
    Unit cur, nxt; int ui = 0;
    if (!S.next(0, cur)) return;
    f32x4 acc[2][2][4][2];
#pragma unroll
    for (int a = 0; a < 2; ++a)
#pragma unroll
        for (int b = 0; b < 2; ++b)
#pragma unroll
            for (int m = 0; m < 4; ++m)
#pragma unroll
                for (int n = 0; n < 2; ++n) acc[a][b][m][n] = (f32x4){0.f, 0.f, 0.f, 0.f};
    bf16x8 At[4][2], B0[2][2], B1[2][2];
    unsigned oA[2][2], nOA[2][2];
    const char* cA = cur.A; const char* cB = cur.B;
    PG8_AOFF(oA, cur);
#pragma unroll
    for (int h = 0; h < 2; ++h)
#pragma unroll
        for (int i = 0; i < 2; ++i) nOA[h][i] = oA[h][i];
    PG8_STAGE(PG8_SB(0, 0), cB, voffB); PG8_STAGE(PG8_SB(0, 1), cB + hstep, voffB); PG8_STAGE(PG8_SA(0, 0), cA, oA[0]); PG8_STAGE(PG8_SA(0, 1), cA, oA[1]);
    if (wr == 1) PG8_BAR;
    PG8_WAIT_V(2); PG8_BAR;
    PG8_STAGE(PG8_SB(1, 0), cB + kstep, voffB); PG8_STAGE(PG8_SA(1, 0), cA + kstep, oA[0]); PG8_STAGE(PG8_SB(1, 1), cB + hstep + kstep, voffB);
    PG8_WAIT_V(6); PG8_BAR;
    for (;;) {
        const bool has_next = S.next(ui + 1, nxt);
        const char* nA = has_next ? nxt.A : cA; const char* nB = has_next ? nxt.B : cB;
        if (GATHER) { if (has_next) { PG8_AOFF(nOA, nxt); } }
        for (int t = 0; t < nt; t += 2) {
            const bool last = (t == nt - 2);
            const char* a1 = cA + (size_t)(t + 1) * kstep;
            const char* a2 = last ? nA : cA + (size_t)(t + 2) * kstep; const char* b2 = last ? nB : cB + (size_t)(t + 2) * kstep;
            const char* a3 = a2 + kstep; const char* b3 = b2 + kstep;
            unsigned o2[2][2];
#pragma unroll
            for (int h = 0; h < 2; ++h)
#pragma unroll
                for (int i = 0; i < 2; ++i) o2[h][i] = (GATHER && last) ? nOA[h][i] : oA[h][i];
            PG8_LDB(B0, 0, 0); PG8_LDB(B1, 0, 1); PG8_SCHED; PG8_LDA(At, 0, 0); PG8_STAGE(PG8_SA(1, 1), a1, oA[1]);
            PG8_WAIT_V(8); PG8_WAIT_L(0); PG8_BAR; PG8_MMA(0, 0, At, B0); PG8_MMA(0, 1, At, B1); PG8_BAR; PG8_SCHED;
            PG8_LDA(At, 0, 1); PG8_STAGE(PG8_SB(0, 0), b2, voffB); PG8_STAGE(PG8_SB(0, 1), b2 + hstep, voffB); PG8_STAGE(PG8_SA(0, 0), a2, o2[0]);
            PG8_WAIT_V(8); PG8_WAIT_L(0); PG8_BAR; PG8_MMA(1, 0, At, B0); PG8_MMA(1, 1, At, B1); PG8_BAR; PG8_SCHED;
            PG8_LDB(B0, 1, 0); PG8_LDB(B1, 1, 1); PG8_SCHED; PG8_LDA(At, 1, 0); PG8_STAGE(PG8_SA(0, 1), a2, o2[1]);
            PG8_WAIT_V(8); PG8_WAIT_L(0); PG8_BAR; PG8_MMA(0, 0, At, B0); PG8_MMA(0, 1, At, B1); PG8_BAR; PG8_SCHED;
            PG8_LDA(At, 1, 1); PG8_STAGE(PG8_SB(1, 0), b3, voffB); PG8_STAGE(PG8_SB(1, 1), b3 + hstep, voffB); PG8_STAGE(PG8_SA(1, 0), a3, o2[0]);
            PG8_WAIT_V(8); PG8_WAIT_L(0); PG8_BAR; PG8_MMA(1, 0, At, B0); PG8_MMA(1, 1, At, B1); PG8_BAR; PG8_SCHED;
        }
        if (wr == 0) PG8_BAR;
        const bool keep = E(acc, cur, wr, wc, fr, fq);
        if (!has_next) break;
        if (!keep) {
#pragma unroll
            for (int a = 0; a < 2; ++a)
#pragma unroll
                for (int b = 0; b < 2; ++b)
#pragma unroll
                    for (int m = 0; m < 4; ++m)
#pragma unroll
                        for (int n = 0; n < 2; ++n) acc[a][b][m][n] = (f32x4){0.f, 0.f, 0.f, 0.f};
        }
        cur = nxt; cA = nA; cB = nB; ++ui;
        if (GATHER) {
#pragma unroll
            for (int h = 0; h < 2; ++h)
#pragma unroll
                for (int i = 0; i < 2; ++i) oA[h][i] = nOA[h][i];
        }
        if (wr == 1) PG8_BAR;
    }
    PG8_WAIT_V(0);
    PG8_BAR;
#undef PG8_SA
#undef PG8_SB
#undef PG8_STAGE
#undef PG8_LDA
#undef PG8_LDB
#undef PG8_MMA
#undef PG8_WAIT_V
#undef PG8_WAIT_L
#undef PG8_BAR
#undef PG8_SCHED
#undef PG8_AOFF
}
}
template <class RowMap>
__device__ __forceinline__ void transpose_item(const float* W, int K, int ld, bf16_t* WT, RowMap rowmap, LAS float* scr, int kb, int nb, int lane) {
    const int k0 = 64 * kb, n0 = 32 * nb;
#pragma unroll 8
    for (int i = 0; i < 32; ++i) { const int kk = 2 * i + (lane >> 5); scr[kk * 33 + (lane & 31)] = W[(size_t)(k0 + kk) * ld + n0 + (lane & 31)]; }
    asm volatile("s_waitcnt lgkmcnt(0)" ::: "memory");
    const int c = lane & 7;
#pragma unroll
    for (int j = 0; j < 4; ++j) { const int n = (lane >> 3) + 8 * j; const LAS float* s = scr + (8 * c) * 33 + n;
        u32x4 o; o.x = cvt_pk_bf16(s[0 * 33], s[1 * 33]); o.y = cvt_pk_bf16(s[2 * 33], s[3 * 33]); o.z = cvt_pk_bf16(s[4 * 33], s[5 * 33]); o.w = cvt_pk_bf16(s[6 * 33], s[7 * 33]);
        *(u32x4*)(WT + (size_t)rowmap(n0 + n) * K + k0 + 8 * c) = o; }
    asm volatile("s_waitcnt lgkmcnt(0)" ::: "memory");
}
template <class RowMap>
__device__ __forceinline__ void transpose_item64(const float* W, int K, int ld, bf16_t* WT, RowMap rowmap, LAS float* scr, int kb, int nb, int lane) {
    const int k0 = 64 * kb, n0 = 64 * nb, lr = lane >> 4, lc = (lane & 15) * 4;
    f32x4 v[16];
#pragma unroll
    for (int i = 0; i < 16; ++i) v[i] = *(const f32x4*)(W + (size_t)(k0 + 4 * i + lr) * ld + n0 + lc);
#pragma unroll
    for (int i = 0; i < 16; ++i) { LAS float* d = scr + (4 * i + lr) * 65 + lc; d[0] = v[i].x; d[1] = v[i].y; d[2] = v[i].z; d[3] = v[i].w; }
    asm volatile("s_waitcnt lgkmcnt(0)" ::: "memory");
    const int c = lane & 7;
#pragma unroll
    for (int j = 0; j < 8; ++j) { const int n = (lane >> 3) + 8 * j; const LAS float* s = scr + (8 * c) * 65 + n;
        u32x4 o; o.x = cvt_pk_bf16(s[0 * 65], s[1 * 65]); o.y = cvt_pk_bf16(s[2 * 65], s[3 * 65]); o.z = cvt_pk_bf16(s[4 * 65], s[5 * 65]); o.w = cvt_pk_bf16(s[6 * 65], s[7 * 65]);
        *(u32x4*)(WT + (size_t)rowmap(n0 + n) * K + k0 + 8 * c) = o; }
    asm volatile("s_waitcnt lgkmcnt(0)" ::: "memory");
}
struct RowId { int off; __device__ __forceinline__ int operator()(int n) const { return off + n; } };
struct RowUp { int which; __device__ __forceinline__ int operator()(int n) const { return 256 * (n >> 7) + 128 * which + (n & 127); } };

__device__ __forceinline__ void p0_prologue(LAS unsigned char* lds, const float* const* in, unsigned char* ws, int G) {
    const int tid = tid_opaque(), lane = tid & 63, wave = __builtin_amdgcn_readfirstlane(tid >> 6);
    const int gw = blockIdx.x * NWAVES + wave, NGW = G * NWAVES;
    LAS float* scr = (LAS float*)(lds + wave * 16640);
    const float* w_in = in[2]; const float* w_da = in[15]; const float* w_ml = in[16]; const float* w_gate = in[17]; const float* w_out = in[19];
    bf16_t* WinT = (bf16_t*)(ws + WS_WIN); bf16_t* WdaT = (bf16_t*)(ws + WS_WDA); bf16_t* WmlT = (bf16_t*)(ws + WS_WML); bf16_t* WoutT = (bf16_t*)(ws + WS_WOUT);
    constexpr int I_IN = 16 * (3584 / 64), I_G = 16 * (2048 / 64), I_DA = 8 * (1024 / 64), I_ML = I_DA, I_OUT = 16 * (1024 / 64);
    constexpr int NITEMS = I_IN + I_G + I_DA + I_ML + I_OUT;
    for (int it = gw; it < NITEMS; it += NGW) {
        int r = it;
        if (r < I_IN) { transpose_item64(w_in, 1024, IN_W, WinT, RowId{0}, scr, r / 56, r % 56, lane); continue; } r -= I_IN;
        if (r < I_G) { transpose_item64(w_gate, 1024, 2048, WinT, RowId{3584}, scr, r / 32, r % 32, lane); continue; } r -= I_G;
        if (r < I_DA) { transpose_item64(w_da, 512, 1024, WdaT, RowId{0}, scr, r / 16, r % 16, lane); continue; } r -= I_DA;
        if (r < I_ML) { transpose_item64(w_ml, 512, 1024, WmlT, RowId{0}, scr, r / 16, r % 16, lane); continue; } r -= I_ML;
        transpose_item64(w_out, 1024, 1024, WoutT, RowId{0}, scr, r / 16, r % 16, lane);
    }
    __syncthreads();
    LAS float* wif = (LAS float*)lds;
    for (int i = tid; i < 8192; i += NTHREADS) { const int d = i >> 3, j = i & 7; wif[j * 1024 + d] = w_in[(size_t)d * IN_W + 3584 + j]; }
    __syncthreads();
    const float* x = in[0]; const float* g = in[1]; const float* ib = in[12]; const float* fb = in[13];
    bf16_t* HB = (bf16_t*)(ws + WS_HB); float* IFP = (float*)(ws + WS_IFP);
    f32x4 gv[4];
#pragma unroll
    for (int j = 0; j < 4; ++j) gv[j] = *(const f32x4*)(g + lane * 4 + 256 * j);
    for (int row = gw; row < T; row += NGW) {
        const f32x4* xr = (const f32x4*)(x + (size_t)row * D) + lane;
        f32x4 v[4]; float s = 0.f;
#pragma unroll
        for (int j = 0; j < 4; ++j) { v[j] = xr[64 * j]; s += (v[j].x * v[j].x + v[j].y * v[j].y) + (v[j].z * v[j].z + v[j].w * v[j].w); }
        const float rstd = 1.0f / sqrtf(wave_sum(s) * (1.f / D) + NORM_EPS);
        unsigned long long* o8 = (unsigned long long*)(HB + (size_t)row * D) + lane;
#pragma unroll
        for (int j = 0; j < 4; ++j) { v[j] = v[j] * rstd * gv[j];
            o8[64 * j] = (unsigned long long)cvt_pk_bf16(v[j].x, v[j].y) | ((unsigned long long)cvt_pk_bf16(v[j].z, v[j].w) << 32); }
        float dsum[8];
#pragma unroll
        for (int c = 0; c < 8; ++c) { float a = 0.f;
#pragma unroll
            for (int j = 0; j < 4; ++j) { const f32x4 w = *(const LAS f32x4*)(wif + c * 1024 + lane * 4 + 256 * j); a += (v[j].x * w.x + v[j].y * w.y) + (v[j].z * w.z + v[j].w * w.w); }
            dsum[c] = wave_sum(a); }
        if (lane < 8) {
            float val = 0.f;
#pragma unroll
            for (int c = 0; c < 8; ++c) val = (lane == c) ? dsum[c] : val;
            if (lane < 4) val += ib[lane];
            else { const float z = val + fb[lane - 4]; val = fminf(z, 0.f) - log1pf(__expf(-fabsf(z))); }
            IFP[(size_t)row * 8 + lane] = val;
        }
    }
}

__device__ __forceinline__ void moe_weight_convert(LAS unsigned char* lds, const float* const* in, unsigned char* ws, int G) {
    const int tid = tid_opaque(), lane = tid & 63, wave = __builtin_amdgcn_readfirstlane(tid >> 6);
    const int gw = blockIdx.x * NWAVES + wave, NGW = G * NWAVES;
    LAS float* scr = (LAS float*)(lds + wave * 16640);
    const float* w1 = in[25]; const float* w3 = in[26]; const float* w2 = in[27];
    bf16_t* W13 = (bf16_t*)(ws + WS_W13); bf16_t* W2T = (bf16_t*)(ws + WS_W2);
    constexpr int I_UP = 16 * 8;
    constexpr int I_DN = 8 * 16;
    constexpr int NIT = NEXP * (2 * I_UP + I_DN);
    for (int it = gw; it < NIT; it += NGW) {
        const int e = it / (2 * I_UP + I_DN); int r = it % (2 * I_UP + I_DN);
        if (r < I_UP) { transpose_item64(w1 + (size_t)e * 1024 * 512, 1024, 512, W13 + (size_t)e * 1024 * 1024, RowUp{0}, scr, r / 8, r % 8, lane); continue; } r -= I_UP;
        if (r < I_UP) { transpose_item64(w3 + (size_t)e * 1024 * 512, 1024, 512, W13 + (size_t)e * 1024 * 1024, RowUp{1}, scr, r / 8, r % 8, lane); continue; } r -= I_UP;
        transpose_item64(w2 + (size_t)e * 512 * 1024, 512, 1024, W2T + (size_t)e * 1024 * 512, RowId{0}, scr, r / 16, r % 16, lane);
    }
}

__device__ __forceinline__ void da_qk_norm(unsigned char* ws, const float* gq, const float* gk, int G) {
    const int tid = tid_opaque(), lane = tid & 63, wave = __builtin_amdgcn_readfirstlane(tid >> 6);
    const int gw = blockIdx.x * NWAVES + wave, NGW = G * NWAVES;
    bf16_t* P = (bf16_t*)(ws + WS_P);
    const bool isq = lane < 32; const float* gsrc = (isq ? gq : gk) + (lane & 3) * 16; const float extra = isq ? (0.125f * LOG2E) : 1.0f;
    float gn[16];
#pragma unroll
    for (int i = 0; i < 16; ++i) gn[i] = gsrc[i] * extra;
    for (int row = gw; row < T; row += NGW) {
        u32x4* p = (u32x4*)(P + (size_t)row * PW + lane * 16);
        const u32x4 a = p[0], b = p[1];
        float v[16];
        v[0] = bf_lo(a.x); v[1] = bf_hi(a.x); v[2] = bf_lo(a.y); v[3] = bf_hi(a.y); v[4] = bf_lo(a.z); v[5] = bf_hi(a.z); v[6] = bf_lo(a.w); v[7] = bf_hi(a.w);
        v[8] = bf_lo(b.x); v[9] = bf_hi(b.x); v[10] = bf_lo(b.y); v[11] = bf_hi(b.y); v[12] = bf_lo(b.z); v[13] = bf_hi(b.z); v[14] = bf_lo(b.w); v[15] = bf_hi(b.w);
        float s = 0.f;
#pragma unroll
        for (int i = 0; i < 16; ++i) s += v[i] * v[i];
        s += __shfl_xor(s, 1); s += __shfl_xor(s, 2);
        const float rstd = 1.0f / sqrtf(s * (1.f / 64.f) + NORM_EPS);
#pragma unroll
        for (int i = 0; i < 16; ++i) v[i] = v[i] * rstd * gn[i];
        u32x4 oa, ob;
        oa.x = cvt_pk_bf16(v[0], v[1]); oa.y = cvt_pk_bf16(v[2], v[3]); oa.z = cvt_pk_bf16(v[4], v[5]); oa.w = cvt_pk_bf16(v[6], v[7]);
        ob.x = cvt_pk_bf16(v[8], v[9]); ob.y = cvt_pk_bf16(v[10], v[11]); ob.z = cvt_pk_bf16(v[12], v[13]); ob.w = cvt_pk_bf16(v[14], v[15]);
        p[0] = oa; p[1] = ob;
    }
}
typedef short v4i16_t __attribute__((ext_vector_type(4)));
constexpr int AT_KSTR = 1040;
constexpr int AT_KBUF = 16 * AT_KSTR;
constexpr int AT_QSTR = 528, AT_QBUF = 16 * AT_QSTR;
constexpr int AT_KOFF = 0, AT_VOFF = 2 * AT_KBUF, AT_QOFF = AT_VOFF + 2 * 16384;
static_assert(AT_QOFF + 8 * AT_QBUF <= LDS_MISC_OFF, "attention LDS");
__device__ __forceinline__ int crow(int r, int hi) { return (r & 3) + 8 * (r >> 2) + 4 * hi; }
__device__ __forceinline__ int v_off(int row, int ch) { return 2048 * (row >> 3) + 512 * (ch >> 2) + 64 * (row & 7) + 16 * ((ch & 3) ^ ((row >> 2) & 3)); }

__device__ __forceinline__ void attn_unit(LAS unsigned char* lds, const bf16_t* P, bf16_t* YDA, int b, int h, int qb, float lam, float mref, float slope2, const float* gout) {
    const int tid = tid_opaque(), lane = tid & 63, r32 = lane & 31, hh = lane >> 5, wid = __builtin_amdgcn_readfirstlane(tid >> 6);
    const int rowbase = b * SEQ;
    const int q0 = qb * 256 + wid * 32;
    const int qpos = q0 + r32;
    LAS unsigned char* Qw = lds + AT_QOFF + wid * AT_QBUF;
    const __amdgpu_buffer_rsrc_t prs = __builtin_amdgcn_make_buffer_rsrc((void*)P, 0, (int)0x7fffffff, 0x00020000);
    const int pbase = (rowbase * PW + h * 128) * 2;
    { const int qo = ((lane >> 4) * PW + PC_Q + (lane & 15) * 8) * 2;
#pragma unroll
      for (int i = 0; i < 8; ++i) { const int r = (lane >> 4) + 4 * i; const u32x4 v = __builtin_amdgcn_raw_buffer_load_b128(prs, qo, pbase + (q0 + 4 * i) * PW * 2, 0);
          *(LAS u32x4*)(Qw + (lane & 15) * AT_QSTR + r * 16) = v; } }
    const LAS unsigned char* qrd = Qw + hh * AT_QSTR + r32 * 16;
    f32x16 o1[4], o2[4];
#pragma unroll
    for (int t = 0; t < 4; ++t) { o1[t] = f32x16{}; o2[t] = f32x16{}; }
    float l1 = 0.f, l2 = 0.f;
    const int ntiles = 4 * qb + 4;
    const int sch = tid & 15;
    unsigned kdst[2], vdst[2]; int goff[2];
#pragma unroll
    for (int i = 0; i < 2; ++i) { const int r = (tid >> 4) + 32 * i; goff[i] = (r * PW + PC_K + sch * 8) * 2;
        kdst[i] = (unsigned)(sch * AT_KSTR + r * 16);
        vdst[i] = (unsigned)v_off(r, sch); }
    u32x4 kreg[2], vreg[2];
#define AT_LOADT(kt) do { const int _so = pbase + (kt) * 64 * PW * 2; _Pragma("unroll") for (int _i = 0; _i < 2; ++_i) { \
        kreg[_i] = __builtin_amdgcn_raw_buffer_load_b128(prs, goff[_i], _so, 0); vreg[_i] = __builtin_amdgcn_raw_buffer_load_b128(prs, goff[_i] + (PC_V - PC_K) * 2, _so, 0); } } while (0)
#define AT_WRITET(buf) do { _Pragma("unroll") for (int _i = 0; _i < 2; ++_i) { \
        *(LAS u32x4*)(lds + AT_KOFF + (buf) * AT_KBUF + kdst[_i]) = kreg[_i]; *(LAS u32x4*)(lds + AT_VOFF + (buf) * 16384 + vdst[_i]) = vreg[_i]; } } while (0)
    AT_LOADT(ntiles - 1); AT_WRITET(0); __syncthreads();
    const int tg = lane >> 4, tq = (lane >> 2) & 3, tp = lane & 3;
    const int vlo = 64 * (4 * hh + tq) + 16 * ((2 * (tg & 1) + (tp >> 1)) ^ hh) + 8 * (tp & 1);
    const int vhi = 64 * (4 * hh + tq) + 16 * ((2 * (tg & 1) + (tp >> 1)) ^ (hh + 2)) + 8 * (tp & 1);
    const int klane = hh * AT_KSTR + r32 * 16;
    for (int it = 0; it < ntiles; ++it) {
        const int kt = ntiles - 1 - it, cur = it & 1;
        if (it + 1 < ntiles) AT_LOADT(kt - 1);
        const int kb0 = kt * 64;
        const LAS unsigned char* Kb = lds + AT_KOFF + cur * AT_KBUF + klane;
        const LAS unsigned char* Vlo = lds + AT_VOFF + cur * 16384 + vlo;
        const LAS unsigned char* Vhi = lds + AT_VOFF + cur * 16384 + vhi;
#pragma unroll
        for (int sb = 0; sb < 2; ++sb) {
            const int kb = kb0 + 32 * sb;
            if (kb <= q0 + 31) {
                const float base = slope2 * (float)(kb + 4 * hh - qpos) - mref;
                bf16x8 pf1[2], pf2[2];
#pragma unroll
                for (int mp = 0; mp < 2; ++mp) {
                    f32x16 sc;
#pragma unroll
                    for (int r = 0; r < 16; ++r) sc[r] = __builtin_fmaf(slope2, (float)((r & 3) + 8 * (r >> 2)), base);
#pragma unroll
                    for (int dd = 0; dd < 4; ++dd) {
                        const bf16x8 ka = *(const LAS bf16x8*)(Kb + (mp * 8 + dd * 2) * AT_KSTR + sb * 512);
                        const bf16x8 qa = *(const LAS bf16x8*)(qrd + (mp * 8 + dd * 2) * AT_QSTR);
                        sc = __builtin_amdgcn_mfma_f32_32x32x16_bf16(ka, qa, sc, 0, 0, 0);
                    }
                    if (kb + 31 > q0) {
#pragma unroll
                        for (int r = 0; r < 16; ++r) { const bool dead = (kb + crow(r, hh)) > qpos; sc[r] = dead ? -INFINITY : sc[r]; }
                    }
                    float ls = 0.f;
#pragma unroll
                    for (int r = 0; r < 16; ++r) { sc[r] = __builtin_amdgcn_exp2f(sc[r]); ls += sc[r]; }
#pragma unroll
                    for (int s = 0; s < 2; ++s) {
                        u32x4 w;
                        w.x = cvt_pk_bf16(sc[8 * s + 0], sc[8 * s + 1]); w.y = cvt_pk_bf16(sc[8 * s + 2], sc[8 * s + 3]); w.z = cvt_pk_bf16(sc[8 * s + 4], sc[8 * s + 5]); w.w = cvt_pk_bf16(sc[8 * s + 6], sc[8 * s + 7]);
                        if (mp == 0) pf1[s] = __builtin_bit_cast(bf16x8, w); else pf2[s] = __builtin_bit_cast(bf16x8, w);
                    }
                    if (mp == 0) l1 += ls; else l2 += ls;
                }
#pragma unroll
                for (int s = 0; s < 2; ++s) {
#pragma unroll
                    for (int t = 0; t < 4; ++t) {
                        const s16x4 lo = __builtin_bit_cast(s16x4, __builtin_amdgcn_ds_read_tr16_b64_v4i16((LAS v4i16_t*)(Vlo + 2048 * (4 * sb + 2 * s) + 512 * t)));
                        const s16x4 hi = __builtin_bit_cast(s16x4, __builtin_amdgcn_ds_read_tr16_b64_v4i16((LAS v4i16_t*)(Vhi + 2048 * (4 * sb + 2 * s + 1) + 512 * t)));
                        const bf16x8 vf = (bf16x8){lo[0], lo[1], lo[2], lo[3], hi[0], hi[1], hi[2], hi[3]};
                        o1[t] = __builtin_amdgcn_mfma_f32_32x32x16_bf16(vf, pf1[s], o1[t], 0, 0, 0);
                        o2[t] = __builtin_amdgcn_mfma_f32_32x32x16_bf16(vf, pf2[s], o2[t], 0, 0, 0);
                    }
                }
            }
        }
        if (it + 1 < ntiles) AT_WRITET(cur ^ 1);
        __syncthreads();
    }
#undef AT_LOADT
#undef AT_WRITET
    l1 += __shfl_xor(l1, 32); l2 += __shfl_xor(l2, 32);
    const float inv1 = 1.0f / l1, c2 = lam / l2;
    float ss = 0.f;
#pragma unroll
    for (int t = 0; t < 4; ++t)
#pragma unroll
        for (int r = 0; r < 16; ++r) { const float v = o1[t][r] * inv1 - o2[t][r] * c2; o1[t][r] = v; ss += v * v; }
    ss += __shfl_xor(ss, 32);
    const float rstd = 0.8f / sqrtf(ss * (1.f / 128.f) + NORM_EPS);
    bf16_t* yrow = YDA + (size_t)(rowbase + qpos) * 512 + h * 128 + 4 * hh;
#pragma unroll
    for (int t = 0; t < 4; ++t)
#pragma unroll
        for (int g4 = 0; g4 < 4; ++g4) {
            const f32x4 gv = *(const f32x4*)(gout + 32 * t + 8 * g4 + 4 * hh);
            u32x2 w; w.x = cvt_pk_bf16(o1[t][4 * g4 + 0] * rstd * gv.x, o1[t][4 * g4 + 1] * rstd * gv.y); w.y = cvt_pk_bf16(o1[t][4 * g4 + 2] * rstd * gv.z, o1[t][4 * g4 + 3] * rstd * gv.w);
            *(u32x2*)(yrow + 32 * t + 8 * g4) = w;
        }
}

__device__ __forceinline__ void attn_phase(LAS unsigned char* lds, const float* const* in, unsigned char* ws, int G) {
    const bf16_t* P = (const bf16_t*)(ws + WS_P); bf16_t* YDA = (bf16_t*)(ws + WS_YDA);
    const float* gq = in[3]; const float* gk = in[4]; const float* lq1 = in[5]; const float* lk1 = in[6]; const float* lq2 = in[7]; const float* lk2 = in[8]; const float* gout = in[9];
    float mq = 0.f, mk = 0.f, a1 = 0.f, a2 = 0.f;
    for (int i = 0; i < 64; ++i) { mq = fmaxf(mq, fabsf(gq[i])); mk = fmaxf(mk, fabsf(gk[i])); a1 += lq1[i] * lk1[i]; a2 += lq2[i] * lk2[i]; }
    const float lam = __expf(a1) - __expf(a2) + 0.2f;
    const float mref = 8.0f * mq * mk * LOG2E * 1.02f + 0.25f;
    { const int w = blockIdx.x;
        const int bh = (w & 7) * 4 + ((w >> 3) & 3), j = w >> 5;
        const int b = bh >> 2, h = bh & 3;
        const float slope2 = exp2f(-2.0f * (float)(h + 1)) * LOG2E;
#pragma unroll 1
        for (int u2 = 0; u2 < 2; ++u2) attn_unit(lds, P, YDA, b, h, u2 ? j : 15 - j, lam, mref, slope2, gout);
    }
}
constexpr int ML_L = 256, ML_NC = SEQ / ML_L, ML_UNITS = NBATCH * 4 * ML_NC;
constexpr size_t MO_U = 0;
constexpr size_t MO_NL = MO_U + (size_t)ML_UNITS * 16384 * 4;
constexpr size_t MO_GU = MO_NL + (size_t)ML_UNITS * 128 * 4;
constexpr size_t MO_C = MO_GU + (size_t)ML_UNITS * 2 * 4;
constexpr size_t MO_N = MO_C + (size_t)ML_UNITS * 16384 * 2;
constexpr size_t MO_M = MO_N + (size_t)ML_UNITS * 128 * 4;
constexpr size_t MO_END = MO_M + (size_t)ML_UNITS * 4;
static_assert(MO_END <= (size_t)T * D * 4, "mLSTM scratch must fit the output buffer");

__device__ __forceinline__ u32x4 ml_conv8(const bf16_t* P, size_t t, int pos, int ch, const float* cw, const float* cb, float scale) {
    float acc[8];
    { const f32x4 b0 = *(const f32x4*)(cb + ch), b1 = *(const f32x4*)(cb + ch + 4);
      acc[0] = b0.x; acc[1] = b0.y; acc[2] = b0.z; acc[3] = b0.w; acc[4] = b1.x; acc[5] = b1.y; acc[6] = b1.z; acc[7] = b1.w; }
#pragma unroll
    for (int j = 0; j < 4; ++j) {
        if (pos - 3 + j >= 0) {
            const u32x4 u = *(const u32x4*)(P + (t - 3 + j) * PW + PC_MQ + ch);
            const f32x4 w0 = *(const f32x4*)(cw + j * 1024 + ch), w1 = *(const f32x4*)(cw + j * 1024 + ch + 4);
            acc[0] += bf_lo(u.x) * w0.x; acc[1] += bf_hi(u.x) * w0.y; acc[2] += bf_lo(u.y) * w0.z; acc[3] += bf_hi(u.y) * w0.w;
            acc[4] += bf_lo(u.z) * w1.x; acc[5] += bf_hi(u.z) * w1.y; acc[6] += bf_lo(u.w) * w1.z; acc[7] += bf_hi(u.w) * w1.w;
        }
    }
#pragma unroll
    for (int e = 0; e < 8; ++e) acc[e] = acc[e] * fast_sigmoid(acc[e]) * scale;
    u32x4 o; o.x = cvt_pk_bf16(acc[0], acc[1]); o.y = cvt_pk_bf16(acc[2], acc[3]); o.z = cvt_pk_bf16(acc[4], acc[5]); o.w = cvt_pk_bf16(acc[6], acc[7]);
    return o;
}

__device__ __forceinline__ void ml_gate_scan(const float* IFP, int t0, int h, int lane, LAS float* ga, LAS float* gz, LAS float* gp) {
    float f[4], iv[4];
#pragma unroll
    for (int j = 0; j < 4; ++j) { const float* r = IFP + (size_t)(t0 + 4 * lane + j) * 8; iv[j] = r[h]; f[j] = r[4 + h]; }
    float c[4]; c[0] = f[0]; c[1] = c[0] + f[1]; c[2] = c[1] + f[2]; c[3] = c[2] + f[3];
    float incl = c[3];
#pragma unroll
    for (int o = 1; o < 64; o <<= 1) { const float v = __shfl_up(incl, o); if (lane >= o) incl += v; }
    const float excl = incl - c[3];
    float a[4], z[4], p[4];
#pragma unroll
    for (int j = 0; j < 4; ++j) { a[j] = excl + c[j]; z[j] = iv[j] - a[j]; }
    p[0] = z[0]; p[1] = fmaxf(p[0], z[1]); p[2] = fmaxf(p[1], z[2]); p[3] = fmaxf(p[2], z[3]);
    float pin = p[3];
#pragma unroll
    for (int o = 1; o < 64; o <<= 1) { const float v = __shfl_up(pin, o); if (lane >= o) pin = fmaxf(pin, v); }
    float pex = __shfl_up(pin, 1); if (lane == 0) pex = -INFINITY;
    *(LAS f32x4*)(ga + 4 * lane) = (f32x4){a[0], a[1], a[2], a[3]};
    *(LAS f32x4*)(gz + 4 * lane) = (f32x4){z[0], z[1], z[2], z[3]};
    *(LAS f32x4*)(gp + 4 * lane) = (f32x4){fmaxf(pex, p[0]), fmaxf(pex, p[1]), fmaxf(pex, p[2]), fmaxf(pex, p[3])};
}

constexpr int MLK_STR = 256 * 16 + 16;
constexpr int MLL_K = 0;
constexpr int MLL_V = 16 * MLK_STR;
constexpr int MLL_G = MLL_V + 65536;
constexpr int MLL_END = MLL_G + 3 * 1024;
static_assert(MLL_END <= LDS_MISC_OFF, "mLSTM LDS");

__device__ __forceinline__ void ml_state_unit(LAS unsigned char* lds, unsigned char* ws, unsigned char* mo, const float* cw, const float* cb, int unit) {
    const int tid = tid_opaque(), lane = tid & 63, r32 = lane & 31, hh = lane >> 5, wid = __builtin_amdgcn_readfirstlane(tid >> 6);
    const int bh = unit >> 4, c = unit & 15, b = bh >> 2, h = bh & 3, t0 = b * SEQ + c * ML_L;
    const float* IFP = (const float*)(ws + WS_IFP); const bf16_t* P = (const bf16_t*)(ws + WS_P); bf16_t* MLQK = (bf16_t*)(ws + WS_MLQK);
    LAS float* ga = (LAS float*)(lds + MLL_G); LAS float* gz = ga + 256; LAS float* gp = gz + 256;
    if (wid == 0) ml_gate_scan(IFP, t0, h, lane, ga, gz, gp);
    __syncthreads();
    const float g = ga[255], pmL = gp[255];
    if (tid == 0) { float* gu = (float*)(mo + MO_GU) + unit * 2; gu[0] = g; gu[1] = g + pmL; }
    const int sch = tid & 15;
#pragma unroll 2
    for (int i = 0; i < 8; ++i) { const int r = (tid >> 4) + 32 * i; const size_t t = (size_t)(t0 + r);
        const u32x4 q = ml_conv8(P, t, c * ML_L + r, h * 128 + sch * 8, cw, cb, 0.08838834764831845f);
        u32x4 k = ml_conv8(P, t, c * ML_L + r, 512 + h * 128 + sch * 8, cw, cb, 1.0f);
        const u32x4 v = *(const u32x4*)(P + t * PW + PC_MV + h * 128 + sch * 8);
        *(u32x4*)(MLQK + t * 1024 + h * 128 + sch * 8) = q; *(u32x4*)(MLQK + t * 1024 + 512 + h * 128 + sch * 8) = k;
        const float w = __builtin_amdgcn_exp2f((gz[r] - pmL) * LOG2E);
        k.x = cvt_pk_bf16(bf_lo(k.x) * w, bf_hi(k.x) * w); k.y = cvt_pk_bf16(bf_lo(k.y) * w, bf_hi(k.y) * w); k.z = cvt_pk_bf16(bf_lo(k.z) * w, bf_hi(k.z) * w); k.w = cvt_pk_bf16(bf_lo(k.w) * w, bf_hi(k.w) * w);
        *(LAS u32x4*)(lds + MLL_K + v_off(r, sch)) = k; *(LAS u32x4*)(lds + MLL_V + v_off(r, sch)) = v; }
    __syncthreads();
    const int et = wid & 3, dt0 = 2 * (wid >> 2);
    f32x16 acc0 = f32x16{}, acc1 = f32x16{}, accn0 = f32x16{}, accn1 = f32x16{};
    const int tg = lane >> 4, tq = (lane >> 2) & 3, tp = lane & 3;
    const int vlo = 64 * (4 * hh + tq) + 16 * ((2 * (tg & 1) + (tp >> 1)) ^ hh) + 8 * (tp & 1);
    const int vhi = 64 * (4 * hh + tq) + 16 * ((2 * (tg & 1) + (tp >> 1)) ^ (hh + 2)) + 8 * (tp & 1);
    const bf16x8 ones = (bf16x8){0x3F80, 0x3F80, 0x3F80, 0x3F80, 0x3F80, 0x3F80, 0x3F80, 0x3F80};
#pragma unroll 4
    for (int ks = 0; ks < 16; ++ks) {
        const int sub = 2048 * (2 * ks);
        const s16x4 vl = __builtin_bit_cast(s16x4, __builtin_amdgcn_ds_read_tr16_b64_v4i16((LAS v4i16_t*)(lds + MLL_V + vlo + sub + 512 * et)));
        const s16x4 vh = __builtin_bit_cast(s16x4, __builtin_amdgcn_ds_read_tr16_b64_v4i16((LAS v4i16_t*)(lds + MLL_V + vhi + sub + 2048 + 512 * et)));
        const bf16x8 vf = (bf16x8){vl[0], vl[1], vl[2], vl[3], vh[0], vh[1], vh[2], vh[3]};
        const s16x4 al = __builtin_bit_cast(s16x4, __builtin_amdgcn_ds_read_tr16_b64_v4i16((LAS v4i16_t*)(lds + MLL_K + vlo + sub + 512 * dt0)));
        const s16x4 ah = __builtin_bit_cast(s16x4, __builtin_amdgcn_ds_read_tr16_b64_v4i16((LAS v4i16_t*)(lds + MLL_K + vhi + sub + 2048 + 512 * dt0)));
        const bf16x8 af = (bf16x8){al[0], al[1], al[2], al[3], ah[0], ah[1], ah[2], ah[3]};
        const s16x4 bl = __builtin_bit_cast(s16x4, __builtin_amdgcn_ds_read_tr16_b64_v4i16((LAS v4i16_t*)(lds + MLL_K + vlo + sub + 512 * (dt0 + 1))));
        const s16x4 bhv = __builtin_bit_cast(s16x4, __builtin_amdgcn_ds_read_tr16_b64_v4i16((LAS v4i16_t*)(lds + MLL_K + vhi + sub + 2048 + 512 * (dt0 + 1))));
        const bf16x8 bf = (bf16x8){bl[0], bl[1], bl[2], bl[3], bhv[0], bhv[1], bhv[2], bhv[3]};
        acc0 = __builtin_amdgcn_mfma_f32_32x32x16_bf16(af, vf, acc0, 0, 0, 0);
        acc1 = __builtin_amdgcn_mfma_f32_32x32x16_bf16(bf, vf, acc1, 0, 0, 0);
        if (et == 0) { accn0 = __builtin_amdgcn_mfma_f32_32x32x16_bf16(af, ones, accn0, 0, 0, 0); accn1 = __builtin_amdgcn_mfma_f32_32x32x16_bf16(bf, ones, accn1, 0, 0, 0); }
    }
    float* U = (float*)(mo + MO_U) + (size_t)unit * 16384 + (size_t)(32 * et + r32) * 128;
#pragma unroll
    for (int g4 = 0; g4 < 4; ++g4) {
        *(f32x4*)(U + 32 * dt0 + 8 * g4 + 4 * hh) = (f32x4){acc0[4 * g4], acc0[4 * g4 + 1], acc0[4 * g4 + 2], acc0[4 * g4 + 3]};
        *(f32x4*)(U + 32 * (dt0 + 1) + 8 * g4 + 4 * hh) = (f32x4){acc1[4 * g4], acc1[4 * g4 + 1], acc1[4 * g4 + 2], acc1[4 * g4 + 3]};
    }
    if (et == 0 && r32 == 0) {
        float* NL = (float*)(mo + MO_NL) + (size_t)unit * 128;
#pragma unroll
        for (int g4 = 0; g4 < 4; ++g4) {
            *(f32x4*)(NL + 32 * dt0 + 8 * g4 + 4 * hh) = (f32x4){accn0[4 * g4], accn0[4 * g4 + 1], accn0[4 * g4 + 2], accn0[4 * g4 + 3]};
            *(f32x4*)(NL + 32 * (dt0 + 1) + 8 * g4 + 4 * hh) = (f32x4){accn1[4 * g4], accn1[4 * g4 + 1], accn1[4 * g4 + 2], accn1[4 * g4 + 3]};
        }
    }
    __syncthreads();
}

__device__ __forceinline__ void ml_scan_phase(unsigned char* mo, int G) {
    const int tid = tid_opaque();
    const float* GU = (const float*)(mo + MO_GU);
    for (int i = blockIdx.x * NTHREADS + tid; i < 32 * 4096; i += G * NTHREADS) {
        const int bh = i >> 12, e4 = i & 4095;
        const float* U = (const float*)(mo + MO_U) + (size_t)bh * 16 * 16384 + e4 * 4;
        bf16_t* C = (bf16_t*)(mo + MO_C) + (size_t)bh * 16 * 16384 + e4 * 4;
        f32x4 st = (f32x4){0.f, 0.f, 0.f, 0.f}; float m = 0.f;
#pragma unroll 5
        for (int c = 0; c < 15; ++c) {
            const float g = GU[(bh * 16 + c) * 2], u = GU[(bh * 16 + c) * 2 + 1];
            const float mn = fmaxf(g + m, u), dec = __expf(g + m - mn), sc = __expf(u - mn);
            const f32x4 uv = *(const f32x4*)(U + (size_t)c * 16384);
            st = st * dec + uv * sc; m = mn;
            u32x2 o; o.x = cvt_pk_bf16(st.x, st.y); o.y = cvt_pk_bf16(st.z, st.w);
            *(u32x2*)(C + (size_t)(c + 1) * 16384) = o;
        }
    }
    for (int i = blockIdx.x * NTHREADS + tid; i < 32 * 32; i += G * NTHREADS) {
        const int bh = i >> 5, d4 = i & 31;
        const float* NL = (const float*)(mo + MO_NL) + (size_t)bh * 16 * 128 + d4 * 4;
        float* N = (float*)(mo + MO_N) + (size_t)bh * 16 * 128 + d4 * 4; float* M = (float*)(mo + MO_M) + bh * 16;
        f32x4 st = (f32x4){0.f, 0.f, 0.f, 0.f}; float m = 0.f;
        if (d4 == 0) M[0] = 0.f;
        for (int c = 0; c < 15; ++c) {
            const float g = GU[(bh * 16 + c) * 2], u = GU[(bh * 16 + c) * 2 + 1];
            const float mn = fmaxf(g + m, u), dec = __expf(g + m - mn), sc = __expf(u - mn);
            const f32x4 uv = *(const f32x4*)(NL + (size_t)c * 128);
            st = st * dec + uv * sc; m = mn;
            *(f32x4*)(N + (size_t)(c + 1) * 128) = st;
            if (d4 == 0) M[c + 1] = m;
        }
    }
}

__device__ __forceinline__ void ml_out_unit(LAS unsigned char* lds, unsigned char* ws, const unsigned char* mo, const float* gnorm, int unit) {
    const int tid = tid_opaque(), lane = tid & 63, r32 = lane & 31, hh = lane >> 5, wid = __builtin_amdgcn_readfirstlane(tid >> 6);
    const int bh = unit >> 4, c = unit & 15, b = bh >> 2, h = bh & 3, t0 = b * SEQ + c * ML_L;
    const float* IFP = (const float*)(ws + WS_IFP); const bf16_t* P = (const bf16_t*)(ws + WS_P); const bf16_t* MLQK = (const bf16_t*)(ws + WS_MLQK);
    bf16_t* YML = (bf16_t*)(ws + WS_YML);
    LAS float* ga = (LAS float*)(lds + MLL_G); LAS float* gz = ga + 256; LAS float* gp = gz + 256;
    if (wid == 0) ml_gate_scan(IFP, t0, h, lane, ga, gz, gp);
    const int sch = tid & 15;
    {
        u32x4 kreg[8], vreg[8];
#pragma unroll
        for (int i = 0; i < 8; ++i) { const size_t t = (size_t)(t0 + (tid >> 4) + 32 * i);
            kreg[i] = *(const u32x4*)(MLQK + t * 1024 + 512 + h * 128 + sch * 8); vreg[i] = *(const u32x4*)(P + t * PW + PC_MV + h * 128 + sch * 8); }
#pragma unroll
        for (int i = 0; i < 8; ++i) { const int r = (tid >> 4) + 32 * i;
            *(LAS u32x4*)(lds + MLL_K + sch * MLK_STR + r * 16) = kreg[i]; *(LAS u32x4*)(lds + MLL_V + v_off(r, sch)) = vreg[i]; }
    }
    const float m_prev = (c > 0) ? ((const float*)(mo + MO_M))[unit] : 0.f;
    const int lq = 32 * wid + r32;
    bf16x8 qf[8];
    { const bf16_t* qp = MLQK + (size_t)(t0 + lq) * 1024 + h * 128 + hh * 8;
#pragma unroll
      for (int dd = 0; dd < 8; ++dd) qf[dd] = *(const bf16x8*)(qp + dd * 16); }
    f32x16 o[4]; f32x16 o4 = f32x16{};
#pragma unroll
    for (int et = 0; et < 4; ++et) o[et] = f32x16{};
    if (c > 0) {
        const bf16_t* Cg = (const bf16_t*)(mo + MO_C) + (size_t)unit * 16384 + (size_t)r32 * 128 + hh * 8; const float* Ng = (const float*)(mo + MO_N) + (size_t)unit * 128 + hh * 8;
#pragma unroll
        for (int dd = 0; dd < 8; ++dd) {
#pragma unroll
            for (int et = 0; et < 4; ++et) { const bf16x8 cf = *(const bf16x8*)(Cg + (size_t)et * 32 * 128 + dd * 16); o[et] = __builtin_amdgcn_mfma_f32_32x32x16_bf16(cf, qf[dd], o[et], 0, 0, 0); }
            u32x4 nv = (u32x4){0u, 0u, 0u, 0u};
            if (r32 == 0) { const f32x4 n0 = *(const f32x4*)(Ng + dd * 16), n1 = *(const f32x4*)(Ng + dd * 16 + 4);
                nv.x = cvt_pk_bf16(n0.x, n0.y); nv.y = cvt_pk_bf16(n0.z, n0.w); nv.z = cvt_pk_bf16(n1.x, n1.y); nv.w = cvt_pk_bf16(n1.z, n1.w); }
            o4 = __builtin_amdgcn_mfma_f32_32x32x16_bf16(__builtin_bit_cast(bf16x8, nv), qf[dd], o4, 0, 0, 0);
        }
    }
    __syncthreads();
    const float a_l = ga[lq], M_l = fmaxf(gp[lq], m_prev);
    const float w_inter = __expf(m_prev - M_l);
    const float dinter = __shfl(o4[0], r32);
#pragma unroll
    for (int et = 0; et < 4; ++et)
#pragma unroll
        for (int r = 0; r < 16; ++r) o[et][r] *= w_inter;
    const int tg = lane >> 4, tq = (lane >> 2) & 3, tp = lane & 3;
    const int vlo = 64 * (4 * hh + tq) + 16 * ((2 * (tg & 1) + (tp >> 1)) ^ hh) + 8 * (tp & 1);
    const int vhi = 64 * (4 * hh + tq) + 16 * ((2 * (tg & 1) + (tp >> 1)) ^ (hh + 2)) + 8 * (tp & 1);
    const int klane = hh * MLK_STR + r32 * 16;
    float dintra = 0.f;
    for (int kb32 = 0; kb32 <= wid; ++kb32) {
        const int kb = 32 * kb32;
        f32x16 sc = f32x16{};
#pragma unroll
        for (int dd = 0; dd < 8; ++dd) { const bf16x8 ka = *(const LAS bf16x8*)(lds + MLL_K + klane + (dd * 2) * MLK_STR + kb32 * 512); sc = __builtin_amdgcn_mfma_f32_32x32x16_bf16(ka, qf[dd], sc, 0, 0, 0); }
#pragma unroll
        for (int g4 = 0; g4 < 4; ++g4) { const f32x4 zv = *(const LAS f32x4*)(gz + kb + 8 * g4 + 4 * hh);
#pragma unroll
            for (int e = 0; e < 4; ++e) { const int s = kb + 8 * g4 + 4 * hh + e; const float wgt = (s <= lq) ? __builtin_amdgcn_exp2f((zv[e] - M_l) * LOG2E) : 0.f; sc[4 * g4 + e] *= wgt; dintra += sc[4 * g4 + e]; } }
        bf16x8 pf[2];
#pragma unroll
        for (int s = 0; s < 2; ++s) { u32x4 w;
            w.x = cvt_pk_bf16(sc[8 * s + 0], sc[8 * s + 1]); w.y = cvt_pk_bf16(sc[8 * s + 2], sc[8 * s + 3]); w.z = cvt_pk_bf16(sc[8 * s + 4], sc[8 * s + 5]); w.w = cvt_pk_bf16(sc[8 * s + 6], sc[8 * s + 7]);
            pf[s] = __builtin_bit_cast(bf16x8, w); }
#pragma unroll
        for (int s = 0; s < 2; ++s)
#pragma unroll
            for (int et = 0; et < 4; ++et) {
                const s16x4 lo = __builtin_bit_cast(s16x4, __builtin_amdgcn_ds_read_tr16_b64_v4i16((LAS v4i16_t*)(lds + MLL_V + vlo + 2048 * (4 * kb32 + 2 * s) + 512 * et)));
                const s16x4 hi = __builtin_bit_cast(s16x4, __builtin_amdgcn_ds_read_tr16_b64_v4i16((LAS v4i16_t*)(lds + MLL_V + vhi + 2048 * (4 * kb32 + 2 * s + 1) + 512 * et)));
                const bf16x8 vf = (bf16x8){lo[0], lo[1], lo[2], lo[3], hi[0], hi[1], hi[2], hi[3]};
                o[et] = __builtin_amdgcn_mfma_f32_32x32x16_bf16(vf, pf[s], o[et], 0, 0, 0);
            }
    }
    dintra += __shfl_xor(dintra, 32);
    const float den = dintra + w_inter * dinter;
    const float hsc = 1.0f / fmaxf(fabsf(den), __expf(-(a_l + M_l)));
    float ss = 0.f;
#pragma unroll
    for (int et = 0; et < 4; ++et)
#pragma unroll
        for (int r = 0; r < 16; ++r) { o[et][r] *= hsc; ss += o[et][r] * o[et][r]; }
    ss += __shfl_xor(ss, 32);
    const float rstd = 1.0f / sqrtf(ss * (1.f / 128.f) + NORM_EPS);
    const size_t tok = (size_t)(t0 + lq);
#pragma unroll
    for (int et = 0; et < 4; ++et)
#pragma unroll
        for (int g4 = 0; g4 < 4; ++g4) {
            const int e0 = 32 * et + 8 * g4 + 4 * hh;
            const f32x4 gv = *(const f32x4*)(gnorm + h * 128 + e0);
            const u32x2 og = *(const u32x2*)(P + tok * PW + PC_MO + h * 128 + e0);
            u32x2 w; w.x = cvt_pk_bf16(o[et][4 * g4 + 0] * rstd * gv.x * bf_lo(og.x), o[et][4 * g4 + 1] * rstd * gv.y * bf_hi(og.x));
            w.y = cvt_pk_bf16(o[et][4 * g4 + 2] * rstd * gv.z * bf_lo(og.y), o[et][4 * g4 + 3] * rstd * gv.w * bf_hi(og.y));
            *(u32x2*)(YML + tok * 512 + h * 128 + e0) = w;
        }
    __syncthreads();
}
struct SchedStatic {
    const char* A; const char* B; int nM, nN, G, c; size_t abytes, bbytes;
    __device__ __forceinline__ bool next(int i, pg8::Unit& u) const {
        int pm, pn; if (!pg8::static_tile(nM, nN, G, c, i, pm, pn)) return false;
        u.pm = pm; u.pn = pn; u.aux = 0; u.A = A + (size_t)pm * abytes; u.B = B + (size_t)pn * bbytes; return true; }
    __device__ __forceinline__ int arow(const pg8::Unit&, int r) const { return r; }
};
template <bool TWO> struct SchedPair {
    const char* A0; const char* A1; const char* B0; const char* B1; int nM, nN, G, c; size_t abytes, bbytes;
    __device__ __forceinline__ bool next(int i, pg8::Unit& u) const {
        const int p = TWO ? (i >> 1) : i, which = TWO ? (i & 1) : 0;
        int pm, pn; if (!pg8::static_tile(nM, nN, G, c, p, pm, pn)) return false;
        u.pm = pm; u.pn = pn; u.aux = which; u.A = (which ? A1 : A0) + (size_t)pm * abytes; u.B = (which ? B1 : B0) + (size_t)pn * bbytes; return true; }
    __device__ __forceinline__ int arow(const pg8::Unit&, int r) const { return r; }
};

struct EpiProj {
    static constexpr bool PERM = true;
    static constexpr int BHALF = 32;
    __host__ __device__ static __forceinline__ int brow(int R) { return 64 * ((R >> 5) & 3) + pg8::perm32(R & 31); }
    bf16_t* P; const float* bgate; const float* gq; const float* gk;
    __device__ __forceinline__ bool operator()(f32x4 (&acc)[2][2][4][2], const pg8::Unit& u, int wr, int wc, int fr, int fq) const {
        const int row0 = u.pm * 256 + wr * 64 + fr, col0 = u.pn * 256 + wc * 64 + 8 * fq;
        const int mode = u.pn < 4 ? 3 : (u.pn < 12 ? 0 : (u.pn < 14 ? 1 : 2));
        f32x4 bv[2][2];
#pragma unroll
        for (int bj = 0; bj < 2; ++bj)
#pragma unroll
            for (int n = 0; n < 2; ++n) {
                if (mode == 2) bv[bj][n] = *(const f32x4*)(bgate + (col0 - PC_G) + bj * 32 + 4 * n);
                else if (mode == 3) { bv[bj][n] = *(const f32x4*)((u.pn < 2 ? gq : gk) + 8 * fq + bj * 32 + 4 * n); if (u.pn < 2) bv[bj][n] = bv[bj][n] * (0.125f * LOG2E); }
                else bv[bj][n] = (f32x4){0.f, 0.f, 0.f, 0.f}; }
#pragma unroll
        for (int ai = 0; ai < 2; ++ai)
#pragma unroll
            for (int m = 0; m < 4; ++m) { bf16_t* rowp = P + (size_t)(row0 + ai * 128 + m * 16) * PW + col0;
                float rstd = 1.f;
                if (mode == 3) { float ss = 0.f;
#pragma unroll
                    for (int bj = 0; bj < 2; ++bj)
#pragma unroll
                        for (int n = 0; n < 2; ++n) { const f32x4 v = acc[ai][bj][m][n]; ss += (v[0] * v[0] + v[1] * v[1]) + (v[2] * v[2] + v[3] * v[3]); }
                    ss += __shfl_xor(ss, 16); ss += __shfl_xor(ss, 32);
                    rstd = 1.0f / sqrtf(ss * (1.f / 64.f) + NORM_EPS); }
#pragma unroll
                for (int bj = 0; bj < 2; ++bj) { f32x4 v0, v1;
                    if (mode == 3) { v0 = acc[ai][bj][m][0] * rstd * bv[bj][0]; v1 = acc[ai][bj][m][1] * rstd * bv[bj][1]; }
                    else { v0 = acc[ai][bj][m][0] + bv[bj][0]; v1 = acc[ai][bj][m][1] + bv[bj][1]; }
                    if (mode == 1 || mode == 2) {
#pragma unroll
                        for (int j = 0; j < 4; ++j) { v0[j] = fast_sigmoid(v0[j]); v1[j] = fast_sigmoid(v1[j]); } }
                    u32x4 w; w.x = cvt_pk_bf16(v0[0], v0[1]); w.y = cvt_pk_bf16(v0[2], v0[3]); w.z = cvt_pk_bf16(v1[0], v1[1]); w.w = cvt_pk_bf16(v1[2], v1[3]);
                    *(u32x4*)(rowp + bj * 32) = w; } }
        return false;
    }
};

template <bool TWO> struct EpiMixed {
    static constexpr bool PERM = true;
    static constexpr int BHALF = 128;
    __host__ __device__ static __forceinline__ int brow(int R) { return pg8::perm_rows(R); }
    const bf16_t* P; bf16_t* MIX;
    __device__ __forceinline__ bool operator()(f32x4 (&acc)[2][2][4][2], const pg8::Unit& u, int wr, int wc, int fr, int fq) const {
        const int row0 = u.pm * 256 + wr * 64 + fr, col0 = u.pn * 256 + wc * 32 + 8 * fq;
        const bool first = TWO && (u.aux == 0);
#pragma unroll
        for (int ai = 0; ai < 2; ++ai)
#pragma unroll
            for (int m = 0; m < 4; ++m) { const int row = row0 + ai * 128 + m * 16; const bf16_t* gp = P + (size_t)row * PW + PC_G + col0;
#pragma unroll
                for (int bj = 0; bj < 2; ++bj) {
                    const u32x4 ga = *(const u32x4*)(gp + bj * 128);
                    float g1[8] = {bf_lo(ga.x), bf_hi(ga.x), bf_lo(ga.y), bf_hi(ga.y), bf_lo(ga.z), bf_hi(ga.z), bf_lo(ga.w), bf_hi(ga.w)};
                    if (!TWO) {
                        f32x4 v0 = acc[ai][bj][m][0], v1 = acc[ai][bj][m][1];
#pragma unroll
                        for (int j = 0; j < 4; ++j) { v0[j] *= g1[j]; v1[j] *= g1[4 + j]; }
                        u32x4 w; w.x = cvt_pk_bf16(v0[0], v0[1]); w.y = cvt_pk_bf16(v0[2], v0[3]); w.z = cvt_pk_bf16(v1[0], v1[1]); w.w = cvt_pk_bf16(v1[2], v1[3]);
                        *(u32x4*)(MIX + (size_t)row * 1024 + col0 + bj * 128) = w;
                    } else {
                        const u32x4 gb = *(const u32x4*)(gp + 1024 + bj * 128);
                        float g2[8] = {bf_lo(gb.x), bf_hi(gb.x), bf_lo(gb.y), bf_hi(gb.y), bf_lo(gb.z), bf_hi(gb.z), bf_lo(gb.w), bf_hi(gb.w)};
                        if (first) {
#pragma unroll
                            for (int j = 0; j < 4; ++j) { acc[ai][bj][m][0][j] *= g1[j] * __builtin_amdgcn_rcpf(fmaxf(g2[j], 1e-30f)); acc[ai][bj][m][1][j] *= g1[4 + j] * __builtin_amdgcn_rcpf(fmaxf(g2[4 + j], 1e-30f)); }
                        } else {
                            f32x4 v0 = acc[ai][bj][m][0], v1 = acc[ai][bj][m][1];
#pragma unroll
                            for (int j = 0; j < 4; ++j) { v0[j] *= g2[j]; v1[j] *= g2[4 + j]; }
                            u32x4 w; w.x = cvt_pk_bf16(v0[0], v0[1]); w.y = cvt_pk_bf16(v0[2], v0[3]); w.z = cvt_pk_bf16(v1[0], v1[1]); w.w = cvt_pk_bf16(v1[2], v1[3]);
                            *(u32x4*)(MIX + (size_t)row * 1024 + col0 + bj * 128) = w;
                        }
                    }
                } }
        return first;
    }
};

struct EpiWout {
    static constexpr bool PERM = true;
    static constexpr int BHALF = 128;
    __host__ __device__ static __forceinline__ int brow(int R) { return pg8::perm_rows(R); }
    const float* x; float* out;
    __device__ __forceinline__ bool operator()(f32x4 (&acc)[2][2][4][2], const pg8::Unit& u, int wr, int wc, int fr, int fq) const {
        const int row0 = u.pm * 256 + wr * 64 + fr, col0 = u.pn * 256 + wc * 32 + 8 * fq;
#pragma unroll
        for (int ai = 0; ai < 2; ++ai)
#pragma unroll
            for (int m = 0; m < 4; ++m) { const size_t ro = (size_t)(row0 + ai * 128 + m * 16) * D + col0;
#pragma unroll
                for (int bj = 0; bj < 2; ++bj)
#pragma unroll
                    for (int n = 0; n < 2; ++n) { const f32x4 xv = *(const f32x4*)(x + ro + bj * 128 + n * 4); *(f32x4*)(out + ro + bj * 128 + n * 4) = xv + acc[ai][bj][m][n]; } }
        return false;
    }
};
constexpr size_t WS_TILEE = WS_WGCNT + (size_t)256 * 64 * 4;
constexpr size_t WS_NT = WS_TILEE + 384 * 4;
constexpr size_t WS_RSTD = WS_NT + 256;
constexpr size_t WS_RSLOT = WS_RSTD + (size_t)T * 4;
static_assert(WS_RSLOT + (size_t)MOE_ROWS * 4 <= WS_END, "MoE tables must fit the P region");
__device__ __forceinline__ int ld_i32(const int* p) { return (int)__hip_atomic_load((const unsigned*)p, __ATOMIC_RELAXED, __HIP_MEMORY_SCOPE_AGENT); }

constexpr int RT_WSTR = 1028;
constexpr int RT_LG = 36 * RT_WSTR * 4;
constexpr int RT_HIST = RT_LG + 8 * 8 * 36 * 4;
static_assert(RT_HIST + 256 <= LDS_MISC_OFF, "router LDS");

#ifndef RSTAMP
#define RSTAMP() do { } while (0)
#define RSTAMPW() do { } while (0)
#endif
__device__ __forceinline__ void router_phase(LAS unsigned char* lds, const float* const* in, unsigned char* ws, const float* x1, int G) {
    moe_weight_convert(lds, in, ws, G);
    __syncthreads();
    RSTAMP();
    const int tid = tid_opaque(), lane = tid & 63, wave = __builtin_amdgcn_readfirstlane(tid >> 6);
    const int gw = blockIdx.x * NWAVES + wave, NGW = G * NWAVES;
    const float* gn = in[20]; const float* w_group = in[21]; const float* b_group = in[22]; const float* w_router = in[23]; const float* b_router = in[24];
    LAS float* wr = (LAS float*)lds;
    for (int i = tid; i < 4096; i += NTHREADS) { const int d = i >> 2, j = i & 3; wr[j * RT_WSTR + d] = w_group[i] * gn[d]; }
    for (int i = tid; i < 32768; i += NTHREADS) { const int d = i >> 5, j = i & 31; wr[(4 + j) * RT_WSTR + d] = w_router[i] * gn[d]; }
    LAS float* lg = (LAS float*)(lds + RT_LG) + wave * (8 * 36);
    LAS int* hist = (LAS int*)(lds + RT_HIST);
    if (tid < 64) hist[tid] = 0;
    __syncthreads();
    bf16_t* HN = (bf16_t*)(ws + WS_HN); int* TEID = (int*)(ws + WS_TEID); float* TGATE = (float*)(ws + WS_TGATE);
    const int li = lane & 15, lq = lane >> 4;
    for (int row0 = gw * 16; row0 < T; row0 += NGW * 16) {
        const float* xr = x1 + (size_t)(row0 + li) * D + 4 * lq;
        const LAS float* wb0 = wr + li * RT_WSTR + 4 * lq;
        const LAS float* wb1 = wr + (16 + li) * RT_WSTR + 4 * lq;
        const LAS float* wb2 = wr + (li < 4 ? 32 + li : 35) * RT_WSTR + 4 * lq;
        f32x4 acc0 = (f32x4){0.f, 0.f, 0.f, 0.f}, acc1 = acc0, acc2 = acc0; float ssq = 0.f;
        unsigned long long* o8 = (unsigned long long*)(HN + (size_t)(row0 + li) * D + 4 * lq);
#pragma unroll 4
        for (int c = 0; c < 64; ++c) {
            const f32x4 a4 = *(const f32x4*)(xr + 16 * c);
            const f32x4 b0 = *(const LAS f32x4*)(wb0 + 16 * c), b1 = *(const LAS f32x4*)(wb1 + 16 * c), b2 = *(const LAS f32x4*)(wb2 + 16 * c);
            ssq += (a4.x * a4.x + a4.y * a4.y) + (a4.z * a4.z + a4.w * a4.w);
            { const f32x4 v = a4 * *(const f32x4*)(gn + 4 * lq + 16 * c);
              o8[4 * c] = (unsigned long long)cvt_pk_bf16(v.x, v.y) | ((unsigned long long)cvt_pk_bf16(v.z, v.w) << 32); }
#pragma unroll
            for (int e = 0; e < 4; ++e) {
                acc0 = __builtin_amdgcn_mfma_f32_16x16x4f32(a4[e], b0[e], acc0, 0, 0, 0);
                acc1 = __builtin_amdgcn_mfma_f32_16x16x4f32(a4[e], b1[e], acc1, 0, 0, 0);
                acc2 = __builtin_amdgcn_mfma_f32_16x16x4f32(a4[e], b2[e], acc2, 0, 0, 0);
            }
        }
        ssq += __shfl_xor(ssq, 16); ssq += __shfl_xor(ssq, 32);
        const float rstd_i = 1.0f / sqrtf(ssq * (1.f / D) + NORM_EPS);
        if (lq == 0) ((float*)(ws + WS_RSTD))[row0 + li] = rstd_i;
        float rs[4];
#pragma unroll
        for (int r = 0; r < 4; ++r) rs[r] = __shfl(rstd_i, 4 * lq + r);
#pragma unroll
        for (int h8 = 0; h8 < 2; ++h8) {
            if ((lq >> 1) == h8) {
#pragma unroll
                for (int r = 0; r < 4; ++r) { const int rr = 4 * (lq & 1) + r;
                    lg[rr * 36 + li] = acc0[r] * rs[r]; lg[rr * 36 + 16 + li] = acc1[r] * rs[r]; if (li < 4) lg[rr * 36 + 32 + li] = acc2[r] * rs[r]; }
            }
            asm volatile("s_waitcnt lgkmcnt(0)" ::: "memory");
            if (lane < 8) {
                const LAS float* L = lg + lane * 36;
                float gl[4]; int gi = 0; float gm = -INFINITY;
#pragma unroll
                for (int i = 0; i < 4; ++i) { gl[i] = L[i] + b_group[i]; if (gl[i] > gm) { gm = gl[i]; gi = i; } }
                float gs = 0.f;
#pragma unroll
                for (int i = 0; i < 4; ++i) gs += __expf(gl[i] - gm);
                const float gtop = 1.0f / gs;
                float l1 = -INFINITY, l2 = -INFINITY; int e1 = 0, e2 = 0;
                for (int i = 0; i < 8; ++i) { const float l = L[4 + gi * 8 + i] + b_router[gi * 8 + i];
                    if (l > l1) { l2 = l1; e2 = e1; l1 = l; e1 = i; } else if (l > l2) { l2 = l; e2 = i; } }
                const float p2 = __expf(l2 - l1), w1 = 1.0f / (1.0f + p2), w2 = p2 * w1;
                const int t = row0 + 8 * h8 + lane;
                TEID[t * 2] = gi * 8 + e1; TEID[t * 2 + 1] = gi * 8 + e2; TGATE[t * 2] = gtop * w1; TGATE[t * 2 + 1] = gtop * w2;
                __hip_atomic_fetch_add(&hist[gi * 8 + e1], 1, __ATOMIC_RELAXED, __HIP_MEMORY_SCOPE_WORKGROUP); __hip_atomic_fetch_add(&hist[32 + gi * 8 + e2], 1, __ATOMIC_RELAXED, __HIP_MEMORY_SCOPE_WORKGROUP);
            }
            asm volatile("s_waitcnt lgkmcnt(0)" ::: "memory");
        }
    }
    __syncthreads();
    if (tid < 64) ((int*)(ws + WS_WGCNT))[blockIdx.x * 64 + tid] = hist[tid];
}

__device__ __forceinline__ void moe_plan_phase(LAS unsigned char* lds, unsigned char* ws, int G) {
    const int tid = tid_opaque();
    LAS int* tot = (LAS int*)lds; LAS int* pre = tot + 64; LAS int* base = pre + 64; LAS int* lcnt = base + 64; LAS int* pt = lcnt + 64; LAS int* pp = pt + 512;
    const int* WGCNT = (const int*)(ws + WS_WGCNT);
    { const int j = tid & 63, part = tid >> 6; int t = 0, p = 0;
#pragma unroll 8
      for (int w = 32 * part; w < 32 * part + 32; ++w) { const int v = ld_i32(WGCNT + w * 64 + j); t += v; p += (w < (int)blockIdx.x) ? v : 0; }
      pt[tid] = t; pp[tid] = p; }
    __syncthreads();
    if (tid < 64) { int t = 0, p = 0;
#pragma unroll
        for (int q = 0; q < 8; ++q) { t += pt[q * 64 + tid]; p += pp[q * 64 + tid]; }
        tot[tid] = t; pre[tid] = p; lcnt[tid] = 0; }
    __syncthreads();
    if (tid == 0) { int run = 0; for (int j = 0; j < 64; ++j) { base[j] = run; run += ((tot[j] + 255) >> 8) << 8; } }
    __syncthreads();
    int* RTOK = (int*)(ws + WS_RTOK); float* RGATE = (float*)(ws + WS_RGATE); float* RSLOT = (float*)(ws + WS_RSLOT);
    if (tid < 256) {
        const int k = tid & 1, ts = tid >> 1;
        const int t = (int)blockIdx.x * 128 + ts;
        const int e = ld_i32((const int*)(ws + WS_TEID) + t * 2 + k); const float g = __uint_as_float((unsigned)ld_i32((const int*)(ws + WS_TGATE) + t * 2 + k));
        const float rs = __uint_as_float((unsigned)ld_i32((const int*)(ws + WS_RSTD) + t));
        const int j = k * 32 + e; const int rk = __hip_atomic_fetch_add(&lcnt[j], 1, __ATOMIC_RELAXED, __HIP_MEMORY_SCOPE_WORKGROUP);
        const int slot = base[j] + pre[j] + rk;
        RTOK[slot] = t; RGATE[slot] = g; RSLOT[slot] = rs;
    }
    if (blockIdx.x < 64) { const int j = blockIdx.x; const int s0 = base[j] + tot[j], s1 = base[j] + (((tot[j] + 255) >> 8) << 8);
        for (int s = s0 + tid; s < s1; s += NTHREADS) { RTOK[s] = -1; RGATE[s] = 0.f; RSLOT[s] = 0.f; } }
    if (blockIdx.x == 0 && tid < 64) { int* TE = (int*)(ws + WS_TILEE); int* NT = (int*)(ws + WS_NT);
        const int n = (tot[tid] + 255) >> 8, b0 = base[tid] >> 8;
        for (int q = 0; q < n; ++q) TE[b0 + q] = tid & 31;
        if (tid == 31) NT[0] = b0 + n;
        if (tid == 63) NT[1] = b0 + n; }
    __syncthreads();
}

struct SchedUp {
    const char* HN; const char* W13; const int* RTOK; const int* TE; int ntiles, G, c;
    __device__ __forceinline__ bool next(int i, pg8::Unit& u) const {
        const int L = i * G + c; if (L >= ntiles * 4) return false;
        const int tau = L >> 2, pn = L & 3, e = ld_i32(TE + tau);
        u.pm = tau; u.pn = pn; u.aux = e; u.A = HN; u.B = W13 + (size_t)e * (1024 * 1024 * 2) + (size_t)pn * (256 * 1024 * 2); return true; }
    __device__ __forceinline__ int arow(const pg8::Unit& u, int r) const { const int t = ld_i32(RTOK + u.pm * 256 + r); return t < 0 ? 0 : t; }
};
struct EpiUp {
    static constexpr bool PERM = true;
    static constexpr int BHALF = 128;
    __host__ __device__ static __forceinline__ int brow(int R) { return pg8::perm_rows(R); }
    bf16_t* HID; const float* RSLOT;
    __device__ __forceinline__ bool operator()(f32x4 (&acc)[2][2][4][2], const pg8::Unit& u, int wr, int wc, int fr, int fq) const {
        const int row0 = u.pm * 256 + wr * 64 + fr, col0 = u.pn * 128 + wc * 32 + 8 * fq;
#pragma unroll
        for (int ai = 0; ai < 2; ++ai)
#pragma unroll
            for (int m = 0; m < 4; ++m) {
                const float rs = __uint_as_float((unsigned)ld_i32((const int*)RSLOT + row0 + ai * 128 + m * 16));
                float hv[8];
#pragma unroll
                for (int n = 0; n < 2; ++n)
#pragma unroll
                    for (int j = 0; j < 4; ++j) { const float a = acc[ai][0][m][n][j] * rs; hv[4 * n + j] = a * fast_sigmoid(a) * (acc[ai][1][m][n][j] * rs); }
                u32x4 w; w.x = cvt_pk_bf16(hv[0], hv[1]); w.y = cvt_pk_bf16(hv[2], hv[3]); w.z = cvt_pk_bf16(hv[4], hv[5]); w.w = cvt_pk_bf16(hv[6], hv[7]);
                *(u32x4*)(HID + (size_t)(row0 + ai * 128 + m * 16) * 512 + col0) = w;
            }
        return false;
    }
};
struct SchedDown {
    const char* HID; const char* W2T; const int* TE; int t0, t1, G, c;
    __device__ __forceinline__ bool next(int i, pg8::Unit& u) const {
        const int L = i * G + c; if (L >= (t1 - t0) * 4) return false;
        const int tau = t0 + (L >> 2), pn = L & 3, e = ld_i32(TE + tau);
        u.pm = tau; u.pn = pn; u.aux = e; u.A = HID + (size_t)tau * (256 * 512 * 2); u.B = W2T + (size_t)e * (1024 * 512 * 2) + (size_t)pn * (256 * 512 * 2); return true; }
    __device__ __forceinline__ int arow(const pg8::Unit&, int r) const { return r; }
};
struct EpiDownY {
    static constexpr bool PERM = true;
    static constexpr int BHALF = 128;
    __host__ __device__ static __forceinline__ int brow(int R) { return pg8::perm_rows(R); }
    const int* RTOK; const float* RGATE; bf16_t* Y1;
    __device__ __forceinline__ bool operator()(f32x4 (&acc)[2][2][4][2], const pg8::Unit& u, int wr, int wc, int fr, int fq) const {
        const int row0 = u.pm * 256 + wr * 64 + fr, col0 = u.pn * 256 + wc * 32 + 8 * fq;
#pragma unroll
        for (int ai = 0; ai < 2; ++ai)
#pragma unroll
            for (int m = 0; m < 4; ++m) { const int slot = row0 + ai * 128 + m * 16; const int tok = ld_i32(RTOK + slot);
                if (tok >= 0) { const float g = __uint_as_float((unsigned)ld_i32((const int*)RGATE + slot)); bf16_t* op = Y1 + (size_t)tok * D + col0;
#pragma unroll
                    for (int bj = 0; bj < 2; ++bj) { const f32x4 v0 = acc[ai][bj][m][0] * g, v1 = acc[ai][bj][m][1] * g;
                        u32x4 w; w.x = cvt_pk_bf16(v0[0], v0[1]); w.y = cvt_pk_bf16(v0[2], v0[3]); w.z = cvt_pk_bf16(v1[0], v1[1]); w.w = cvt_pk_bf16(v1[2], v1[3]);
                        *(u32x4*)(op + bj * 128) = w; } } }
        return false;
    }
};
struct EpiDown {
    static constexpr bool PERM = true;
    static constexpr int BHALF = 128;
    __host__ __device__ static __forceinline__ int brow(int R) { return pg8::perm_rows(R); }
    const int* RTOK; const float* RGATE; float* out; const bf16_t* Y1;
    __device__ __forceinline__ bool operator()(f32x4 (&acc)[2][2][4][2], const pg8::Unit& u, int wr, int wc, int fr, int fq) const {
        const int row0 = u.pm * 256 + wr * 64 + fr, col0 = u.pn * 256 + wc * 32 + 8 * fq;
#pragma unroll
        for (int ai = 0; ai < 2; ++ai)
#pragma unroll
            for (int m = 0; m < 4; ++m) { const int slot = row0 + ai * 128 + m * 16; const int tok = ld_i32(RTOK + slot);
                if (tok >= 0) { const float g = __uint_as_float((unsigned)ld_i32((const int*)RGATE + slot)); float* op = out + (size_t)tok * D + col0; const bf16_t* yp = Y1 + (size_t)tok * D + col0;
#pragma unroll
                    for (int bj = 0; bj < 2; ++bj) { const u32x4 yv = *(const u32x4*)(yp + bj * 128);
                        f32x4* q0 = (f32x4*)(op + bj * 128); f32x4* q1 = (f32x4*)(op + bj * 128 + 4);
                        *q0 = *q0 + acc[ai][bj][m][0] * g + (f32x4){bf_lo(yv.x), bf_hi(yv.x), bf_lo(yv.y), bf_hi(yv.y)};
                        *q1 = *q1 + acc[ai][bj][m][1] * g + (f32x4){bf_lo(yv.z), bf_hi(yv.z), bf_lo(yv.w), bf_hi(yv.w)}; } } }
        return false;
    }
};
struct Args { const float* in[28]; float* out; unsigned char* ws; };

__global__ void __launch_bounds__(NTHREADS, 2) fwd(Args a) {
    extern __shared__ __attribute__((aligned(16))) unsigned char lds_raw[];
    LAS unsigned char* lds = (LAS unsigned char*)lds_raw;
    const int tid = threadIdx.x; const int G = (int)gridDim.x;
    volatile LAS unsigned* misc = (volatile LAS unsigned*)(lds + LDS_MISC_OFF);
    if (tid < 64) misc[tid] = 0u;
    __syncthreads();
    unsigned* ctl = (unsigned*)(a.ws + WS_CTL);
    XcdBarrier bar = xcd_barrier_post(ctl + CW_BAR, misc);
    unsigned char* ws = a.ws;

    p0_prologue(lds, a.in, ws, G);
    xcd_barrier(bar);
    {
        SchedStatic S{(const char*)(ws + WS_HB), (const char*)(ws + WS_WIN), 128, 22, G, (int)blockIdx.x, (size_t)256 * 1024 * 2, (size_t)256 * 1024 * 2};
        EpiProj E{(bf16_t*)(ws + WS_P), a.in[18], a.in[3], a.in[4]};
        pg8::gemm_run<EpiProj, SchedStatic, false>(lds, 1024, S, E);
    }
    xcd_barrier(bar);
    unsigned char* mo = (unsigned char*)a.out;
    for (int u = blockIdx.x; u < ML_UNITS; u += G) ml_state_unit(lds, ws, mo, a.in[10], a.in[11], u);
    xcd_barrier(bar);
    ml_scan_phase(mo, G);
    xcd_barrier(bar);
    attn_phase(lds, a.in, ws, G);
    __syncthreads();
    for (int u = blockIdx.x; u < ML_UNITS; u += G) ml_out_unit(lds, ws, mo, a.in[14], u);
    xcd_barrier(bar);
    {
        SchedPair<true> S{(const char*)(ws + WS_YDA), (const char*)(ws + WS_YML), (const char*)(ws + WS_WDA), (const char*)(ws + WS_WML), 128, 4, G, (int)blockIdx.x, (size_t)256 * 512 * 2, (size_t)256 * 512 * 2};
        EpiMixed<true> E{(const bf16_t*)(ws + WS_P), (bf16_t*)(ws + WS_MIX)};
        pg8::gemm_run<EpiMixed<true>, SchedPair<true>, false>(lds, 512, S, E);
    }
    xcd_barrier(bar);
    {
        SchedStatic S{(const char*)(ws + WS_MIX), (const char*)(ws + WS_WOUT), 128, 4, G, (int)blockIdx.x, (size_t)256 * 1024 * 2, (size_t)256 * 1024 * 2};
        EpiWout E{a.in[0], a.out};
        pg8::gemm_run<EpiWout, SchedStatic, false>(lds, 1024, S, E);
    }
    xcd_barrier(bar);
    router_phase(lds, a.in, ws, a.out, G);
    xcd_barrier(bar);
    moe_plan_phase(lds, ws, G);
    xcd_barrier(bar);
    const int nt0 = ld_i32((const int*)(ws + WS_NT)), nt1 = ld_i32((const int*)(ws + WS_NT) + 1);
    {
        SchedUp S{(const char*)(ws + WS_HN), (const char*)(ws + WS_W13), (const int*)(ws + WS_RTOK), (const int*)(ws + WS_TILEE), nt1, G, (int)blockIdx.x};
        EpiUp E{(bf16_t*)(ws + WS_HID), (const float*)(ws + WS_RSLOT)};
        pg8::gemm_run<EpiUp, SchedUp, true>(lds, 1024, S, E);
    }
    xcd_barrier(bar);
    {
        SchedDown S{(const char*)(ws + WS_HID), (const char*)(ws + WS_W2), (const int*)(ws + WS_TILEE), nt0, nt1, G, (int)blockIdx.x};
        EpiDownY E{(const int*)(ws + WS_RTOK), (const float*)(ws + WS_RGATE), (bf16_t*)(ws + WS_HB)};
        pg8::gemm_run<EpiDownY, SchedDown, false>(lds, 512, S, E);
    }
    xcd_barrier(bar);
    {
        SchedDown S{(const char*)(ws + WS_HID), (const char*)(ws + WS_W2), (const int*)(ws + WS_TILEE), 0, nt0, G, (int)blockIdx.x};
        EpiDown E{(const int*)(ws + WS_RTOK), (const float*)(ws + WS_RGATE), a.out, (const bf16_t*)(ws + WS_HB)};
        pg8::gemm_run<EpiDown, SchedDown, false>(lds, 512, S, E);
    }
}

extern "C" void kernel_launch(void* const* d_in, const int* in_sizes, int n_in, void* d_out, int out_size, void* d_ws, size_t ws_size, hipStream_t stream) {
    static int grid = 0;
    if (grid == 0) {
        if (n_in != 28 || out_size != T * D || ws_size < WS_END) { fprintf(stderr, "kernel_launch: unexpected shapes (n_in %d, out %d, ws %zu, need %zu)\n", n_in, out_size, ws_size, (size_t)WS_END); grid = -1; return; }
        int dev = 0, cus = 0, per_cu = 0;
        if (hipGetDevice(&dev) != hipSuccess || hipDeviceGetAttribute(&cus, hipDeviceAttributeMultiprocessorCount, dev) != hipSuccess) { grid = -1; return; }
        if (hipFuncSetAttribute((const void*)fwd, hipFuncAttributeMaxDynamicSharedMemorySize, LDS_BYTES) != hipSuccess) { fprintf(stderr, "kernel_launch: hipFuncSetAttribute failed\n"); grid = -1; return; }
        if (hipOccupancyMaxActiveBlocksPerMultiprocessor(&per_cu, (const void*)fwd, NTHREADS, LDS_BYTES) != hipSuccess || per_cu < 1) { fprintf(stderr, "kernel_launch: occupancy query reports %d\n", per_cu); }
        (void)hipGetLastError();
        grid = cus;
        if (grid != 256) { fprintf(stderr, "kernel_launch: built for a 256-CU device (got %d)\n", cus); grid = -1; return; }
    }
    if (grid < 0) return;
    if (hipMemsetAsync((char*)d_ws + WS_CTL, 0, CTL_BYTES, stream) != hipSuccess) return;
    Args a{};
    for (int i = 0; i < 28; ++i) a.in[i] = (const float*)d_in[i];
    a.out = (float*)d_out; a.ws = (unsigned char*)d_ws;
    hipLaunchKernelGGL(fwd, dim3(grid), dim3(NTHREADS), LDS_BYTES, stream, a);
}
```

```cpp
#include <hip/hip_runtime.h>
#include <cstdio>
#include <cstdint>

#define LAS __attribute__((address_space(3)))
typedef unsigned short bf16_t;
typedef short bf16x8 __attribute__((ext_vector_type(8)));
typedef short s16x4 __attribute__((ext_vector_type(4)));
typedef float f32x2 __attribute__((ext_vector_type(2)));
typedef float f32x4 __attribute__((ext_vector_type(4)));
typedef float f32x16 __attribute__((ext_vector_type(16)));
typedef unsigned u32x2 __attribute__((ext_vector_type(2)));
typedef unsigned u32x4 __attribute__((ext_vector_type(4)));

constexpr int T = 32768, D = 1024, SEQ = 4096, NBATCH = 8;
constexpr int PW = 5632;
constexpr int IN_W = 3592;
constexpr int PC_Q = 0, PC_K = 512, PC_V = 1024, PC_MQ = 1536, PC_MK = 2048, PC_MV = 2560, PC_MO = 3072, PC_G = 3584;
constexpr int NEXP = 32, FF = 512;
constexpr float NORM_EPS = 1e-6f;
constexpr float LOG2E = 1.4426950408889634f;
constexpr int NTHREADS = 512, NWAVES = 8;

constexpr size_t WS_CTL = 0, CTL_BYTES = 65536;
constexpr size_t WS_WIN = WS_CTL + CTL_BYTES;
constexpr size_t WS_WDA = WS_WIN + (size_t)PW * 1024 * 2;
constexpr size_t WS_WML = WS_WDA + (size_t)1024 * 512 * 2;
constexpr size_t WS_WOUT = WS_WML + (size_t)1024 * 512 * 2;
constexpr size_t WS_IFP = WS_WOUT + (size_t)1024 * 1024 * 2;
constexpr size_t WS_HB = WS_IFP + (size_t)T * 8 * 4;
constexpr size_t WS_MLQK = WS_HB + (size_t)T * 1024 * 2;
constexpr size_t WS_P = WS_MLQK + (size_t)T * 1024 * 2;
constexpr size_t WS_END = WS_P + (size_t)T * PW * 2;
constexpr size_t WS_YDA = WS_HB;
constexpr size_t WS_YML = WS_HB + (size_t)T * 512 * 2;
constexpr size_t WS_MIX = WS_MLQK;
constexpr size_t WS_HN = WS_HB;
constexpr int MOE_ROWS = 65536 + 64 * 256;
constexpr size_t WS_W13 = WS_P;
constexpr size_t WS_W2 = WS_W13 + (size_t)NEXP * 1024 * 1024 * 2;
constexpr size_t WS_HID = WS_W2 + (size_t)NEXP * 1024 * 512 * 2;
constexpr size_t WS_RTOK = WS_HID + (size_t)MOE_ROWS * 512 * 2;
constexpr size_t WS_RGATE = WS_RTOK + (size_t)MOE_ROWS * 4;
constexpr size_t WS_TEID = WS_RGATE + (size_t)MOE_ROWS * 4;
constexpr size_t WS_TGATE = WS_TEID + (size_t)T * 2 * 4;
constexpr size_t WS_WGCNT = WS_TGATE + (size_t)T * 2 * 4;
constexpr size_t WS_MOE_END = WS_WGCNT + (size_t)256 * 64 * 4;
static_assert(WS_MOE_END <= WS_END, "MoE overlay must fit the P region");
constexpr int CW_BAR = 0;
constexpr int CW_MISC = 4096;

constexpr int LDS_BYTES = 160 * 1024;
constexpr int LDS_MISC_OFF = LDS_BYTES - 256;

__device__ __forceinline__ unsigned cvt_pk_bf16(float lo, float hi) { unsigned r; asm volatile("v_cvt_pk_bf16_f32 %0, %1, %2" : "=v"(r) : "v"(lo), "v"(hi)); return r; }
__device__ __forceinline__ float bf_lo(unsigned w) { return __uint_as_float(w << 16); }
__device__ __forceinline__ float bf_hi(unsigned w) { return __uint_as_float(w & 0xffff0000u); }
__device__ __forceinline__ float bf2f(bf16_t b) { return __uint_as_float(((unsigned)b) << 16); }
__device__ __forceinline__ float fast_sigmoid(float x) { return __builtin_amdgcn_rcpf(1.0f + __builtin_amdgcn_exp2f(-LOG2E * x)); }
__device__ __forceinline__ float wave_sum(float v) {
#pragma unroll
    for (int o = 1; o < 64; o <<= 1) v += __shfl_xor(v, o);
    return v;
}
__device__ __forceinline__ int tid_opaque() { int t = (int)threadIdx.x; asm volatile("" : "+v"(t)); return t; }
#define XB_TMO      128
#define XB_XCNT(j)  (256  + 64 * (j))
#define XB_XSUB(j)  (1280 + 64 * (j))
#define XB_XGEN(j)  (2304 + 64 * (j))
#define XB_TOP      3328
#define XB_TOPGEN   3392
#define XCD_BAR_WORDS 3456
#define XB_SPIN_CAP (1u << 18)

__device__ __forceinline__ unsigned xb_ld(unsigned* p)              { return __hip_atomic_load(p, __ATOMIC_RELAXED, __HIP_MEMORY_SCOPE_AGENT); }
__device__ __forceinline__ unsigned xb_add(unsigned* p, unsigned v) { return __hip_atomic_fetch_add(p, v, __ATOMIC_RELAXED, __HIP_MEMORY_SCOPE_AGENT); }
__device__ __forceinline__ unsigned xb_xcc_id() { return (unsigned)__builtin_amdgcn_s_getreg((3 << 11) | 20) & 0xFu; }
#define XB_SPIN(cond, bar) do { unsigned _sp = 0; while (cond) { __builtin_amdgcn_s_sleep(1); \
    if ((++_sp & 255u) == 0u) { if (xb_ld(&(bar)[XB_TMO])) break; if (_sp > XB_SPIN_CAP) { atomicAdd(&(bar)[XB_TMO], 1u); break; } } } } while (0)

struct XcdBarrier {
    unsigned* bar; unsigned x;
    volatile LAS unsigned* st;
};

__device__ __forceinline__ XcdBarrier xcd_barrier_post(unsigned* bar, volatile LAS unsigned* st) {
    XcdBarrier b; b.bar = bar; b.x = xb_xcc_id(); b.st = st;
    if (threadIdx.x == 0) (void)xb_add(&bar[XB_XCNT(b.x)], 1u);
    return b;
}
__device__ __forceinline__ void xcd_barrier_complete(unsigned* bar, unsigned x, unsigned& nloc, unsigned& nx) {
    const unsigned G = gridDim.x * gridDim.y * gridDim.z;
    unsigned sum, cnt, mine, sp = 0u;
    for (;;) {
        sum = 0u; cnt = 0u; mine = 0u;
#pragma unroll
        for (unsigned j = 0; j < 16; ++j) { const unsigned c = xb_ld(&bar[XB_XCNT(j)]); sum += c; cnt += (c > 0u) ? 1u : 0u; mine = (j == x) ? c : mine; }
        if (sum == G) break;
        __builtin_amdgcn_s_sleep(1);
        if ((++sp & 255u) == 0u) { if (xb_ld(&bar[XB_TMO])) break; if (sp > XB_SPIN_CAP) { atomicAdd(&bar[XB_TMO], 1u); break; } }
    }
    nloc = mine > 0u ? mine : 1u; nx = cnt > 0u ? cnt : 1u;
}

__device__ __forceinline__ void xcd_barrier(const XcdBarrier& b) {
    asm volatile("s_waitcnt vmcnt(0)" ::: "memory");
    __syncthreads();
    if (threadIdx.x == 0) {
        unsigned* bar = b.bar;
        __builtin_amdgcn_s_waitcnt(0);
        unsigned nloc = b.st[0], nx = b.st[1];
        if (nloc == 0u) { xcd_barrier_complete(bar, b.x, nloc, nx); b.st[0] = nloc; b.st[1] = nx; }
        const unsigned old = xb_add(&bar[XB_XSUB(b.x)], 1u);
        const unsigned gen = old / nloc;
        if (old + 1u == (gen + 1u) * nloc) {
            __builtin_amdgcn_fence(__ATOMIC_RELEASE, "agent");
            asm volatile("s_waitcnt vmcnt(0)" ::: "memory");
            const unsigned og = xb_add(&bar[XB_TOP], 1u);
            const unsigned tg = og / nx;
            if (og + 1u == (tg + 1u) * nx) xb_add(&bar[XB_TOPGEN], 1u);
            else XB_SPIN(xb_ld(&bar[XB_TOPGEN]) == tg, bar);
            __builtin_amdgcn_fence(__ATOMIC_ACQUIRE, "agent");
            xb_add(&bar[XB_XGEN(b.x)], 1u);
            asm volatile("s_waitcnt vmcnt(0)" ::: "memory");
        } else {
            XB_SPIN(xb_ld(&bar[XB_XGEN(b.x)]) == gen, bar);
            __builtin_amdgcn_fence(__ATOMIC_ACQUIRE, "agent");
            asm volatile("s_waitcnt vmcnt(0)" ::: "memory");
        }
    }
    __syncthreads();
}

namespace pg8 {
constexpr int BM = 256, BK = 64, HALF = 128, HTB = HALF * BK * 2  , STAGE_BYTES = 8 * HTB, NXCD = 8, WGM = 8;
__host__ __device__ __forceinline__ int lds_byte(int r, int c) { const int st = (r >> 4) * 2 + (c >> 5), rr = r & 15, cc = c & 31, ob = rr * 64 + cc * 2; return st * 1024 + (ob ^ (((ob >> 9) & 1) << 5)); }
__host__ __device__ __forceinline__ void stage_rc(int b, int& R, int& C) { const int st = b / 1024, sb = b % 1024, swz = sb ^ (((sb >> 9) & 1) << 5); R = (st >> 1) * 16 + swz / 64; C = (st & 1) * 32 + (swz % 64) / 2; }
__host__ __device__ __forceinline__ int perm32(int rho) { const int n = rho >> 4, i = rho & 15; return 8 * (i >> 2) + 4 * n + (i & 3); }

__host__ __device__ __forceinline__ int perm_rows(int R) { return (R & ~31) + perm32(R & 31); }
struct Unit { const char* A; const char* B; int pm, pn, aux; };

__device__ __forceinline__ bool static_tile(int nM, int nN, int G, int c, int i, int& pm, int& pn) {
    const int nwg = nM * nN; const long L = (long)i * G + c; if (L >= nwg) return false;
    int wgid = (int)L; { const int q = nwg / NXCD, r = nwg % NXCD, xcd = wgid % NXCD, off = wgid / NXCD; wgid = (xcd < r ? xcd * (q + 1) : r * (q + 1) + (xcd - r) * q) + off; }
    const int nig = WGM * nN, gid = wgid / nig, fm = gid * WGM, gsz = (nM - fm) < WGM ? (nM - fm) : WGM;
    pm = fm + ((wgid % nig) % gsz); pn = (wgid % nig) / gsz; return true;
}

template <class Epi, class Sched, bool GATHER>
__device__ __forceinline__ void gemm_run(LAS unsigned char* lds, const int K, const Sched& S, const Epi& E) {
    const int tid = tid_opaque(), wid = __builtin_amdgcn_readfirstlane(tid >> 6), lane = tid & 63, wr = wid >> 2, wc = wid & 3, fr = lane & 15, fq = lane >> 4;
    const int nt = K / BK;
    int Rr[2]; unsigned colb[2], voffB[2];
#pragma unroll
    for (int i = 0; i < 2; ++i) { int R, C; stage_rc(tid * 16 + i * 8192, R, C); const int Rb = Epi::brow(R);
        Rr[i] = R; colb[i] = (unsigned)C * 2u; voffB[i] = (unsigned)(Rb * K + C) * 2u; }
    const size_t kstep = (size_t)(BK * 2);
    const size_t hstep = (size_t)Epi::BHALF * K * 2;
    const unsigned ldsw = (unsigned)wid * 1024u;
    const int aoff = lds_byte(wr * 64 + fr, fq * 8), boff = lds_byte(wc * 32 + fr, fq * 8);
#define PG8_SA(b, h) (((b) * 2 + (h)) * HTB)
#define PG8_SB(b, h) ((4 + (b) * 2 + (h)) * HTB)
#define PG8_STAGE(bufoff, gbase, voff) do { _Pragma("unroll") for (int _i = 0; _i < 2; ++_i) \
        __builtin_amdgcn_global_load_lds((const unsigned*)((const char*)(gbase) + (voff)[_i]), (LAS unsigned*)(lds + (bufoff) + ldsw + _i * 8192), 16, 0, 0); } while (0)
#define PG8_LDA(dst, b, h) do { _Pragma("unroll") for (int m = 0; m < 4; ++m) _Pragma("unroll") for (int k = 0; k < 2; ++k) dst[m][k] = *(const LAS bf16x8*)(lds + PG8_SA(b, h) + aoff + m * 2048 + k * 1024); } while (0)
#define PG8_LDB(dst, b, h) do { _Pragma("unroll") for (int n = 0; n < 2; ++n) _Pragma("unroll") for (int k = 0; k < 2; ++k) dst[n][k] = *(const LAS bf16x8*)(lds + PG8_SB(b, h) + boff + n * 2048 + k * 1024); } while (0)
#define PG8_MMA(ai, bj, At, Bt) do { __builtin_amdgcn_s_setprio(1); _Pragma("unroll") for (int m = 0; m < 4; ++m) _Pragma("unroll") for (int n = 0; n < 2; ++n) _Pragma("unroll") for (int k = 0; k < 2; ++k) \
        acc[ai][bj][m][n] = __builtin_amdgcn_mfma_f32_16x16x32_bf16(Bt[n][k], At[m][k], acc[ai][bj][m][n], 0, 0, 0); __builtin_amdgcn_s_setprio(0); } while (0)
#define PG8_WAIT_V(n) asm volatile("s_waitcnt vmcnt(" #n ")" ::: "memory")
#define PG8_WAIT_L(n) asm volatile("s_waitcnt lgkmcnt(" #n ")" ::: "memory")
#define PG8_BAR __builtin_amdgcn_s_barrier()
#define PG8_SCHED __builtin_amdgcn_sched_barrier(0)
#define PG8_AOFF(o, u) do { _Pragma("unroll") for (int _h = 0; _h < 2; ++_h) _Pragma("unroll") for (int _i = 0; _i < 2; ++_i) { \
        const int _r = Rr[_i] + HALF * _h; const unsigned _row = GATHER ? (unsigned)S.arow(u, _r) : (unsigned)_r; o[_h][_i] = _row * (unsigned)(K * 2) + colb[_i]; } } while (0)
    Unit cur, nxt; int ui = 0;
    if (!S.next(0, cur)) return;
    f32x4 acc[2][2][4][2];
#pragma unroll
    for (int a = 0; a < 2; ++a)
#pragma unroll
        for (int b = 0; b < 2; ++b)
#pragma unroll
            for (int m = 0; m < 4; ++m)
#pragma unroll
                for (int n = 0; n < 2; ++n) acc[a][b][m][n] = (f32x4){0.f, 0.f, 0.f, 0.f};
    bf16x8 At[4][2], B0[2][2], B1[2][2];
    unsigned oA[2][2], nOA[2][2];
    const char* cA = cur.A; const char* cB = cur.B;
    PG8_AOFF(oA, cur);
#pragma unroll
    for (int h = 0; h < 2; ++h)
#pragma unroll
        for (int i = 0; i < 2; ++i) nOA[h][i] = oA[h][i];
    PG8_STAGE(PG8_SB(0, 0), cB, voffB); PG8_STAGE(PG8_SB(0, 1), cB + hstep, voffB); PG8_STAGE(PG8_SA(0, 0), cA, oA[0]); PG8_STAGE(PG8_SA(0, 1), cA, oA[1]);
    if (wr == 1) PG8_BAR;
    PG8_WAIT_V(2); PG8_BAR;
    PG8_STAGE(PG8_SB(1, 0), cB + kstep, voffB); PG8_STAGE(PG8_SA(1, 0), cA + kstep, oA[0]); PG8_STAGE(PG8_SB(1, 1), cB + hstep + kstep, voffB);
    PG8_WAIT_V(6); PG8_BAR;
    for (;;) {
        const bool has_next = S.next(ui + 1, nxt);
        const char* nA = has_next ? nxt.A : cA; const char* nB = has_next ? nxt.B : cB;
        if (GATHER) { if (has_next) { PG8_AOFF(nOA, nxt); } }
        for (int t = 0; t < nt; t += 2) {
            const bool last = (t == nt - 2);
            const char* a1 = cA + (size_t)(t + 1) * kstep;
            const char* a2 = last ? nA : cA + (size_t)(t + 2) * kstep; const char* b2 = last ? nB : cB + (size_t)(t + 2) * kstep;
            const char* a3 = a2 + kstep; const char* b3 = b2 + kstep;
            unsigned o2[2][2];
#pragma unroll
            for (int h = 0; h < 2; ++h)
#pragma unroll
                for (int i = 0; i < 2; ++i) o2[h][i] = (GATHER && last) ? nOA[h][i] : oA[h][i];
            PG8_LDB(B0, 0, 0); PG8_LDB(B1, 0, 1); PG8_SCHED; PG8_LDA(At, 0, 0); PG8_STAGE(PG8_SA(1, 1), a1, oA[1]);
            PG8_WAIT_V(8); PG8_WAIT_L(0); PG8_BAR; PG8_MMA(0, 0, At, B0); PG8_MMA(0, 1, At, B1); PG8_BAR; PG8_SCHED;
            PG8_LDA(At, 0, 1); PG8_STAGE(PG8_SB(0, 0), b2, voffB); PG8_STAGE(PG8_SB(0, 1), b2 + hstep, voffB); PG8_STAGE(PG8_SA(0, 0), a2, o2[0]);
            PG8_WAIT_V(8); PG8_WAIT_L(0); PG8_BAR; PG8_MMA(1, 0, At, B0); PG8_MMA(1, 1, At, B1); PG8_BAR; PG8_SCHED;
            PG8_LDB(B0, 1, 0); PG8_LDB(B1, 1, 1); PG8_SCHED; PG8_LDA(At, 1, 0); PG8_STAGE(PG8_SA(0, 1), a2, o2[1]);
            PG8_WAIT_V(8); PG8_WAIT_L(0); PG8_BAR; PG8_MMA(0, 0, At, B0); PG8_MMA(0, 1, At, B1); PG8_BAR; PG8_SCHED;
            PG8_LDA(At, 1, 1); PG8_STAGE(PG8_SB(1, 0), b3, voffB); PG8_STAGE(PG8_SB(1, 1), b3 + hstep, voffB); PG8_STAGE(PG8_SA(1, 0), a3, o2[0]);
            PG8_WAIT_V(8); PG8_WAIT_L(0); PG8_BAR; PG8_MMA(1, 0, At, B0); PG8_MMA(1, 1, At, B1); PG8_BAR; PG8_SCHED;
        }
        if (wr == 0) PG8_BAR;
        const bool keep = E(acc, cur, wr, wc, fr, fq);
        if (!has_next) break;
        if (!keep) {
#pragma unroll
            for (int a = 0; a < 2; ++a)
#pragma unroll
                for (int b = 0; b < 2; ++b)
#pragma unroll
                    for (int m = 0; m < 4; ++m)
#pragma unroll
                        for (int n = 0; n < 2; ++n) acc[a][b][m][n] = (f32x4){0.f, 0.f, 0.f, 0.f};
        }
        cur = nxt; cA = nA; cB = nB; ++ui;
        if (GATHER) {
#pragma unroll
            for (int h = 0; h < 2; ++h)
#pragma unroll
                for (int i = 0; i < 2; ++i) oA[h][i] = nOA[h][i];
        }
        if (wr == 1) PG8_BAR;
    }
    PG8_WAIT_V(0);
    PG8_BAR;
#undef PG8_SA
#undef PG8_SB
#undef PG8_STAGE
#undef PG8_LDA
#undef PG8_LDB
#undef PG8_MMA
#undef PG8_WAIT_V
#undef PG8_WAIT_L
#undef PG8_BAR
#undef PG8_SCHED
#undef PG8_AOFF
}
}
template <class RowMap>
__device__ __forceinline__ void transpose_item(const float* W, int K, int ld, bf16_t* WT, RowMap rowmap, LAS float* scr, int kb, int nb, int lane) {
    const int k0 = 64 * kb, n0 = 32 * nb;
#pragma unroll 8
    for (int i = 0; i < 32; ++i) { const int kk = 2 * i + (lane >> 5); scr[kk * 33 + (lane & 31)] = W[(size_t)(k0 + kk) * ld + n0 + (lane & 31)]; }
    asm volatile("s_waitcnt lgkmcnt(0)" ::: "memory");
    const int c = lane & 7;
#pragma unroll
    for (int j = 0; j < 4; ++j) { const int n = (lane >> 3) + 8 * j; const LAS float* s = scr + (8 * c) * 33 + n;
        u32x4 o; o.x = cvt_pk_bf16(s[0 * 33], s[1 * 33]); o.y = cvt_pk_bf16(s[2 * 33], s[3 * 33]); o.z = cvt_pk_bf16(s[4 * 33], s[5 * 33]); o.w = cvt_pk_bf16(s[6 * 33], s[7 * 33]);
        *(u32x4*)(WT + (size_t)rowmap(n0 + n) * K + k0 + 8 * c) = o; }
    asm volatile("s_waitcnt lgkmcnt(0)" ::: "memory");
}
template <class RowMap>
__device__ __forceinline__ void transpose_item64(const float* W, int K, int ld, bf16_t* WT, RowMap rowmap, LAS float* scr, int kb, int nb, int lane) {
    const int k0 = 64 * kb, n0 = 64 * nb, lr = lane >> 4, lc = (lane & 15) * 4;
    f32x4 v[16];
#pragma unroll
    for (int i = 0; i < 16; ++i) v[i] = *(const f32x4*)(W + (size_t)(k0 + 4 * i + lr) * ld + n0 + lc);
#pragma unroll
    for (int i = 0; i < 16; ++i) { LAS float* d = scr + (4 * i + lr) * 65 + lc; d[0] = v[i].x; d[1] = v[i].y; d[2] = v[i].z; d[3] = v[i].w; }
    asm volatile("s_waitcnt lgkmcnt(0)" ::: "memory");
    const int c = lane & 7;
#pragma unroll
    for (int j = 0; j < 8; ++j) { const int n = (lane >> 3) + 8 * j; const LAS float* s = scr + (8 * c) * 65 + n;
        u32x4 o; o.x = cvt_pk_bf16(s[0 * 65], s[1 * 65]); o.y = cvt_pk_bf16(s[2 * 65], s[3 * 65]); o.z = cvt_pk_bf16(s[4 * 65], s[5 * 65]); o.w = cvt_pk_bf16(s[6 * 65], s[7 * 65]);
        *(u32x4*)(WT + (size_t)rowmap(n0 + n) * K + k0 + 8 * c) = o; }
    asm volatile("s_waitcnt lgkmcnt(0)" ::: "memory");
}
struct RowId { int off; __device__ __forceinline__ int operator()(int n) const { return off + n; } };
struct RowUp { int which; __device__ __forceinline__ int operator()(int n) const { return 256 * (n >> 7) + 128 * which + (n & 127); } };

__device__ __forceinline__ void p0_prologue(LAS unsigned char* lds, const float* const* in, unsigned char* ws, int G) {
    const int tid = tid_opaque(), lane = tid & 63, wave = __builtin_amdgcn_readfirstlane(tid >> 6);
    const int gw = blockIdx.x * NWAVES + wave, NGW = G * NWAVES;
    LAS float* scr = (LAS float*)(lds + wave * 16640);
    const float* w_in = in[2]; const float* w_da = in[15]; const float* w_ml = in[16]; const float* w_gate = in[17]; const float* w_out = in[19];
    bf16_t* WinT = (bf16_t*)(ws + WS_WIN); bf16_t* WdaT = (bf16_t*)(ws + WS_WDA); bf16_t* WmlT = (bf16_t*)(ws + WS_WML); bf16_t* WoutT = (bf16_t*)(ws + WS_WOUT);
    constexpr int I_IN = 16 * (3584 / 64), I_G = 16 * (2048 / 64), I_DA = 8 * (1024 / 64), I_ML = I_DA, I_OUT = 16 * (1024 / 64);
    constexpr int NITEMS = I_IN + I_G + I_DA + I_ML + I_OUT;
    for (int it = gw; it < NITEMS; it += NGW) {
        int r = it;
        if (r < I_IN) { transpose_item64(w_in, 1024, IN_W, WinT, RowId{0}, scr, r / 56, r % 56, lane); continue; } r -= I_IN;
        if (r < I_G) { transpose_item64(w_gate, 1024, 2048, WinT, RowId{3584}, scr, r / 32, r % 32, lane); continue; } r -= I_G;
        if (r < I_DA) { transpose_item64(w_da, 512, 1024, WdaT, RowId{0}, scr, r / 16, r % 16, lane); continue; } r -= I_DA;
        if (r < I_ML) { transpose_item64(w_ml, 512, 1024, WmlT, RowId{0}, scr, r / 16, r % 16, lane); continue; } r -= I_ML;
        transpose_item64(w_out, 1024, 1024, WoutT, RowId{0}, scr, r / 16, r % 16, lane);
    }
    __syncthreads();
    LAS float* wif = (LAS float*)lds;
    for (int i = tid; i < 8192; i += NTHREADS) { const int d = i >> 3, j = i & 7; wif[j * 1024 + d] = w_in[(size_t)d * IN_W + 3584 + j]; }
    __syncthreads();
    const float* x = in[0]; const float* g = in[1]; const float* ib = in[12]; const float* fb = in[13];
    bf16_t* HB = (bf16_t*)(ws + WS_HB); float* IFP = (float*)(ws + WS_IFP);
    f32x4 gv[4];
#pragma unroll
    for (int j = 0; j < 4; ++j) gv[j] = *(const f32x4*)(g + lane * 4 + 256 * j);
    for (int row0 = gw * 2; row0 < T; row0 += NGW * 2) {
        f32x4 v[2][4]; float s[2] = {0.f, 0.f};
#pragma unroll
        for (int r = 0; r < 2; ++r) { const f32x4* xr = (const f32x4*)(x + (size_t)(row0 + r) * D) + lane;
#pragma unroll
            for (int j = 0; j < 4; ++j) v[r][j] = xr[64 * j]; }
#pragma unroll
        for (int r = 0; r < 2; ++r) {
#pragma unroll
            for (int j = 0; j < 4; ++j) s[r] += (v[r][j].x * v[r][j].x + v[r][j].y * v[r][j].y) + (v[r][j].z * v[r][j].z + v[r][j].w * v[r][j].w);
            const float rstd = 1.0f / sqrtf(wave_sum(s[r]) * (1.f / D) + NORM_EPS);
            unsigned long long* o8 = (unsigned long long*)(HB + (size_t)(row0 + r) * D) + lane;
#pragma unroll
            for (int j = 0; j < 4; ++j) { v[r][j] = v[r][j] * rstd * gv[j];
                o8[64 * j] = (unsigned long long)cvt_pk_bf16(v[r][j].x, v[r][j].y) | ((unsigned long long)cvt_pk_bf16(v[r][j].z, v[r][j].w) << 32); }
        }
        float p[16];
#pragma unroll
        for (int c = 0; c < 8; ++c) {
            f32x4 w[4];
#pragma unroll
            for (int j = 0; j < 4; ++j) w[j] = *(const LAS f32x4*)(wif + c * 1024 + lane * 4 + 256 * j);
#pragma unroll
            for (int r = 0; r < 2; ++r) { float a = 0.f;
#pragma unroll
                for (int j = 0; j < 4; ++j) a += (v[r][j].x * w[j].x + v[r][j].y * w[j].y) + (v[r][j].z * w[j].z + v[r][j].w * w[j].w);
                p[r * 8 + c] = a; }
        }
        { const bool up = (lane & 32) != 0;
#pragma unroll
          for (int i = 0; i < 8; ++i) { const float send = up ? p[i] : p[8 + i]; const float keep = up ? p[8 + i] : p[i]; p[i] = keep + __shfl_xor(send, 32); } }
        { const bool up = (lane & 16) != 0;
#pragma unroll
          for (int i = 0; i < 4; ++i) { const float send = up ? p[i] : p[4 + i]; const float keep = up ? p[4 + i] : p[i]; p[i] = keep + __shfl_xor(send, 16); } }
        { const bool up = (lane & 8) != 0;
#pragma unroll
          for (int i = 0; i < 2; ++i) { const float send = up ? p[i] : p[2 + i]; const float keep = up ? p[2 + i] : p[i]; p[i] = keep + __shfl_xor(send, 8); } }
        { const bool up = (lane & 4) != 0; const float send = up ? p[0] : p[1]; const float keep = up ? p[1] : p[0]; p[0] = keep + __shfl_xor(send, 4); }
        p[0] += __shfl_xor(p[0], 2); p[0] += __shfl_xor(p[0], 1);
        if ((lane & 3) == 0) {
            const int idx = ((lane >> 5) & 1) * 8 + ((lane >> 4) & 1) * 4 + ((lane >> 3) & 1) * 2 + ((lane >> 2) & 1);
            const int r = idx >> 3, c = idx & 7;
            float val = p[0];
            if (c < 4) val += ib[c];
            else { const float z = val + fb[c - 4]; val = fminf(z, 0.f) - log1pf(__expf(-fabsf(z))); }
            IFP[(size_t)(row0 + r) * 8 + c] = val;
        }
    }
}

__device__ __forceinline__ void moe_weight_convert(LAS unsigned char* lds, const float* const* in, unsigned char* ws, int G) {
    const int tid = tid_opaque(), lane = tid & 63, wave = __builtin_amdgcn_readfirstlane(tid >> 6);
    const int gw = blockIdx.x * NWAVES + wave, NGW = G * NWAVES;
    LAS float* scr = (LAS float*)(lds + wave * 16640);
    const float* w1 = in[25]; const float* w3 = in[26]; const float* w2 = in[27];
    bf16_t* W13 = (bf16_t*)(ws + WS_W13); bf16_t* W2T = (bf16_t*)(ws + WS_W2);
    constexpr int I_UP = 16 * 8;
    constexpr int I_DN = 8 * 16;
    constexpr int NIT = NEXP * (2 * I_UP + I_DN);
    for (int it = gw; it < NIT; it += NGW) {
        const int e = it / (2 * I_UP + I_DN); int r = it % (2 * I_UP + I_DN);
        if (r < I_UP) { transpose_item64(w1 + (size_t)e * 1024 * 512, 1024, 512, W13 + (size_t)e * 1024 * 1024, RowUp{0}, scr, r / 8, r % 8, lane); continue; } r -= I_UP;
        if (r < I_UP) { transpose_item64(w3 + (size_t)e * 1024 * 512, 1024, 512, W13 + (size_t)e * 1024 * 1024, RowUp{1}, scr, r / 8, r % 8, lane); continue; } r -= I_UP;
        transpose_item64(w2 + (size_t)e * 512 * 1024, 512, 1024, W2T + (size_t)e * 1024 * 512, RowId{0}, scr, r / 16, r % 16, lane);
    }
}

__device__ __forceinline__ void da_qk_norm(unsigned char* ws, const float* gq, const float* gk, int G) {
    const int tid = tid_opaque(), lane = tid & 63, wave = __builtin_amdgcn_readfirstlane(tid >> 6);
    const int gw = blockIdx.x * NWAVES + wave, NGW = G * NWAVES;
    bf16_t* P = (bf16_t*)(ws + WS_P);
    const bool isq = lane < 32; const float* gsrc = (isq ? gq : gk) + (lane & 3) * 16; const float extra = isq ? (0.125f * LOG2E) : 1.0f;
    float gn[16];
#pragma unroll
    for (int i = 0; i < 16; ++i) gn[i] = gsrc[i] * extra;
    for (int row = gw; row < T; row += NGW) {
        u32x4* p = (u32x4*)(P + (size_t)row * PW + lane * 16);
        const u32x4 a = p[0], b = p[1];
        float v[16];
        v[0] = bf_lo(a.x); v[1] = bf_hi(a.x); v[2] = bf_lo(a.y); v[3] = bf_hi(a.y); v[4] = bf_lo(a.z); v[5] = bf_hi(a.z); v[6] = bf_lo(a.w); v[7] = bf_hi(a.w);
        v[8] = bf_lo(b.x); v[9] = bf_hi(b.x); v[10] = bf_lo(b.y); v[11] = bf_hi(b.y); v[12] = bf_lo(b.z); v[13] = bf_hi(b.z); v[14] = bf_lo(b.w); v[15] = bf_hi(b.w);
        float s = 0.f;
#pragma unroll
        for (int i = 0; i < 16; ++i) s += v[i] * v[i];
        s += __shfl_xor(s, 1); s += __shfl_xor(s, 2);
        const float rstd = 1.0f / sqrtf(s * (1.f / 64.f) + NORM_EPS);
#pragma unroll
        for (int i = 0; i < 16; ++i) v[i] = v[i] * rstd * gn[i];
        u32x4 oa, ob;
        oa.x = cvt_pk_bf16(v[0], v[1]); oa.y = cvt_pk_bf16(v[2], v[3]); oa.z = cvt_pk_bf16(v[4], v[5]); oa.w = cvt_pk_bf16(v[6], v[7]);
        ob.x = cvt_pk_bf16(v[8], v[9]); ob.y = cvt_pk_bf16(v[10], v[11]); ob.z = cvt_pk_bf16(v[12], v[13]); ob.w = cvt_pk_bf16(v[14], v[15]);
        p[0] = oa; p[1] = ob;
    }
}
typedef short v4i16_t __attribute__((ext_vector_type(4)));
constexpr int AT_KSTR = 1040;
constexpr int AT_KBUF = 16 * AT_KSTR;
constexpr int AT_QSTR = 528, AT_QBUF = 16 * AT_QSTR;
constexpr int AT_KOFF = 0, AT_VOFF = 2 * AT_KBUF, AT_QOFF = AT_VOFF + 2 * 16384;
static_assert(AT_QOFF + 8 * AT_QBUF <= LDS_MISC_OFF, "attention LDS");
__device__ __forceinline__ int crow(int r, int hi) { return (r & 3) + 8 * (r >> 2) + 4 * hi; }
__device__ __forceinline__ int v_off(int row, int ch) { return 2048 * (row >> 3) + 512 * (ch >> 2) + 64 * (row & 7) + 16 * ((ch & 3) ^ ((row >> 2) & 3)); }

__device__ __forceinline__ void attn_unit(LAS unsigned char* lds, const bf16_t* P, bf16_t* YDA, int b, int h, int qb, float lam, float mref, float slope2, const float* gout) {
    const int tid = tid_opaque(), lane = tid & 63, r32 = lane & 31, hh = lane >> 5, wid = __builtin_amdgcn_readfirstlane(tid >> 6);
    const int rowbase = b * SEQ;
    const int q0 = qb * 256 + wid * 32;
    const int qpos = q0 + r32;
    LAS unsigned char* Qw = lds + AT_QOFF + wid * AT_QBUF;
    const __amdgpu_buffer_rsrc_t prs = __builtin_amdgcn_make_buffer_rsrc((void*)P, 0, (int)0x7fffffff, 0x00020000);
    const int pbase = (rowbase * PW + h * 128) * 2;
    { const int qo = ((lane >> 4) * PW + PC_Q + (lane & 15) * 8) * 2;
#pragma unroll
      for (int i = 0; i < 8; ++i) { const int r = (lane >> 4) + 4 * i; const u32x4 v = __builtin_amdgcn_raw_buffer_load_b128(prs, qo, pbase + (q0 + 4 * i) * PW * 2, 0);
          *(LAS u32x4*)(Qw + (lane & 15) * AT_QSTR + r * 16) = v; } }
    const LAS unsigned char* qrd = Qw + hh * AT_QSTR + r32 * 16;
    f32x16 o1[4], o2[4];
#pragma unroll
    for (int t = 0; t < 4; ++t) { o1[t] = f32x16{}; o2[t] = f32x16{}; }
    float l1 = 0.f, l2 = 0.f;
    const int ntiles = 4 * qb + 4;
    const int sch = tid & 15;
    unsigned kdst[2], vdst[2]; int goff[2];
#pragma unroll
    for (int i = 0; i < 2; ++i) { const int r = (tid >> 4) + 32 * i; goff[i] = (r * PW + PC_K + sch * 8) * 2;
        kdst[i] = (unsigned)(sch * AT_KSTR + r * 16);
        vdst[i] = (unsigned)v_off(r, sch); }
    u32x4 kreg[2], vreg[2];
#define AT_LOADT(kt) do { const int _so = pbase + (kt) * 64 * PW * 2; _Pragma("unroll") for (int _i = 0; _i < 2; ++_i) { \
        kreg[_i] = __builtin_amdgcn_raw_buffer_load_b128(prs, goff[_i], _so, 0); vreg[_i] = __builtin_amdgcn_raw_buffer_load_b128(prs, goff[_i] + (PC_V - PC_K) * 2, _so, 0); } } while (0)
#define AT_WRITET(buf) do { _Pragma("unroll") for (int _i = 0; _i < 2; ++_i) { \
        *(LAS u32x4*)(lds + AT_KOFF + (buf) * AT_KBUF + kdst[_i]) = kreg[_i]; *(LAS u32x4*)(lds + AT_VOFF + (buf) * 16384 + vdst[_i]) = vreg[_i]; } } while (0)
    AT_LOADT(ntiles - 1); AT_WRITET(0); __syncthreads();
    const int tg = lane >> 4, tq = (lane >> 2) & 3, tp = lane & 3;
    const int vlo = 64 * (4 * hh + tq) + 16 * ((2 * (tg & 1) + (tp >> 1)) ^ hh) + 8 * (tp & 1);
    const int vhi = 64 * (4 * hh + tq) + 16 * ((2 * (tg & 1) + (tp >> 1)) ^ (hh + 2)) + 8 * (tp & 1);
    const int klane = hh * AT_KSTR + r32 * 16;
    for (int it = 0; it < ntiles; ++it) {
        const int kt = ntiles - 1 - it, cur = it & 1;
        if (it + 1 < ntiles) AT_LOADT(kt - 1);
        const int kb0 = kt * 64;
        const LAS unsigned char* Kb = lds + AT_KOFF + cur * AT_KBUF + klane;
        const LAS unsigned char* Vlo = lds + AT_VOFF + cur * 16384 + vlo;
        const LAS unsigned char* Vhi = lds + AT_VOFF + cur * 16384 + vhi;
#pragma unroll
        for (int sb = 0; sb < 2; ++sb) {
            const int kb = kb0 + 32 * sb;
            if (kb <= q0 + 31) {
                const float base = slope2 * (float)(kb + 4 * hh - qpos) - mref;
                bf16x8 pf1[2], pf2[2];
#pragma unroll
                for (int mp = 0; mp < 2; ++mp) {
                    f32x16 sc;
#pragma unroll
                    for (int r = 0; r < 16; ++r) sc[r] = __builtin_fmaf(slope2, (float)((r & 3) + 8 * (r >> 2)), base);
#pragma unroll
                    for (int dd = 0; dd < 4; ++dd) {
                        const bf16x8 ka = *(const LAS bf16x8*)(Kb + (mp * 8 + dd * 2) * AT_KSTR + sb * 512);
                        const bf16x8 qa = *(const LAS bf16x8*)(qrd + (mp * 8 + dd * 2) * AT_QSTR);
                        sc = __builtin_amdgcn_mfma_f32_32x32x16_bf16(ka, qa, sc, 0, 0, 0);
                    }
                    if (kb + 31 > q0) {
#pragma unroll
                        for (int r = 0; r < 16; ++r) { const bool dead = (kb + crow(r, hh)) > qpos; sc[r] = dead ? -INFINITY : sc[r]; }
                    }
                    float ls = 0.f;
#pragma unroll
                    for (int r = 0; r < 16; ++r) { sc[r] = __builtin_amdgcn_exp2f(sc[r]); ls += sc[r]; }
#pragma unroll
                    for (int s = 0; s < 2; ++s) {
                        u32x4 w;
                        w.x = cvt_pk_bf16(sc[8 * s + 0], sc[8 * s + 1]); w.y = cvt_pk_bf16(sc[8 * s + 2], sc[8 * s + 3]); w.z = cvt_pk_bf16(sc[8 * s + 4], sc[8 * s + 5]); w.w = cvt_pk_bf16(sc[8 * s + 6], sc[8 * s + 7]);
                        if (mp == 0) pf1[s] = __builtin_bit_cast(bf16x8, w); else pf2[s] = __builtin_bit_cast(bf16x8, w);
                    }
                    if (mp == 0) l1 += ls; else l2 += ls;
                }
#pragma unroll
                for (int s = 0; s < 2; ++s) {
#pragma unroll
                    for (int t = 0; t < 4; ++t) {
                        const s16x4 lo = __builtin_bit_cast(s16x4, __builtin_amdgcn_ds_read_tr16_b64_v4i16((LAS v4i16_t*)(Vlo + 2048 * (4 * sb + 2 * s) + 512 * t)));
                        const s16x4 hi = __builtin_bit_cast(s16x4, __builtin_amdgcn_ds_read_tr16_b64_v4i16((LAS v4i16_t*)(Vhi + 2048 * (4 * sb + 2 * s + 1) + 512 * t)));
                        const bf16x8 vf = (bf16x8){lo[0], lo[1], lo[2], lo[3], hi[0], hi[1], hi[2], hi[3]};
                        o1[t] = __builtin_amdgcn_mfma_f32_32x32x16_bf16(vf, pf1[s], o1[t], 0, 0, 0);
                        o2[t] = __builtin_amdgcn_mfma_f32_32x32x16_bf16(vf, pf2[s], o2[t], 0, 0, 0);
                    }
                }
            }
        }
        if (it + 1 < ntiles) AT_WRITET(cur ^ 1);
        __syncthreads();
    }
#undef AT_LOADT
#undef AT_WRITET
    l1 += __shfl_xor(l1, 32); l2 += __shfl_xor(l2, 32);
    const float inv1 = 1.0f / l1, c2 = lam / l2;
    float ss = 0.f;
#pragma unroll
    for (int t = 0; t < 4; ++t)
#pragma unroll
        for (int r = 0; r < 16; ++r) { const float v = o1[t][r] * inv1 - o2[t][r] * c2; o1[t][r] = v; ss += v * v; }
    ss += __shfl_xor(ss, 32);
    const float rstd = 0.8f / sqrtf(ss * (1.f / 128.f) + NORM_EPS);
    bf16_t* yrow = YDA + (size_t)(rowbase + qpos) * 512 + h * 128 + 4 * hh;
#pragma unroll
    for (int t = 0; t < 4; ++t)
#pragma unroll
        for (int g4 = 0; g4 < 4; ++g4) {
            const f32x4 gv = *(const f32x4*)(gout + 32 * t + 8 * g4 + 4 * hh);
            u32x2 w; w.x = cvt_pk_bf16(o1[t][4 * g4 + 0] * rstd * gv.x, o1[t][4 * g4 + 1] * rstd * gv.y); w.y = cvt_pk_bf16(o1[t][4 * g4 + 2] * rstd * gv.z, o1[t][4 * g4 + 3] * rstd * gv.w);
            *(u32x2*)(yrow + 32 * t + 8 * g4) = w;
        }
}

__device__ __forceinline__ void attn_unit2(LAS unsigned char* lds, const bf16_t* P, bf16_t* YDA, int b, int h, int j, int kt_lo, float lam, float mref, float slope2, const float* gout) {
    const int tid = tid_opaque(), lane = tid & 63, r32 = lane & 31, hh = lane >> 5, wid = __builtin_amdgcn_readfirstlane(tid >> 6);
    const int rg = wid & 3, mp = wid >> 2;
    const int rowbase = b * SEQ;
    const int q0 = j * 128 + rg * 32;
    const int qpos = q0 + r32;
    const __amdgpu_buffer_rsrc_t prs = __builtin_amdgcn_make_buffer_rsrc((void*)P, 0, (int)0x7fffffff, 0x00020000);
    const int pbase = (rowbase * PW + h * 128) * 2;
    LAS unsigned char* Qw = lds + AT_QOFF + rg * AT_QBUF;
    { const int ch = mp * 8 + (lane & 7); const int qo = ((lane >> 3) * PW + PC_Q + ch * 8) * 2;
#pragma unroll
      for (int i = 0; i < 4; ++i) { const int r = (lane >> 3) + 8 * i; const u32x4 v = __builtin_amdgcn_raw_buffer_load_b128(prs, qo, pbase + (q0 + 8 * i) * PW * 2, 0);
          *(LAS u32x4*)(Qw + ch * AT_QSTR + r * 16) = v; } }
    const LAS unsigned char* qrd = Qw + (mp * 8 + hh) * AT_QSTR + r32 * 16;
    f32x16 o[4];
#pragma unroll
    for (int t = 0; t < 4; ++t) o[t] = f32x16{};
    float l = 0.f;
    const int kt_hi = 2 * j + 1, ntiles = kt_hi - kt_lo + 1;
    const int sch = tid & 15;
    unsigned kdst[2], vdst[2]; int goff[2];
#pragma unroll
    for (int i = 0; i < 2; ++i) { const int r = (tid >> 4) + 32 * i; goff[i] = (r * PW + PC_K + sch * 8) * 2;
        kdst[i] = (unsigned)(sch * AT_KSTR + r * 16);
        vdst[i] = (unsigned)v_off(r, sch); }
    u32x4 kreg[2], vreg[2];
#define AT_LOADT(kt) do { const int _so = pbase + (kt) * 64 * PW * 2; _Pragma("unroll") for (int _i = 0; _i < 2; ++_i) { \
        kreg[_i] = __builtin_amdgcn_raw_buffer_load_b128(prs, goff[_i], _so, 0); vreg[_i] = __builtin_amdgcn_raw_buffer_load_b128(prs, goff[_i] + (PC_V - PC_K) * 2, _so, 0); } } while (0)
#define AT_WRITET(buf) do { _Pragma("unroll") for (int _i = 0; _i < 2; ++_i) { \
        *(LAS u32x4*)(lds + AT_KOFF + (buf) * AT_KBUF + kdst[_i]) = kreg[_i]; *(LAS u32x4*)(lds + AT_VOFF + (buf) * 16384 + vdst[_i]) = vreg[_i]; } } while (0)
    AT_LOADT(kt_hi); AT_WRITET(0); __syncthreads();
    const int tg = lane >> 4, tq = (lane >> 2) & 3, tp = lane & 3;
    const int vlo = 64 * (4 * hh + tq) + 16 * ((2 * (tg & 1) + (tp >> 1)) ^ hh) + 8 * (tp & 1);
    const int vhi = 64 * (4 * hh + tq) + 16 * ((2 * (tg & 1) + (tp >> 1)) ^ (hh + 2)) + 8 * (tp & 1);
    const int klane = (mp * 8 + hh) * AT_KSTR + r32 * 16;
    for (int it = 0; it < ntiles; ++it) {
        const int kt = kt_hi - it, cur = it & 1;
        if (it + 1 < ntiles) AT_LOADT(kt - 1);
        const int kb0 = kt * 64;
        const LAS unsigned char* Kb = lds + AT_KOFF + cur * AT_KBUF + klane;
        const LAS unsigned char* Vlo = lds + AT_VOFF + cur * 16384 + vlo;
        const LAS unsigned char* Vhi = lds + AT_VOFF + cur * 16384 + vhi;
#pragma unroll
        for (int sb = 0; sb < 2; ++sb) {
            const int kb = kb0 + 32 * sb;
            if (kb <= q0 + 31) {
                const float base = slope2 * (float)(kb + 4 * hh - qpos) - mref;
                f32x16 sc;
#pragma unroll
                for (int r = 0; r < 16; ++r) sc[r] = __builtin_fmaf(slope2, (float)((r & 3) + 8 * (r >> 2)), base);
#pragma unroll
                for (int dd = 0; dd < 4; ++dd) {
                    const bf16x8 ka = *(const LAS bf16x8*)(Kb + (dd * 2) * AT_KSTR + sb * 512);
                    const bf16x8 qa = *(const LAS bf16x8*)(qrd + (dd * 2) * AT_QSTR);
                    sc = __builtin_amdgcn_mfma_f32_32x32x16_bf16(ka, qa, sc, 0, 0, 0);
                }
                if (kb + 31 > q0) {
#pragma unroll
                    for (int r = 0; r < 16; ++r) { const bool dead = (kb + crow(r, hh)) > qpos; sc[r] = dead ? -INFINITY : sc[r]; }
                }
#pragma unroll
                for (int r = 0; r < 16; ++r) { sc[r] = __builtin_amdgcn_exp2f(sc[r]); l += sc[r]; }
                bf16x8 pf[2];
#pragma unroll
                for (int s = 0; s < 2; ++s) {
                    u32x4 w;
                    w.x = cvt_pk_bf16(sc[8 * s + 0], sc[8 * s + 1]); w.y = cvt_pk_bf16(sc[8 * s + 2], sc[8 * s + 3]); w.z = cvt_pk_bf16(sc[8 * s + 4], sc[8 * s + 5]); w.w = cvt_pk_bf16(sc[8 * s + 6], sc[8 * s + 7]);
                    pf[s] = __builtin_bit_cast(bf16x8, w);
                }
#pragma unroll
                for (int s = 0; s < 2; ++s) {
#pragma unroll
                    for (int t = 0; t < 4; ++t) {
                        const s16x4 lo = __builtin_bit_cast(s16x4, __builtin_amdgcn_ds_read_tr16_b64_v4i16((LAS v4i16_t*)(Vlo + 2048 * (4 * sb + 2 * s) + 512 * t)));
                        const s16x4 hi = __builtin_bit_cast(s16x4, __builtin_amdgcn_ds_read_tr16_b64_v4i16((LAS v4i16_t*)(Vhi + 2048 * (4 * sb + 2 * s + 1) + 512 * t)));
                        const bf16x8 vf = (bf16x8){lo[0], lo[1], lo[2], lo[3], hi[0], hi[1], hi[2], hi[3]};
                        o[t] = __builtin_amdgcn_mfma_f32_32x32x16_bf16(vf, pf[s], o[t], 0, 0, 0);
                    }
                }
            }
        }
        if (it + 1 < ntiles) AT_WRITET(cur ^ 1);
        __syncthreads();
    }
#undef AT_LOADT
#undef AT_WRITET
    l += __shfl_xor(l, 32);
    LAS float* CB = (LAS float*)(lds + AT_KOFF + rg * 16384) + lane;
    if (mp == 1) {
        const float c2 = lam / l;
#pragma unroll
        for (int t = 0; t < 4; ++t)
#pragma unroll
            for (int r = 0; r < 16; ++r) CB[(t * 16 + r) * 64] = o[t][r] * c2;
    }
    __syncthreads();
    if (mp == 0) {
        const float inv1 = 1.0f / l;
        float ss = 0.f;
#pragma unroll
        for (int t = 0; t < 4; ++t)
#pragma unroll
            for (int r = 0; r < 16; ++r) { const float v = o[t][r] * inv1 - CB[(t * 16 + r) * 64]; o[t][r] = v; ss += v * v; }
        ss += __shfl_xor(ss, 32);
        const float rstd = 0.8f / sqrtf(ss * (1.f / 128.f) + NORM_EPS);
        bf16_t* yrow = YDA + (size_t)(rowbase + qpos) * 512 + h * 128 + 4 * hh;
#pragma unroll
        for (int t = 0; t < 4; ++t)
#pragma unroll
            for (int g4 = 0; g4 < 4; ++g4) {
                const f32x4 gv = *(const f32x4*)(gout + 32 * t + 8 * g4 + 4 * hh);
                u32x2 w; w.x = cvt_pk_bf16(o[t][4 * g4 + 0] * rstd * gv.x, o[t][4 * g4 + 1] * rstd * gv.y); w.y = cvt_pk_bf16(o[t][4 * g4 + 2] * rstd * gv.z, o[t][4 * g4 + 3] * rstd * gv.w);
                *(u32x2*)(yrow + 32 * t + 8 * g4) = w;
            }
    }
    __syncthreads();
}

__device__ __forceinline__ int attn_kt_lo(int j, float dh) { const float f = (128.f * (float)j - 63.f - dh) * (1.f / 64.f); const int k = f >= 0.f ? (int)floorf(f) + 1 : 0; return k > 2 * j + 1 ? 2 * j + 1 : k; }

__device__ __forceinline__ void attn_phase(LAS unsigned char* lds, const float* const* in, unsigned char* ws, int G) {
    const bf16_t* P = (const bf16_t*)(ws + WS_P); bf16_t* YDA = (bf16_t*)(ws + WS_YDA);
    const float* gq = in[3]; const float* gk = in[4]; const float* lq1 = in[5]; const float* lk1 = in[6]; const float* lq2 = in[7]; const float* lk2 = in[8]; const float* gout = in[9];
    float mq = 0.f, mk = 0.f, a1 = 0.f, a2 = 0.f;
    for (int i = 0; i < 64; ++i) { mq = fmaxf(mq, fabsf(gq[i])); mk = fmaxf(mk, fabsf(gk[i])); a1 += lq1[i] * lk1[i]; a2 += lq2[i] * lk2[i]; }
    const float lam = __expf(a1) - __expf(a2) + 0.2f;
    const float mref = 8.0f * mq * mk * LOG2E * 1.02f + 0.25f;
    const float thr = 2.0f * mref + 45.0f;
    const int tid = tid_opaque(), lane = tid & 63;
    LAS int* cst = (LAS int*)(lds + AT_QOFF); LAS int* sel = cst + 128;
    const int b = blockIdx.x & 7, bin = blockIdx.x >> 3;
    if (tid < 128) { const int hh_ = tid >> 5, j = tid & 31; const float s2 = exp2f(-2.0f * (float)(hh_ + 1)) * LOG2E; cst[tid] = 2 * j + 2 - attn_kt_lo(j, thr / s2); }
    __syncthreads();
    if (tid < 128) { const int c = cst[tid]; int rk = 0;
        for (int v = 0; v < 128; ++v) { const int cv = cst[v]; rk += (cv > c || (cv == c && v < tid)) ? 1 : 0; }
        if (rk == bin) sel[0] = tid; if (rk == 63 - bin) sel[1] = tid; if (rk == 64 + bin) sel[2] = tid; if (rk == 127 - bin) sel[3] = tid; }
    __syncthreads();
    int us[4];
#pragma unroll
    for (int i = 0; i < 4; ++i) us[i] = sel[i];
    __syncthreads();
    if (blockIdx.x < 256) {
#pragma unroll 1
        for (int i = 0; i < 4; ++i) { const int u = __builtin_amdgcn_readfirstlane(us[i]); const int h = u >> 5, j = u & 31;
            const float slope2 = exp2f(-2.0f * (float)(h + 1)) * LOG2E;
            attn_unit2(lds, P, YDA, b, h, j, attn_kt_lo(j, thr / slope2), lam, mref, slope2, gout); }
    }
}
constexpr int ML_L = 256, ML_NC = SEQ / ML_L, ML_UNITS = NBATCH * 4 * ML_NC;
constexpr size_t MO_U = 0;
constexpr size_t MO_NL = MO_U + (size_t)ML_UNITS * 16384 * 4;
constexpr size_t MO_GU = MO_NL + (size_t)ML_UNITS * 128 * 4;
constexpr size_t MO_C = MO_GU + (size_t)ML_UNITS * 2 * 4;
constexpr size_t MO_N = MO_C + (size_t)ML_UNITS * 16384 * 2;
constexpr size_t MO_M = MO_N + (size_t)ML_UNITS * 128 * 4;
constexpr size_t MO_END = MO_M + (size_t)ML_UNITS * 4;
static_assert(MO_END <= (size_t)T * D * 4, "mLSTM scratch must fit the output buffer");

__device__ __forceinline__ u32x4 ml_conv8(const bf16_t* P, size_t t, int pos, int ch, const float* cw, const float* cb, float scale) {
    float acc[8];
    { const f32x4 b0 = *(const f32x4*)(cb + ch), b1 = *(const f32x4*)(cb + ch + 4);
      acc[0] = b0.x; acc[1] = b0.y; acc[2] = b0.z; acc[3] = b0.w; acc[4] = b1.x; acc[5] = b1.y; acc[6] = b1.z; acc[7] = b1.w; }
#pragma unroll
    for (int j = 0; j < 4; ++j) {
        if (pos - 3 + j >= 0) {
            const u32x4 u = *(const u32x4*)(P + (t - 3 + j) * PW + PC_MQ + ch);
            const f32x4 w0 = *(const f32x4*)(cw + j * 1024 + ch), w1 = *(const f32x4*)(cw + j * 1024 + ch + 4);
            acc[0] += bf_lo(u.x) * w0.x; acc[1] += bf_hi(u.x) * w0.y; acc[2] += bf_lo(u.y) * w0.z; acc[3] += bf_hi(u.y) * w0.w;
            acc[4] += bf_lo(u.z) * w1.x; acc[5] += bf_hi(u.z) * w1.y; acc[6] += bf_lo(u.w) * w1.z; acc[7] += bf_hi(u.w) * w1.w;
        }
    }
#pragma unroll
    for (int e = 0; e < 8; ++e) acc[e] = acc[e] * fast_sigmoid(acc[e]) * scale;
    u32x4 o; o.x = cvt_pk_bf16(acc[0], acc[1]); o.y = cvt_pk_bf16(acc[2], acc[3]); o.z = cvt_pk_bf16(acc[4], acc[5]); o.w = cvt_pk_bf16(acc[6], acc[7]);
    return o;
}

__device__ __forceinline__ void ml_gate_scan(const float* IFP, int t0, int h, int lane, LAS float* ga, LAS float* gz, LAS float* gp) {
    float f[4], iv[4];
#pragma unroll
    for (int j = 0; j < 4; ++j) { const float* r = IFP + (size_t)(t0 + 4 * lane + j) * 8; iv[j] = r[h]; f[j] = r[4 + h]; }
    float c[4]; c[0] = f[0]; c[1] = c[0] + f[1]; c[2] = c[1] + f[2]; c[3] = c[2] + f[3];
    float incl = c[3];
#pragma unroll
    for (int o = 1; o < 64; o <<= 1) { const float v = __shfl_up(incl, o); if (lane >= o) incl += v; }
    const float excl = incl - c[3];
    float a[4], z[4], p[4];
#pragma unroll
    for (int j = 0; j < 4; ++j) { a[j] = excl + c[j]; z[j] = iv[j] - a[j]; }
    p[0] = z[0]; p[1] = fmaxf(p[0], z[1]); p[2] = fmaxf(p[1], z[2]); p[3] = fmaxf(p[2], z[3]);
    float pin = p[3];
#pragma unroll
    for (int o = 1; o < 64; o <<= 1) { const float v = __shfl_up(pin, o); if (lane >= o) pin = fmaxf(pin, v); }
    float pex = __shfl_up(pin, 1); if (lane == 0) pex = -INFINITY;
    *(LAS f32x4*)(ga + 4 * lane) = (f32x4){a[0], a[1], a[2], a[3]};
    *(LAS f32x4*)(gz + 4 * lane) = (f32x4){z[0], z[1], z[2], z[3]};
    *(LAS f32x4*)(gp + 4 * lane) = (f32x4){fmaxf(pex, p[0]), fmaxf(pex, p[1]), fmaxf(pex, p[2]), fmaxf(pex, p[3])};
}

constexpr int MLK_STR = 256 * 16 + 16;
constexpr int MLL_K = 0;
constexpr int MLL_V = 16 * MLK_STR;
constexpr int MLL_G = MLL_V + 65536;
constexpr int MLL_END = MLL_G + 3 * 1024;
static_assert(MLL_END <= LDS_MISC_OFF, "mLSTM LDS");

__device__ __forceinline__ void ml_state_unit(LAS unsigned char* lds, unsigned char* ws, unsigned char* mo, const float* cw, const float* cb, int unit) {
    const int tid = tid_opaque(), lane = tid & 63, r32 = lane & 31, hh = lane >> 5, wid = __builtin_amdgcn_readfirstlane(tid >> 6);
    const int bh = unit >> 4, c = unit & 15, b = bh >> 2, h = bh & 3, t0 = b * SEQ + c * ML_L;
    const float* IFP = (const float*)(ws + WS_IFP); const bf16_t* P = (const bf16_t*)(ws + WS_P); bf16_t* MLQK = (bf16_t*)(ws + WS_MLQK);
    LAS float* ga = (LAS float*)(lds + MLL_G); LAS float* gz = ga + 256; LAS float* gp = gz + 256;
    if (wid == 0) ml_gate_scan(IFP, t0, h, lane, ga, gz, gp);
    __syncthreads();
    const float g = ga[255], pmL = gp[255];
    if (tid == 0) { float* gu = (float*)(mo + MO_GU) + unit * 2; gu[0] = g; gu[1] = g + pmL; }
    const int sch = tid & 15;
#pragma unroll 2
    for (int i = 0; i < 8; ++i) { const int r = (tid >> 4) + 32 * i; const size_t t = (size_t)(t0 + r);
        const u32x4 q = ml_conv8(P, t, c * ML_L + r, h * 128 + sch * 8, cw, cb, 0.08838834764831845f);
        u32x4 k = ml_conv8(P, t, c * ML_L + r, 512 + h * 128 + sch * 8, cw, cb, 1.0f);
        const u32x4 v = *(const u32x4*)(P + t * PW + PC_MV + h * 128 + sch * 8);
        *(u32x4*)(MLQK + t * 1024 + h * 128 + sch * 8) = q; *(u32x4*)(MLQK + t * 1024 + 512 + h * 128 + sch * 8) = k;
        const float w = __builtin_amdgcn_exp2f((gz[r] - pmL) * LOG2E);
        k.x = cvt_pk_bf16(bf_lo(k.x) * w, bf_hi(k.x) * w); k.y = cvt_pk_bf16(bf_lo(k.y) * w, bf_hi(k.y) * w); k.z = cvt_pk_bf16(bf_lo(k.z) * w, bf_hi(k.z) * w); k.w = cvt_pk_bf16(bf_lo(k.w) * w, bf_hi(k.w) * w);
        *(LAS u32x4*)(lds + MLL_K + v_off(r, sch)) = k; *(LAS u32x4*)(lds + MLL_V + v_off(r, sch)) = v; }
    __syncthreads();
    const int et = wid & 3, dt0 = 2 * (wid >> 2);
    f32x16 acc0 = f32x16{}, acc1 = f32x16{}, accn0 = f32x16{}, accn1 = f32x16{};
    const int tg = lane >> 4, tq = (lane >> 2) & 3, tp = lane & 3;
    const int vlo = 64 * (4 * hh + tq) + 16 * ((2 * (tg & 1) + (tp >> 1)) ^ hh) + 8 * (tp & 1);
    const int vhi = 64 * (4 * hh + tq) + 16 * ((2 * (tg & 1) + (tp >> 1)) ^ (hh + 2)) + 8 * (tp & 1);
    const bf16x8 ones = (bf16x8){0x3F80, 0x3F80, 0x3F80, 0x3F80, 0x3F80, 0x3F80, 0x3F80, 0x3F80};
#pragma unroll 4
    for (int ks = 0; ks < 16; ++ks) {
        const int sub = 2048 * (2 * ks);
        const s16x4 vl = __builtin_bit_cast(s16x4, __builtin_amdgcn_ds_read_tr16_b64_v4i16((LAS v4i16_t*)(lds + MLL_V + vlo + sub + 512 * et)));
        const s16x4 vh = __builtin_bit_cast(s16x4, __builtin_amdgcn_ds_read_tr16_b64_v4i16((LAS v4i16_t*)(lds + MLL_V + vhi + sub + 2048 + 512 * et)));
        const bf16x8 vf = (bf16x8){vl[0], vl[1], vl[2], vl[3], vh[0], vh[1], vh[2], vh[3]};
        const s16x4 al = __builtin_bit_cast(s16x4, __builtin_amdgcn_ds_read_tr16_b64_v4i16((LAS v4i16_t*)(lds + MLL_K + vlo + sub + 512 * dt0)));
        const s16x4 ah = __builtin_bit_cast(s16x4, __builtin_amdgcn_ds_read_tr16_b64_v4i16((LAS v4i16_t*)(lds + MLL_K + vhi + sub + 2048 + 512 * dt0)));
        const bf16x8 af = (bf16x8){al[0], al[1], al[2], al[3], ah[0], ah[1], ah[2], ah[3]};
        const s16x4 bl = __builtin_bit_cast(s16x4, __builtin_amdgcn_ds_read_tr16_b64_v4i16((LAS v4i16_t*)(lds + MLL_K + vlo + sub + 512 * (dt0 + 1))));
        const s16x4 bhv = __builtin_bit_cast(s16x4, __builtin_amdgcn_ds_read_tr16_b64_v4i16((LAS v4i16_t*)(lds + MLL_K + vhi + sub + 2048 + 512 * (dt0 + 1))));
        const bf16x8 bf = (bf16x8){bl[0], bl[1], bl[2], bl[3], bhv[0], bhv[1], bhv[2], bhv[3]};
        acc0 = __builtin_amdgcn_mfma_f32_32x32x16_bf16(af, vf, acc0, 0, 0, 0);
        acc1 = __builtin_amdgcn_mfma_f32_32x32x16_bf16(bf, vf, acc1, 0, 0, 0);
        if (et == 0) { accn0 = __builtin_amdgcn_mfma_f32_32x32x16_bf16(af, ones, accn0, 0, 0, 0); accn1 = __builtin_amdgcn_mfma_f32_32x32x16_bf16(bf, ones, accn1, 0, 0, 0); }
    }
    float* U = (float*)(mo + MO_U) + (size_t)unit * 16384 + (size_t)(32 * et + r32) * 128;
#pragma unroll
    for (int g4 = 0; g4 < 4; ++g4) {
        *(f32x4*)(U + 32 * dt0 + 8 * g4 + 4 * hh) = (f32x4){acc0[4 * g4], acc0[4 * g4 + 1], acc0[4 * g4 + 2], acc0[4 * g4 + 3]};
        *(f32x4*)(U + 32 * (dt0 + 1) + 8 * g4 + 4 * hh) = (f32x4){acc1[4 * g4], acc1[4 * g4 + 1], acc1[4 * g4 + 2], acc1[4 * g4 + 3]};
    }
    if (et == 0 && r32 == 0) {
        float* NL = (float*)(mo + MO_NL) + (size_t)unit * 128;
#pragma unroll
        for (int g4 = 0; g4 < 4; ++g4) {
            *(f32x4*)(NL + 32 * dt0 + 8 * g4 + 4 * hh) = (f32x4){accn0[4 * g4], accn0[4 * g4 + 1], accn0[4 * g4 + 2], accn0[4 * g4 + 3]};
            *(f32x4*)(NL + 32 * (dt0 + 1) + 8 * g4 + 4 * hh) = (f32x4){accn1[4 * g4], accn1[4 * g4 + 1], accn1[4 * g4 + 2], accn1[4 * g4 + 3]};
        }
    }
    __syncthreads();
}

__device__ __forceinline__ void ml_scan_phase(unsigned char* mo, int G) {
    const int tid = tid_opaque();
    const float* GU = (const float*)(mo + MO_GU);
    for (int i = blockIdx.x * NTHREADS + tid; i < 32 * 4096; i += G * NTHREADS) {
        const int bh = i >> 12, e4 = i & 4095;
        const float* U = (const float*)(mo + MO_U) + (size_t)bh * 16 * 16384 + e4 * 4;
        bf16_t* C = (bf16_t*)(mo + MO_C) + (size_t)bh * 16 * 16384 + e4 * 4;
        f32x4 st = (f32x4){0.f, 0.f, 0.f, 0.f}; float m = 0.f;
#pragma unroll 5
        for (int c = 0; c < 15; ++c) {
            const float g = GU[(bh * 16 + c) * 2], u = GU[(bh * 16 + c) * 2 + 1];
            const float mn = fmaxf(g + m, u), dec = __expf(g + m - mn), sc = __expf(u - mn);
            const f32x4 uv = *(const f32x4*)(U + (size_t)c * 16384);
            st = st * dec + uv * sc; m = mn;
            u32x2 o; o.x = cvt_pk_bf16(st.x, st.y); o.y = cvt_pk_bf16(st.z, st.w);
            *(u32x2*)(C + (size_t)(c + 1) * 16384) = o;
        }
    }
    for (int i = blockIdx.x * NTHREADS + tid; i < 32 * 32; i += G * NTHREADS) {
        const int bh = i >> 5, d4 = i & 31;
        const float* NL = (const float*)(mo + MO_NL) + (size_t)bh * 16 * 128 + d4 * 4;
        float* N = (float*)(mo + MO_N) + (size_t)bh * 16 * 128 + d4 * 4; float* M = (float*)(mo + MO_M) + bh * 16;
        f32x4 st = (f32x4){0.f, 0.f, 0.f, 0.f}; float m = 0.f;
        if (d4 == 0) M[0] = 0.f;
        for (int c = 0; c < 15; ++c) {
            const float g = GU[(bh * 16 + c) * 2], u = GU[(bh * 16 + c) * 2 + 1];
            const float mn = fmaxf(g + m, u), dec = __expf(g + m - mn), sc = __expf(u - mn);
            const f32x4 uv = *(const f32x4*)(NL + (size_t)c * 128);
            st = st * dec + uv * sc; m = mn;
            *(f32x4*)(N + (size_t)(c + 1) * 128) = st;
            if (d4 == 0) M[c + 1] = m;
        }
    }
}

__device__ __forceinline__ void ml_out_unit(LAS unsigned char* lds, unsigned char* ws, const unsigned char* mo, const float* gnorm, int unit) {
    const int tid = tid_opaque(), lane = tid & 63, r32 = lane & 31, hh = lane >> 5, wid = __builtin_amdgcn_readfirstlane(tid >> 6);
    const int bh = unit >> 4, c = unit & 15, b = bh >> 2, h = bh & 3, t0 = b * SEQ + c * ML_L;
    const float* IFP = (const float*)(ws + WS_IFP); const bf16_t* P = (const bf16_t*)(ws + WS_P); const bf16_t* MLQK = (const bf16_t*)(ws + WS_MLQK);
    bf16_t* YML = (bf16_t*)(ws + WS_YML);
    LAS float* ga = (LAS float*)(lds + MLL_G); LAS float* gz = ga + 256; LAS float* gp = gz + 256;
    if (wid == 0) ml_gate_scan(IFP, t0, h, lane, ga, gz, gp);
    const int sch = tid & 15;
    {
        u32x4 kreg[8], vreg[8];
#pragma unroll
        for (int i = 0; i < 8; ++i) { const size_t t = (size_t)(t0 + (tid >> 4) + 32 * i);
            kreg[i] = *(const u32x4*)(MLQK + t * 1024 + 512 + h * 128 + sch * 8); vreg[i] = *(const u32x4*)(P + t * PW + PC_MV + h * 128 + sch * 8); }
#pragma unroll
        for (int i = 0; i < 8; ++i) { const int r = (tid >> 4) + 32 * i;
            *(LAS u32x4*)(lds + MLL_K + sch * MLK_STR + r * 16) = kreg[i]; *(LAS u32x4*)(lds + MLL_V + v_off(r, sch)) = vreg[i]; }
    }
    const float m_prev = (c > 0) ? ((const float*)(mo + MO_M))[unit] : 0.f;
    const int lq = 32 * wid + r32;
    bf16x8 qf[8];
    { const bf16_t* qp = MLQK + (size_t)(t0 + lq) * 1024 + h * 128 + hh * 8;
#pragma unroll
      for (int dd = 0; dd < 8; ++dd) qf[dd] = *(const bf16x8*)(qp + dd * 16); }
    f32x16 o[4]; f32x16 o4 = f32x16{};
#pragma unroll
    for (int et = 0; et < 4; ++et) o[et] = f32x16{};
    if (c > 0) {
        const bf16_t* Cg = (const bf16_t*)(mo + MO_C) + (size_t)unit * 16384 + (size_t)r32 * 128 + hh * 8; const float* Ng = (const float*)(mo + MO_N) + (size_t)unit * 128 + hh * 8;
#pragma unroll
        for (int dd = 0; dd < 8; ++dd) {
#pragma unroll
            for (int et = 0; et < 4; ++et) { const bf16x8 cf = *(const bf16x8*)(Cg + (size_t)et * 32 * 128 + dd * 16); o[et] = __builtin_amdgcn_mfma_f32_32x32x16_bf16(cf, qf[dd], o[et], 0, 0, 0); }
            u32x4 nv = (u32x4){0u, 0u, 0u, 0u};
            if (r32 == 0) { const f32x4 n0 = *(const f32x4*)(Ng + dd * 16), n1 = *(const f32x4*)(Ng + dd * 16 + 4);
                nv.x = cvt_pk_bf16(n0.x, n0.y); nv.y = cvt_pk_bf16(n0.z, n0.w); nv.z = cvt_pk_bf16(n1.x, n1.y); nv.w = cvt_pk_bf16(n1.z, n1.w); }
            o4 = __builtin_amdgcn_mfma_f32_32x32x16_bf16(__builtin_bit_cast(bf16x8, nv), qf[dd], o4, 0, 0, 0);
        }
    }
    __syncthreads();
    const float a_l = ga[lq], M_l = fmaxf(gp[lq], m_prev);
    const float w_inter = __expf(m_prev - M_l);
    const float dinter = __shfl(o4[0], r32);
#pragma unroll
    for (int et = 0; et < 4; ++et)
#pragma unroll
        for (int r = 0; r < 16; ++r) o[et][r] *= w_inter;
    const int tg = lane >> 4, tq = (lane >> 2) & 3, tp = lane & 3;
    const int vlo = 64 * (4 * hh + tq) + 16 * ((2 * (tg & 1) + (tp >> 1)) ^ hh) + 8 * (tp & 1);
    const int vhi = 64 * (4 * hh + tq) + 16 * ((2 * (tg & 1) + (tp >> 1)) ^ (hh + 2)) + 8 * (tp & 1);
    const int klane = hh * MLK_STR + r32 * 16;
    float dintra = 0.f;
    for (int kb32 = 0; kb32 <= wid; ++kb32) {
        const int kb = 32 * kb32;
        f32x16 sc = f32x16{};
#pragma unroll
        for (int dd = 0; dd < 8; ++dd) { const bf16x8 ka = *(const LAS bf16x8*)(lds + MLL_K + klane + (dd * 2) * MLK_STR + kb32 * 512); sc = __builtin_amdgcn_mfma_f32_32x32x16_bf16(ka, qf[dd], sc, 0, 0, 0); }
#pragma unroll
        for (int g4 = 0; g4 < 4; ++g4) { const f32x4 zv = *(const LAS f32x4*)(gz + kb + 8 * g4 + 4 * hh);
#pragma unroll
            for (int e = 0; e < 4; ++e) { const int s = kb + 8 * g4 + 4 * hh + e; const float wgt = (s <= lq) ? __builtin_amdgcn_exp2f((zv[e] - M_l) * LOG2E) : 0.f; sc[4 * g4 + e] *= wgt; dintra += sc[4 * g4 + e]; } }
        bf16x8 pf[2];
#pragma unroll
        for (int s = 0; s < 2; ++s) { u32x4 w;
            w.x = cvt_pk_bf16(sc[8 * s + 0], sc[8 * s + 1]); w.y = cvt_pk_bf16(sc[8 * s + 2], sc[8 * s + 3]); w.z = cvt_pk_bf16(sc[8 * s + 4], sc[8 * s + 5]); w.w = cvt_pk_bf16(sc[8 * s + 6], sc[8 * s + 7]);
            pf[s] = __builtin_bit_cast(bf16x8, w); }
#pragma unroll
        for (int s = 0; s < 2; ++s)
#pragma unroll
            for (int et = 0; et < 4; ++et) {
                const s16x4 lo = __builtin_bit_cast(s16x4, __builtin_amdgcn_ds_read_tr16_b64_v4i16((LAS v4i16_t*)(lds + MLL_V + vlo + 2048 * (4 * kb32 + 2 * s) + 512 * et)));
                const s16x4 hi = __builtin_bit_cast(s16x4, __builtin_amdgcn_ds_read_tr16_b64_v4i16((LAS v4i16_t*)(lds + MLL_V + vhi + 2048 * (4 * kb32 + 2 * s + 1) + 512 * et)));
                const bf16x8 vf = (bf16x8){lo[0], lo[1], lo[2], lo[3], hi[0], hi[1], hi[2], hi[3]};
                o[et] = __builtin_amdgcn_mfma_f32_32x32x16_bf16(vf, pf[s], o[et], 0, 0, 0);
            }
    }
    dintra += __shfl_xor(dintra, 32);
    const float den = dintra + w_inter * dinter;
    const float hsc = 1.0f / fmaxf(fabsf(den), __expf(-(a_l + M_l)));
    float ss = 0.f;
#pragma unroll
    for (int et = 0; et < 4; ++et)
#pragma unroll
        for (int r = 0; r < 16; ++r) { o[et][r] *= hsc; ss += o[et][r] * o[et][r]; }
    ss += __shfl_xor(ss, 32);
    const float rstd = 1.0f / sqrtf(ss * (1.f / 128.f) + NORM_EPS);
    const size_t tok = (size_t)(t0 + lq);
#pragma unroll
    for (int et = 0; et < 4; ++et)
#pragma unroll
        for (int g4 = 0; g4 < 4; ++g4) {
            const int e0 = 32 * et + 8 * g4 + 4 * hh;
            const f32x4 gv = *(const f32x4*)(gnorm + h * 128 + e0);
            const u32x2 og = *(const u32x2*)(P + tok * PW + PC_MO + h * 128 + e0);
            u32x2 w; w.x = cvt_pk_bf16(o[et][4 * g4 + 0] * rstd * gv.x * bf_lo(og.x), o[et][4 * g4 + 1] * rstd * gv.y * bf_hi(og.x));
            w.y = cvt_pk_bf16(o[et][4 * g4 + 2] * rstd * gv.z * bf_lo(og.y), o[et][4 * g4 + 3] * rstd * gv.w * bf_hi(og.y));
            *(u32x2*)(YML + tok * 512 + h * 128 + e0) = w;
        }
    __syncthreads();
}
struct SchedStatic {
    const char* A; const char* B; int nM, nN, G, c; size_t abytes, bbytes;
    __device__ __forceinline__ bool next(int i, pg8::Unit& u) const {
        int pm, pn; if (!pg8::static_tile(nM, nN, G, c, i, pm, pn)) return false;
        u.pm = pm; u.pn = pn; u.aux = 0; u.A = A + (size_t)pm * abytes; u.B = B + (size_t)pn * bbytes; return true; }
    __device__ __forceinline__ int arow(const pg8::Unit&, int r) const { return r; }
};
template <bool TWO> struct SchedPair {
    const char* A0; const char* A1; const char* B0; const char* B1; int nM, nN, G, c; size_t abytes, bbytes;
    __device__ __forceinline__ bool next(int i, pg8::Unit& u) const {
        const int p = TWO ? (i >> 1) : i, which = TWO ? (i & 1) : 0;
        int pm, pn; if (!pg8::static_tile(nM, nN, G, c, p, pm, pn)) return false;
        u.pm = pm; u.pn = pn; u.aux = which; u.A = (which ? A1 : A0) + (size_t)pm * abytes; u.B = (which ? B1 : B0) + (size_t)pn * bbytes; return true; }
    __device__ __forceinline__ int arow(const pg8::Unit&, int r) const { return r; }
};

struct EpiProj {
    static constexpr bool PERM = true;
    static constexpr int BHALF = 32;
    __host__ __device__ static __forceinline__ int brow(int R) { return 64 * ((R >> 5) & 3) + pg8::perm32(R & 31); }
    bf16_t* P; const float* bgate; const float* gq; const float* gk;
    __device__ __forceinline__ bool operator()(f32x4 (&acc)[2][2][4][2], const pg8::Unit& u, int wr, int wc, int fr, int fq) const {
        const int row0 = u.pm * 256 + wr * 64 + fr, col0 = u.pn * 256 + wc * 64 + 8 * fq;
        const int mode = u.pn < 4 ? 3 : (u.pn < 12 ? 0 : (u.pn < 14 ? 1 : 2));
        f32x4 bv[2][2];
#pragma unroll
        for (int bj = 0; bj < 2; ++bj)
#pragma unroll
            for (int n = 0; n < 2; ++n) {
                if (mode == 2) bv[bj][n] = *(const f32x4*)(bgate + (col0 - PC_G) + bj * 32 + 4 * n);
                else if (mode == 3) { bv[bj][n] = *(const f32x4*)((u.pn < 2 ? gq : gk) + 8 * fq + bj * 32 + 4 * n); if (u.pn < 2) bv[bj][n] = bv[bj][n] * (0.125f * LOG2E); }
                else bv[bj][n] = (f32x4){0.f, 0.f, 0.f, 0.f}; }
#pragma unroll
        for (int ai = 0; ai < 2; ++ai)
#pragma unroll
            for (int m = 0; m < 4; ++m) { bf16_t* rowp = P + (size_t)(row0 + ai * 128 + m * 16) * PW + col0;
                float rstd = 1.f;
                if (mode == 3) { float ss = 0.f;
#pragma unroll
                    for (int bj = 0; bj < 2; ++bj)
#pragma unroll
                        for (int n = 0; n < 2; ++n) { const f32x4 v = acc[ai][bj][m][n]; ss += (v[0] * v[0] + v[1] * v[1]) + (v[2] * v[2] + v[3] * v[3]); }
                    ss += __shfl_xor(ss, 16); ss += __shfl_xor(ss, 32);
                    rstd = 1.0f / sqrtf(ss * (1.f / 64.f) + NORM_EPS); }
#pragma unroll
                for (int bj = 0; bj < 2; ++bj) { f32x4 v0, v1;
                    if (mode == 3) { v0 = acc[ai][bj][m][0] * rstd * bv[bj][0]; v1 = acc[ai][bj][m][1] * rstd * bv[bj][1]; }
                    else { v0 = acc[ai][bj][m][0] + bv[bj][0]; v1 = acc[ai][bj][m][1] + bv[bj][1]; }
                    if (mode == 1 || mode == 2) {
#pragma unroll
                        for (int j = 0; j < 4; ++j) { v0[j] = fast_sigmoid(v0[j]); v1[j] = fast_sigmoid(v1[j]); } }
                    u32x4 w; w.x = cvt_pk_bf16(v0[0], v0[1]); w.y = cvt_pk_bf16(v0[2], v0[3]); w.z = cvt_pk_bf16(v1[0], v1[1]); w.w = cvt_pk_bf16(v1[2], v1[3]);
                    *(u32x4*)(rowp + bj * 32) = w; } }
        return false;
    }
};

template <bool TWO> struct EpiMixed {
    static constexpr bool PERM = true;
    static constexpr int BHALF = 128;
    __host__ __device__ static __forceinline__ int brow(int R) { return pg8::perm_rows(R); }
    const bf16_t* P; bf16_t* MIX;
    __device__ __forceinline__ bool operator()(f32x4 (&acc)[2][2][4][2], const pg8::Unit& u, int wr, int wc, int fr, int fq) const {
        const int row0 = u.pm * 256 + wr * 64 + fr, col0 = u.pn * 256 + wc * 32 + 8 * fq;
        const bool first = TWO && (u.aux == 0);
#pragma unroll
        for (int ai = 0; ai < 2; ++ai) {
            u32x4 ga[4][2], gb[4][2];
#pragma unroll
            for (int m = 0; m < 4; ++m) { const bf16_t* gp = P + (size_t)(row0 + ai * 128 + m * 16) * PW + PC_G + col0;
#pragma unroll
                for (int bj = 0; bj < 2; ++bj) { if (!TWO || first) ga[m][bj] = *(const u32x4*)(gp + bj * 128); if (TWO) gb[m][bj] = *(const u32x4*)(gp + 1024 + bj * 128); } }
#pragma unroll
            for (int m = 0; m < 4; ++m) { const int row = row0 + ai * 128 + m * 16;
#pragma unroll
                for (int bj = 0; bj < 2; ++bj) {
                    if (first) {
                        const u32x4 a = ga[m][bj], b = gb[m][bj];
                        const float g1[8] = {bf_lo(a.x), bf_hi(a.x), bf_lo(a.y), bf_hi(a.y), bf_lo(a.z), bf_hi(a.z), bf_lo(a.w), bf_hi(a.w)};
                        const float g2[8] = {bf_lo(b.x), bf_hi(b.x), bf_lo(b.y), bf_hi(b.y), bf_lo(b.z), bf_hi(b.z), bf_lo(b.w), bf_hi(b.w)};
#pragma unroll
                        for (int j = 0; j < 4; ++j) { acc[ai][bj][m][0][j] *= g1[j] * __builtin_amdgcn_rcpf(fmaxf(g2[j], 1e-30f)); acc[ai][bj][m][1][j] *= g1[4 + j] * __builtin_amdgcn_rcpf(fmaxf(g2[4 + j], 1e-30f)); }
                    } else {
                        const u32x4 b = TWO ? gb[m][bj] : ga[m][bj];
                        const float g[8] = {bf_lo(b.x), bf_hi(b.x), bf_lo(b.y), bf_hi(b.y), bf_lo(b.z), bf_hi(b.z), bf_lo(b.w), bf_hi(b.w)};
                        f32x4 v0 = acc[ai][bj][m][0], v1 = acc[ai][bj][m][1];
#pragma unroll
                        for (int j = 0; j < 4; ++j) { v0[j] *= g[j]; v1[j] *= g[4 + j]; }
                        u32x4 w; w.x = cvt_pk_bf16(v0[0], v0[1]); w.y = cvt_pk_bf16(v0[2], v0[3]); w.z = cvt_pk_bf16(v1[0], v1[1]); w.w = cvt_pk_bf16(v1[2], v1[3]);
                        *(u32x4*)(MIX + (size_t)row * 1024 + col0 + bj * 128) = w;
                    }
                } }
        }
        return first;
    }
};

struct EpiWout {
    static constexpr bool PERM = true;
    static constexpr int BHALF = 128;
    __host__ __device__ static __forceinline__ int brow(int R) { return pg8::perm_rows(R); }
    const float* x; float* out;
    __device__ __forceinline__ bool operator()(f32x4 (&acc)[2][2][4][2], const pg8::Unit& u, int wr, int wc, int fr, int fq) const {
        const int row0 = u.pm * 256 + wr * 64 + fr, col0 = u.pn * 256 + wc * 32 + 8 * fq;
#pragma unroll
        for (int ai = 0; ai < 2; ++ai) {
            f32x4 xv[4][2][2];
#pragma unroll
            for (int m = 0; m < 4; ++m) { const size_t ro = (size_t)(row0 + ai * 128 + m * 16) * D + col0;
#pragma unroll
                for (int bj = 0; bj < 2; ++bj)
#pragma unroll
                    for (int n = 0; n < 2; ++n) xv[m][bj][n] = *(const f32x4*)(x + ro + bj * 128 + n * 4); }
#pragma unroll
            for (int m = 0; m < 4; ++m) { const size_t ro = (size_t)(row0 + ai * 128 + m * 16) * D + col0;
#pragma unroll
                for (int bj = 0; bj < 2; ++bj)
#pragma unroll
                    for (int n = 0; n < 2; ++n) *(f32x4*)(out + ro + bj * 128 + n * 4) = xv[m][bj][n] + acc[ai][bj][m][n]; }
        }
        return false;
    }
};
constexpr size_t WS_TILEE = WS_WGCNT + (size_t)256 * 64 * 4;
constexpr size_t WS_NT = WS_TILEE + 384 * 4;
constexpr size_t WS_RSTD = WS_NT + 256;
constexpr size_t WS_RSLOT = WS_RSTD + (size_t)T * 4;
static_assert(WS_RSLOT + (size_t)MOE_ROWS * 4 <= WS_END, "MoE tables must fit the P region");
__device__ __forceinline__ int ld_i32(const int* p) { return (int)__hip_atomic_load((const unsigned*)p, __ATOMIC_RELAXED, __HIP_MEMORY_SCOPE_AGENT); }

constexpr int RT_WSTR = 1028;
constexpr int RT_LG = 36 * RT_WSTR * 4;
constexpr int RT_HIST = RT_LG + 8 * 8 * 36 * 4;
static_assert(RT_HIST + 256 <= LDS_MISC_OFF, "router LDS");

#ifndef RSTAMP
#define RSTAMP() do { } while (0)
#define RSTAMPW() do { } while (0)
#endif
__device__ __forceinline__ void router_phase(LAS unsigned char* lds, const float* const* in, unsigned char* ws, const float* x1, int G) {
    moe_weight_convert(lds, in, ws, G);
    __syncthreads();
    RSTAMP();
    const int tid = tid_opaque(), lane = tid & 63, wave = __builtin_amdgcn_readfirstlane(tid >> 6);
    const int gw = blockIdx.x * NWAVES + wave, NGW = G * NWAVES;
    const float* gn = in[20]; const float* w_group = in[21]; const float* b_group = in[22]; const float* w_router = in[23]; const float* b_router = in[24];
    LAS float* wr = (LAS float*)lds;
    for (int i = tid; i < 4096; i += NTHREADS) { const int d = i >> 2, j = i & 3; wr[j * RT_WSTR + d] = w_group[i] * gn[d]; }
    for (int i = tid; i < 32768; i += NTHREADS) { const int d = i >> 5, j = i & 31; wr[(4 + j) * RT_WSTR + d] = w_router[i] * gn[d]; }
    LAS float* lg = (LAS float*)(lds + RT_LG) + wave * (8 * 36);
    LAS int* hist = (LAS int*)(lds + RT_HIST);
    if (tid < 64) hist[tid] = 0;
    __syncthreads();
    bf16_t* HN = (bf16_t*)(ws + WS_HN); int* TEID = (int*)(ws + WS_TEID); float* TGATE = (float*)(ws + WS_TGATE);
    const int li = lane & 15, lq = lane >> 4;
    for (int row0 = gw * 16; row0 < T; row0 += NGW * 16) {
        const float* xr = x1 + (size_t)(row0 + li) * D + 4 * lq;
        const LAS float* wb0 = wr + li * RT_WSTR + 4 * lq;
        const LAS float* wb1 = wr + (16 + li) * RT_WSTR + 4 * lq;
        const LAS float* wb2 = wr + (li < 4 ? 32 + li : 35) * RT_WSTR + 4 * lq;
        f32x4 acc0 = (f32x4){0.f, 0.f, 0.f, 0.f}, acc1 = acc0, acc2 = acc0; float ssq = 0.f;
        unsigned long long* o8 = (unsigned long long*)(HN + (size_t)(row0 + li) * D + 4 * lq);
#define RT_LOAD(buf, c0) do { _Pragma("unroll") for (int _u = 0; _u < 8; ++_u) buf[_u] = *(const f32x4*)(xr + 16 * ((c0) + _u)); } while (0)
#define RT_STEP(buf, c0) do { _Pragma("unroll") for (int _u = 0; _u < 8; ++_u) { const int c = (c0) + _u; const f32x4 a4 = buf[_u]; \
            const f32x4 b0 = *(const LAS f32x4*)(wb0 + 16 * c), b1 = *(const LAS f32x4*)(wb1 + 16 * c), b2 = *(const LAS f32x4*)(wb2 + 16 * c); \
            ssq += (a4.x * a4.x + a4.y * a4.y) + (a4.z * a4.z + a4.w * a4.w); \
            { const f32x4 v = a4 * *(const f32x4*)(gn + 4 * lq + 16 * c); \
              o8[4 * c] = (unsigned long long)cvt_pk_bf16(v.x, v.y) | ((unsigned long long)cvt_pk_bf16(v.z, v.w) << 32); } \
            _Pragma("unroll") for (int e = 0; e < 4; ++e) { \
                acc0 = __builtin_amdgcn_mfma_f32_16x16x4f32(a4[e], b0[e], acc0, 0, 0, 0); \
                acc1 = __builtin_amdgcn_mfma_f32_16x16x4f32(a4[e], b1[e], acc1, 0, 0, 0); \
                acc2 = __builtin_amdgcn_mfma_f32_16x16x4f32(a4[e], b2[e], acc2, 0, 0, 0); } } } while (0)
        f32x4 xa[8], xb[8];
        RT_LOAD(xa, 0);
#pragma unroll 1
        for (int cb = 0; cb < 64; cb += 16) {
            RT_LOAD(xb, cb + 8);
            RT_STEP(xa, cb);
            if (cb + 16 < 64) RT_LOAD(xa, cb + 16);
            RT_STEP(xb, cb + 8);
        }
#undef RT_LOAD
#undef RT_STEP
        ssq += __shfl_xor(ssq, 16); ssq += __shfl_xor(ssq, 32);
        const float rstd_i = 1.0f / sqrtf(ssq * (1.f / D) + NORM_EPS);
        if (lq == 0) ((float*)(ws + WS_RSTD))[row0 + li] = rstd_i;
        float rs[4];
#pragma unroll
        for (int r = 0; r < 4; ++r) rs[r] = __shfl(rstd_i, 4 * lq + r);
#pragma unroll
        for (int h8 = 0; h8 < 2; ++h8) {
            if ((lq >> 1) == h8) {
#pragma unroll
                for (int r = 0; r < 4; ++r) { const int rr = 4 * (lq & 1) + r;
                    lg[rr * 36 + li] = acc0[r] * rs[r]; lg[rr * 36 + 16 + li] = acc1[r] * rs[r]; if (li < 4) lg[rr * 36 + 32 + li] = acc2[r] * rs[r]; }
            }
            asm volatile("s_waitcnt lgkmcnt(0)" ::: "memory");
            if (lane < 8) {
                const LAS float* L = lg + lane * 36;
                float gl[4]; int gi = 0; float gm = -INFINITY;
#pragma unroll
                for (int i = 0; i < 4; ++i) { gl[i] = L[i] + b_group[i]; if (gl[i] > gm) { gm = gl[i]; gi = i; } }
                float gs = 0.f;
#pragma unroll
                for (int i = 0; i < 4; ++i) gs += __expf(gl[i] - gm);
                const float gtop = 1.0f / gs;
                float l1 = -INFINITY, l2 = -INFINITY; int e1 = 0, e2 = 0;
                for (int i = 0; i < 8; ++i) { const float l = L[4 + gi * 8 + i] + b_router[gi * 8 + i];
                    if (l > l1) { l2 = l1; e2 = e1; l1 = l; e1 = i; } else if (l > l2) { l2 = l; e2 = i; } }
                const float p2 = __expf(l2 - l1), w1 = 1.0f / (1.0f + p2), w2 = p2 * w1;
                const int t = row0 + 8 * h8 + lane;
                TEID[t * 2] = gi * 8 + e1; TEID[t * 2 + 1] = gi * 8 + e2; TGATE[t * 2] = gtop * w1; TGATE[t * 2 + 1] = gtop * w2;
                __hip_atomic_fetch_add(&hist[gi * 8 + e1], 1, __ATOMIC_RELAXED, __HIP_MEMORY_SCOPE_WORKGROUP); __hip_atomic_fetch_add(&hist[32 + gi * 8 + e2], 1, __ATOMIC_RELAXED, __HIP_MEMORY_SCOPE_WORKGROUP);
            }
            asm volatile("s_waitcnt lgkmcnt(0)" ::: "memory");
        }
    }
    __syncthreads();
    if (tid < 64) ((int*)(ws + WS_WGCNT))[blockIdx.x * 64 + tid] = hist[tid];
}

__device__ __forceinline__ void moe_plan_phase(LAS unsigned char* lds, unsigned char* ws, int G) {
    const int tid = tid_opaque();
    LAS int* tot = (LAS int*)lds; LAS int* pre = tot + 64; LAS int* base = pre + 64; LAS int* lcnt = base + 64; LAS int* pt = lcnt + 64; LAS int* pp = pt + 512;
    const int* WGCNT = (const int*)(ws + WS_WGCNT);
    { const int j = tid & 63, part = tid >> 6; int t = 0, p = 0;
#pragma unroll 8
      for (int w = 32 * part; w < 32 * part + 32; ++w) { const int v = ld_i32(WGCNT + w * 64 + j); t += v; p += (w < (int)blockIdx.x) ? v : 0; }
      pt[tid] = t; pp[tid] = p; }
    __syncthreads();
    if (tid < 64) { int t = 0, p = 0;
#pragma unroll
        for (int q = 0; q < 8; ++q) { t += pt[q * 64 + tid]; p += pp[q * 64 + tid]; }
        tot[tid] = t; pre[tid] = p; lcnt[tid] = 0; }
    __syncthreads();
    if (tid == 0) { int run = 0; for (int j = 0; j < 64; ++j) { base[j] = run; run += ((tot[j] + 255) >> 8) << 8; } }
    __syncthreads();
    int* RTOK = (int*)(ws + WS_RTOK); float* RGATE = (float*)(ws + WS_RGATE); float* RSLOT = (float*)(ws + WS_RSLOT);
    if (tid < 256) {
        const int k = tid & 1, ts = tid >> 1;
        const int t = (int)blockIdx.x * 128 + ts;
        const int e = ld_i32((const int*)(ws + WS_TEID) + t * 2 + k); const float g = __uint_as_float((unsigned)ld_i32((const int*)(ws + WS_TGATE) + t * 2 + k));
        const float rs = __uint_as_float((unsigned)ld_i32((const int*)(ws + WS_RSTD) + t));
        const int j = k * 32 + e; const int rk = __hip_atomic_fetch_add(&lcnt[j], 1, __ATOMIC_RELAXED, __HIP_MEMORY_SCOPE_WORKGROUP);
        const int slot = base[j] + pre[j] + rk;
        RTOK[slot] = t; RGATE[slot] = g; RSLOT[slot] = rs;
    }
    if (blockIdx.x < 64) { const int j = blockIdx.x; const int s0 = base[j] + tot[j], s1 = base[j] + (((tot[j] + 255) >> 8) << 8);
        for (int s = s0 + tid; s < s1; s += NTHREADS) { RTOK[s] = -1; RGATE[s] = 0.f; RSLOT[s] = 0.f; } }
    if (blockIdx.x == 0 && tid < 64) { int* TE = (int*)(ws + WS_TILEE); int* NT = (int*)(ws + WS_NT);
        const int n = (tot[tid] + 255) >> 8, b0 = base[tid] >> 8;
        for (int q = 0; q < n; ++q) TE[b0 + q] = tid & 31;
        if (tid == 31) NT[0] = b0 + n;
        if (tid == 63) NT[1] = b0 + n; }
    __syncthreads();
}

struct SchedUp {
    const char* HN; const char* W13; const int* RTOK; const int* TE; int ntiles, G, c;
    __device__ __forceinline__ bool next(int i, pg8::Unit& u) const {
        const int L = i * G + c; if (L >= ntiles * 4) return false;
        const int tau = L >> 2, pn = L & 3, e = ld_i32(TE + tau);
        u.pm = tau; u.pn = pn; u.aux = e; u.A = HN; u.B = W13 + (size_t)e * (1024 * 1024 * 2) + (size_t)pn * (256 * 1024 * 2); return true; }
    __device__ __forceinline__ int arow(const pg8::Unit& u, int r) const { const int t = ld_i32(RTOK + u.pm * 256 + r); return t < 0 ? 0 : t; }
};
struct EpiUp {
    static constexpr bool PERM = true;
    static constexpr int BHALF = 128;
    __host__ __device__ static __forceinline__ int brow(int R) { return pg8::perm_rows(R); }
    bf16_t* HID; const float* RSLOT;
    __device__ __forceinline__ bool operator()(f32x4 (&acc)[2][2][4][2], const pg8::Unit& u, int wr, int wc, int fr, int fq) const {
        const int row0 = u.pm * 256 + wr * 64 + fr, col0 = u.pn * 128 + wc * 32 + 8 * fq;
#pragma unroll
        for (int ai = 0; ai < 2; ++ai)
#pragma unroll
            for (int m = 0; m < 4; ++m) {
                const float rs = __uint_as_float((unsigned)ld_i32((const int*)RSLOT + row0 + ai * 128 + m * 16));
                float hv[8];
#pragma unroll
                for (int n = 0; n < 2; ++n)
#pragma unroll
                    for (int j = 0; j < 4; ++j) { const float a = acc[ai][0][m][n][j] * rs; hv[4 * n + j] = a * fast_sigmoid(a) * (acc[ai][1][m][n][j] * rs); }
                u32x4 w; w.x = cvt_pk_bf16(hv[0], hv[1]); w.y = cvt_pk_bf16(hv[2], hv[3]); w.z = cvt_pk_bf16(hv[4], hv[5]); w.w = cvt_pk_bf16(hv[6], hv[7]);
                *(u32x4*)(HID + (size_t)(row0 + ai * 128 + m * 16) * 512 + col0) = w;
            }
        return false;
    }
};
struct SchedDown {
    const char* HID; const char* W2T; const int* TE; int t0, t1, G, c;
    __device__ __forceinline__ bool next(int i, pg8::Unit& u) const {
        const int L = i * G + c; if (L >= (t1 - t0) * 4) return false;
        const int tau = t0 + (L >> 2), pn = L & 3, e = ld_i32(TE + tau);
        u.pm = tau; u.pn = pn; u.aux = e; u.A = HID + (size_t)tau * (256 * 512 * 2); u.B = W2T + (size_t)e * (1024 * 512 * 2) + (size_t)pn * (256 * 512 * 2); return true; }
    __device__ __forceinline__ int arow(const pg8::Unit&, int r) const { return r; }
};
struct EpiDownY {
    static constexpr bool PERM = true;
    static constexpr int BHALF = 128;
    __host__ __device__ static __forceinline__ int brow(int R) { return pg8::perm_rows(R); }
    const int* RTOK; const float* RGATE; bf16_t* Y1;
    __device__ __forceinline__ bool operator()(f32x4 (&acc)[2][2][4][2], const pg8::Unit& u, int wr, int wc, int fr, int fq) const {
        const int row0 = u.pm * 256 + wr * 64 + fr, col0 = u.pn * 256 + wc * 32 + 8 * fq;
#pragma unroll
        for (int ai = 0; ai < 2; ++ai)
#pragma unroll
            for (int m = 0; m < 4; ++m) { const int slot = row0 + ai * 128 + m * 16; const int tok = ld_i32(RTOK + slot);
                if (tok >= 0) { const float g = __uint_as_float((unsigned)ld_i32((const int*)RGATE + slot)); bf16_t* op = Y1 + (size_t)tok * D + col0;
#pragma unroll
                    for (int bj = 0; bj < 2; ++bj) { const f32x4 v0 = acc[ai][bj][m][0] * g, v1 = acc[ai][bj][m][1] * g;
                        u32x4 w; w.x = cvt_pk_bf16(v0[0], v0[1]); w.y = cvt_pk_bf16(v0[2], v0[3]); w.z = cvt_pk_bf16(v1[0], v1[1]); w.w = cvt_pk_bf16(v1[2], v1[3]);
                        *(u32x4*)(op + bj * 128) = w; } } }
        return false;
    }
};
struct EpiDown {
    static constexpr bool PERM = true;
    static constexpr int BHALF = 128;
    __host__ __device__ static __forceinline__ int brow(int R) { return pg8::perm_rows(R); }
    const int* RTOK; const float* RGATE; float* out; const bf16_t* Y1;
    __device__ __forceinline__ bool operator()(f32x4 (&acc)[2][2][4][2], const pg8::Unit& u, int wr, int wc, int fr, int fq) const {
        const int row0 = u.pm * 256 + wr * 64 + fr, col0 = u.pn * 256 + wc * 32 + 8 * fq;
        int tok[2][4]; float gt[2][4];
#pragma unroll
        for (int ai = 0; ai < 2; ++ai)
#pragma unroll
            for (int m = 0; m < 4; ++m) { const int slot = row0 + ai * 128 + m * 16; tok[ai][m] = ld_i32(RTOK + slot); gt[ai][m] = __uint_as_float((unsigned)ld_i32((const int*)RGATE + slot)); }
#pragma unroll
        for (int ai = 0; ai < 2; ++ai)
#pragma unroll
          for (int mh = 0; mh < 2; ++mh) {
            f32x4 xv[2][2][2]; u32x4 yv[2][2];
#pragma unroll
            for (int mm = 0; mm < 2; ++mm) { const int m = 2 * mh + mm; const size_t ro = (size_t)(tok[ai][m] < 0 ? 0 : tok[ai][m]) * D + col0;
#pragma unroll
                for (int bj = 0; bj < 2; ++bj) { xv[mm][bj][0] = *(const f32x4*)(out + ro + bj * 128); xv[mm][bj][1] = *(const f32x4*)(out + ro + bj * 128 + 4); yv[mm][bj] = *(const u32x4*)(Y1 + ro + bj * 128); } }
#pragma unroll
            for (int mm = 0; mm < 2; ++mm) { const int m = 2 * mh + mm; if (tok[ai][m] >= 0) { const size_t ro = (size_t)tok[ai][m] * D + col0; const float g = gt[ai][m];
#pragma unroll
                for (int bj = 0; bj < 2; ++bj) { const u32x4 y = yv[mm][bj];
                    *(f32x4*)(out + ro + bj * 128) = xv[mm][bj][0] + acc[ai][bj][m][0] * g + (f32x4){bf_lo(y.x), bf_hi(y.x), bf_lo(y.y), bf_hi(y.y)};
                    *(f32x4*)(out + ro + bj * 128 + 4) = xv[mm][bj][1] + acc[ai][bj][m][1] * g + (f32x4){bf_lo(y.z), bf_hi(y.z), bf_lo(y.w), bf_hi(y.w)}; } } }
          }
        return false;
    }
};
struct Args { const float* in[28]; float* out; unsigned char* ws; };

__global__ void __launch_bounds__(NTHREADS, 2) fwd(Args a) {
    extern __shared__ __attribute__((aligned(16))) unsigned char lds_raw[];
    LAS unsigned char* lds = (LAS unsigned char*)lds_raw;
    const int tid = threadIdx.x; const int G = (int)gridDim.x;
    volatile LAS unsigned* misc = (volatile LAS unsigned*)(lds + LDS_MISC_OFF);
    if (tid < 64) misc[tid] = 0u;
    __syncthreads();
    unsigned* ctl = (unsigned*)(a.ws + WS_CTL);
    XcdBarrier bar = xcd_barrier_post(ctl + CW_BAR, misc);
    unsigned char* ws = a.ws;

    p0_prologue(lds, a.in, ws, G);
    xcd_barrier(bar);
    {
        SchedStatic S{(const char*)(ws + WS_HB), (const char*)(ws + WS_WIN), 128, 22, G, (int)blockIdx.x, (size_t)256 * 1024 * 2, (size_t)256 * 1024 * 2};
        EpiProj E{(bf16_t*)(ws + WS_P), a.in[18], a.in[3], a.in[4]};
        pg8::gemm_run<EpiProj, SchedStatic, false>(lds, 1024, S, E);
    }
    xcd_barrier(bar);
    unsigned char* mo = (unsigned char*)a.out;
    for (int u = blockIdx.x; u < ML_UNITS; u += G) ml_state_unit(lds, ws, mo, a.in[10], a.in[11], u);
    xcd_barrier(bar);
    ml_scan_phase(mo, G);
    xcd_barrier(bar);
    attn_phase(lds, a.in, ws, G);
    __syncthreads();
    for (int u = blockIdx.x; u < ML_UNITS; u += G) ml_out_unit(lds, ws, mo, a.in[14], u);
    xcd_barrier(bar);
    {
        SchedPair<true> S{(const char*)(ws + WS_YDA), (const char*)(ws + WS_YML), (const char*)(ws + WS_WDA), (const char*)(ws + WS_WML), 128, 4, G, (int)blockIdx.x, (size_t)256 * 512 * 2, (size_t)256 * 512 * 2};
        EpiMixed<true> E{(const bf16_t*)(ws + WS_P), (bf16_t*)(ws + WS_MIX)};
        pg8::gemm_run<EpiMixed<true>, SchedPair<true>, false>(lds, 512, S, E);
    }
    xcd_barrier(bar);
    {
        SchedStatic S{(const char*)(ws + WS_MIX), (const char*)(ws + WS_WOUT), 128, 4, G, (int)blockIdx.x, (size_t)256 * 1024 * 2, (size_t)256 * 1024 * 2};
        EpiWout E{a.in[0], a.out};
        pg8::gemm_run<EpiWout, SchedStatic, false>(lds, 1024, S, E);
    }
    xcd_barrier(bar);
    router_phase(lds, a.in, ws, a.out, G);
    xcd_barrier(bar);
    moe_plan_phase(lds, ws, G);
    xcd_barrier(bar);
    const int nt0 = ld_i32((const int*)(ws + WS_NT)), nt1 = ld_i32((const int*)(ws + WS_NT) + 1);
    {
        SchedUp S{(const char*)(ws + WS_HN), (const char*)(ws + WS_W13), (const int*)(ws + WS_RTOK), (const int*)(ws + WS_TILEE), nt1, G, (int)blockIdx.x};
        EpiUp E{(bf16_t*)(ws + WS_HID), (const float*)(ws + WS_RSLOT)};
        pg8::gemm_run<EpiUp, SchedUp, true>(lds, 1024, S, E);
    }
    xcd_barrier(bar);
    {
        SchedDown S{(const char*)(ws + WS_HID), (const char*)(ws + WS_W2), (const int*)(ws + WS_TILEE), nt0, nt1, G, (int)blockIdx.x};
        EpiDownY E{(const int*)(ws + WS_RTOK), (const float*)(ws + WS_RGATE), (bf16_t*)(ws + WS_HB)};
        pg8::gemm_run<EpiDownY, SchedDown, false>(lds, 512, S, E);
    }
    xcd_barrier(bar);
    {
        SchedDown S{(const char*)(ws + WS_HID), (const char*)(ws + WS_W2), (const int*)(ws + WS_TILEE), 0, nt0, G, (int)blockIdx.x};
        EpiDown E{(const int*)(ws + WS_RTOK), (const float*)(ws + WS_RGATE), a.out, (const bf16_t*)(ws + WS_HB)};
        pg8::gemm_run<EpiDown, SchedDown, false>(lds, 512, S, E);
    }
}

extern "C" void kernel_launch(void* const* d_in, const int* in_sizes, int n_in, void* d_out, int out_size, void* d_ws, size_t ws_size, hipStream_t stream) {
    static int grid = 0;
    if (grid == 0) {
        if (n_in != 28 || out_size != T * D || ws_size < WS_END) { fprintf(stderr, "kernel_launch: unexpected shapes (n_in %d, out %d, ws %zu, need %zu)\n", n_in, out_size, ws_size, (size_t)WS_END); grid = -1; return; }
        int dev = 0, cus = 0, per_cu = 0;
        if (hipGetDevice(&dev) != hipSuccess || hipDeviceGetAttribute(&cus, hipDeviceAttributeMultiprocessorCount, dev) != hipSuccess) { grid = -1; return; }
        if (hipFuncSetAttribute((const void*)fwd, hipFuncAttributeMaxDynamicSharedMemorySize, LDS_BYTES) != hipSuccess) { fprintf(stderr, "kernel_launch: hipFuncSetAttribute failed\n"); grid = -1; return; }
        if (hipOccupancyMaxActiveBlocksPerMultiprocessor(&per_cu, (const void*)fwd, NTHREADS, LDS_BYTES) != hipSuccess || per_cu < 1) { fprintf(stderr, "kernel_launch: occupancy query reports %d\n", per_cu); }
        (void)hipGetLastError();
        grid = cus;
        if (grid != 256) { fprintf(stderr, "kernel_launch: built for a 256-CU device (got %d)\n", cus); grid = -1; return; }
    }
    if (grid < 0) return;
    if (hipMemsetAsync((char*)d_ws + WS_CTL, 0, CTL_BYTES, stream) != hipSuccess) return;
    Args a{};
    for (int i = 0; i < 28; ++i) a.in[i] = (const float*)d_in[i];
    a.out = (float*)d_out; a.ws = (unsigned char*)d_ws;
    hipLaunchKernelGGL(fwd, dim3(grid), dim3(NTHREADS), LDS_BYTES, stream, a);
}
```

```cpp
#include <hip/hip_runtime.h>
#include <cstdio>
#include <cstdint>

#define LAS __attribute__((address_space(3)))
typedef unsigned short bf16_t;
typedef short bf16x8 __attribute__((ext_vector_type(8)));
typedef short s16x4 __attribute__((ext_vector_type(4)));
typedef float f32x2 __attribute__((ext_vector_type(2)));
typedef float f32x4 __attribute__((ext_vector_type(4)));
typedef float f32x16 __attribute__((ext_vector_type(16)));
typedef unsigned u32x2 __attribute__((ext_vector_type(2)));
typedef unsigned u32x4 __attribute__((ext_vector_type(4)));

constexpr int T = 32768, D = 1024, SEQ = 4096, NBATCH = 8;
constexpr int PW = 5632;
constexpr int IN_W = 3592;
constexpr int PC_Q = 0, PC_K = 512, PC_V = 1024, PC_MQ = 1536, PC_MK = 2048, PC_MV = 2560, PC_MO = 3072, PC_G = 3584;
constexpr int NEXP = 32, FF = 512;
constexpr float NORM_EPS = 1e-6f;
constexpr float LOG2E = 1.4426950408889634f;
constexpr int NTHREADS = 512, NWAVES = 8;

constexpr size_t WS_CTL = 0, CTL_BYTES = 65536;
constexpr size_t WS_WIN = WS_CTL + CTL_BYTES;
constexpr size_t WS_WDA = WS_WIN + (size_t)PW * 1024 * 2;
constexpr size_t WS_WML = WS_WDA + (size_t)1024 * 512 * 2;
constexpr size_t WS_WOUT = WS_WML + (size_t)1024 * 512 * 2;
constexpr size_t WS_IFP = WS_WOUT + (size_t)1024 * 1024 * 2;
constexpr size_t WS_HB = WS_IFP + (size_t)T * 8 * 4;
constexpr size_t WS_MLQK = WS_HB + (size_t)T * 1024 * 2;
constexpr size_t WS_P = WS_MLQK + (size_t)T * 1024 * 2;
constexpr size_t WS_END = WS_P + (size_t)T * PW * 2;
constexpr size_t WS_YDA = WS_HB;
constexpr size_t WS_YML = WS_HB + (size_t)T * 512 * 2;
constexpr size_t WS_MIX = WS_MLQK;
constexpr size_t WS_HN = WS_HB;
constexpr int MOE_ROWS = 65536 + 64 * 256;
constexpr size_t WS_W13 = WS_P;
constexpr size_t WS_W2 = WS_W13 + (size_t)NEXP * 1024 * 1024 * 2;
constexpr size_t WS_HID = WS_W2 + (size_t)NEXP * 1024 * 512 * 2;
constexpr size_t WS_RTOK = WS_HID + (size_t)MOE_ROWS * 512 * 2;
constexpr size_t WS_RGATE = WS_RTOK + (size_t)MOE_ROWS * 4;
constexpr size_t WS_TEID = WS_RGATE + (size_t)MOE_ROWS * 4;
constexpr size_t WS_TGATE = WS_TEID + (size_t)T * 2 * 4;
constexpr size_t WS_WGCNT = WS_TGATE + (size_t)T * 2 * 4;
constexpr size_t WS_MOE_END = WS_WGCNT + (size_t)256 * 64 * 4;
static_assert(WS_MOE_END <= WS_END, "MoE overlay must fit the P region");
constexpr int CW_BAR = 0;
constexpr int CW_MISC = 4096;

constexpr int LDS_BYTES = 160 * 1024;
constexpr int LDS_MISC_OFF = LDS_BYTES - 256;

__device__ __forceinline__ unsigned cvt_pk_bf16(float lo, float hi) { unsigned r; asm volatile("v_cvt_pk_bf16_f32 %0, %1, %2" : "=v"(r) : "v"(lo), "v"(hi)); return r; }
__device__ __forceinline__ float bf_lo(unsigned w) { return __uint_as_float(w << 16); }
__device__ __forceinline__ float bf_hi(unsigned w) { return __uint_as_float(w & 0xffff0000u); }
__device__ __forceinline__ float bf2f(bf16_t b) { return __uint_as_float(((unsigned)b) << 16); }
__device__ __forceinline__ float fast_sigmoid(float x) { return __builtin_amdgcn_rcpf(1.0f + __builtin_amdgcn_exp2f(-LOG2E * x)); }
__device__ __forceinline__ float wave_sum(float v) {
#pragma unroll
    for (int o = 1; o < 64; o <<= 1) v += __shfl_xor(v, o);
    return v;
}
__device__ __forceinline__ int tid_opaque() { int t = (int)threadIdx.x; asm volatile("" : "+v"(t)); return t; }
#define XB_TMO      128
#define XB_XCNT(j)  (256  + 64 * (j))
#define XB_XSUB(j)  (1280 + 64 * (j))
#define XB_XGEN(j)  (2304 + 64 * (j))
#define XB_TOP      3328
#define XB_TOPGEN   3392
#define XCD_BAR_WORDS 3456
#define XB_SPIN_CAP (1u << 18)

__device__ __forceinline__ unsigned xb_ld(unsigned* p)              { return __hip_atomic_load(p, __ATOMIC_RELAXED, __HIP_MEMORY_SCOPE_AGENT); }
__device__ __forceinline__ unsigned xb_add(unsigned* p, unsigned v) { return __hip_atomic_fetch_add(p, v, __ATOMIC_RELAXED, __HIP_MEMORY_SCOPE_AGENT); }
__device__ __forceinline__ unsigned xb_xcc_id() { return (unsigned)__builtin_amdgcn_s_getreg((3 << 11) | 20) & 0xFu; }
#define XB_SPIN(cond, bar) do { unsigned _sp = 0; while (cond) { __builtin_amdgcn_s_sleep(1); \
    if ((++_sp & 255u) == 0u) { if (xb_ld(&(bar)[XB_TMO])) break; if (_sp > XB_SPIN_CAP) { atomicAdd(&(bar)[XB_TMO], 1u); break; } } } } while (0)

struct XcdBarrier {
    unsigned* bar; unsigned x;
    volatile LAS unsigned* st;
};

__device__ __forceinline__ XcdBarrier xcd_barrier_post(unsigned* bar, volatile LAS unsigned* st) {
    XcdBarrier b; b.bar = bar; b.x = xb_xcc_id(); b.st = st;
    if (threadIdx.x == 0) (void)xb_add(&bar[XB_XCNT(b.x)], 1u);
    return b;
}
__device__ __forceinline__ void xcd_barrier_complete(unsigned* bar, unsigned x, unsigned& nloc, unsigned& nx) {
    const unsigned G = gridDim.x * gridDim.y * gridDim.z;
    unsigned sum, cnt, mine, sp = 0u;
    for (;;) {
        sum = 0u; cnt = 0u; mine = 0u;
#pragma unroll
        for (unsigned j = 0; j < 16; ++j) { const unsigned c = xb_ld(&bar[XB_XCNT(j)]); sum += c; cnt += (c > 0u) ? 1u : 0u; mine = (j == x) ? c : mine; }
        if (sum == G) break;
        __builtin_amdgcn_s_sleep(1);
        if ((++sp & 255u) == 0u) { if (xb_ld(&bar[XB_TMO])) break; if (sp > XB_SPIN_CAP) { atomicAdd(&bar[XB_TMO], 1u); break; } }
    }
    nloc = mine > 0u ? mine : 1u; nx = cnt > 0u ? cnt : 1u;
}

__device__ __forceinline__ void xcd_barrier(const XcdBarrier& b) {
    asm volatile("s_waitcnt vmcnt(0)" ::: "memory");
    __syncthreads();
    if (threadIdx.x == 0) {
        unsigned* bar = b.bar;
        __builtin_amdgcn_s_waitcnt(0);
        unsigned nloc = b.st[0], nx = b.st[1];
        if (nloc == 0u) { xcd_barrier_complete(bar, b.x, nloc, nx); b.st[0] = nloc; b.st[1] = nx; }
        const unsigned old = xb_add(&bar[XB_XSUB(b.x)], 1u);
        const unsigned gen = old / nloc;
        if (old + 1u == (gen + 1u) * nloc) {
            __builtin_amdgcn_fence(__ATOMIC_RELEASE, "agent");
            asm volatile("s_waitcnt vmcnt(0)" ::: "memory");
            const unsigned og = xb_add(&bar[XB_TOP], 1u);
            const unsigned tg = og / nx;
            if (og + 1u == (tg + 1u) * nx) xb_add(&bar[XB_TOPGEN], 1u);
            else XB_SPIN(xb_ld(&bar[XB_TOPGEN]) == tg, bar);
            __builtin_amdgcn_fence(__ATOMIC_ACQUIRE, "agent");
            xb_add(&bar[XB_XGEN(b.x)], 1u);
            asm volatile("s_waitcnt vmcnt(0)" ::: "memory");
        } else {
            XB_SPIN(xb_ld(&bar[XB_XGEN(b.x)]) == gen, bar);
            __builtin_amdgcn_fence(__ATOMIC_ACQUIRE, "agent");
            asm volatile("s_waitcnt vmcnt(0)" ::: "memory");
        }
    }
    __syncthreads();
}

namespace pg8 {
constexpr int BM = 256, BK = 64, HALF = 128, HTB = HALF * BK * 2  , STAGE_BYTES = 8 * HTB, NXCD = 8, WGM = 8;
__host__ __device__ __forceinline__ int lds_byte(int r, int c) { const int st = (r >> 4) * 2 + (c >> 5), rr = r & 15, cc = c & 31, ob = rr * 64 + cc * 2; return st * 1024 + (ob ^ (((ob >> 9) & 1) << 5)); }
__host__ __device__ __forceinline__ void stage_rc(int b, int& R, int& C) { const int st = b / 1024, sb = b % 1024, swz = sb ^ (((sb >> 9) & 1) << 5); R = (st >> 1) * 16 + swz / 64; C = (st & 1) * 32 + (swz % 64) / 2; }
__host__ __device__ __forceinline__ int perm32(int rho) { const int n = rho >> 4, i = rho & 15; return 8 * (i >> 2) + 4 * n + (i & 3); }

__host__ __device__ __forceinline__ int perm_rows(int R) { return (R & ~31) + perm32(R & 31); }
struct Unit { const char* A; const char* B; int pm, pn, aux; };

__device__ __forceinline__ bool static_tile(int nM, int nN, int G, int c, int i, int& pm, int& pn) {
    const int nwg = nM * nN; const long L = (long)i * G + c; if (L >= nwg) return false;
    int wgid = (int)L; { const int q = nwg / NXCD, r = nwg % NXCD, xcd = wgid % NXCD, off = wgid / NXCD; wgid = (xcd < r ? xcd * (q + 1) : r * (q + 1) + (xcd - r) * q) + off; }
    const int nig = WGM * nN, gid = wgid / nig, fm = gid * WGM, gsz = (nM - fm) < WGM ? (nM - fm) : WGM;
    pm = fm + ((wgid % nig) % gsz); pn = (wgid % nig) / gsz; return true;
}

template <class Epi, class Sched, bool GATHER>
__device__ __forceinline__ void gemm_run(LAS unsigned char* lds, const int K, const Sched& S, const Epi& E) {
    const int tid = tid_opaque(), wid = __builtin_amdgcn_readfirstlane(tid >> 6), lane = tid & 63, wr = wid >> 2, wc = wid & 3, fr = lane & 15, fq = lane >> 4;
    const int nt = K / BK;
    int Rr[2]; unsigned colb[2], voffB[2];
#pragma unroll
    for (int i = 0; i < 2; ++i) { int R, C; stage_rc(tid * 16 + i * 8192, R, C); const int Rb = Epi::brow(R);
        Rr[i] = R; colb[i] = (unsigned)C * 2u; voffB[i] = (unsigned)(Rb * K + C) * 2u; }
    const size_t kstep = (size_t)(BK * 2);
    const size_t hstep = (size_t)Epi::BHALF * K * 2;
    const unsigned ldsw = (unsigned)wid * 1024u;
    const int aoff = lds_byte(wr * 64 + fr, fq * 8), boff = lds_byte(wc * 32 + fr, fq * 8);
#define PG8_SA(b, h) (((b) * 2 + (h)) * HTB)
#define PG8_SB(b, h) ((4 + (b) * 2 + (h)) * HTB)
#define PG8_STAGE(bufoff, gbase, voff) do { _Pragma("unroll") for (int _i = 0; _i < 2; ++_i) \
        __builtin_amdgcn_global_load_lds((const unsigned*)((const char*)(gbase) + (voff)[_i]), (LAS unsigned*)(lds + (bufoff) + ldsw + _i * 8192), 16, 0, 0); } while (0)
#define PG8_LDA(dst, b, h) do { _Pragma("unroll") for (int m = 0; m < 4; ++m) _Pragma("unroll") for (int k = 0; k < 2; ++k) dst[m][k] = *(const LAS bf16x8*)(lds + PG8_SA(b, h) + aoff + m * 2048 + k * 1024); } while (0)
#define PG8_LDB(dst, b, h) do { _Pragma("unroll") for (int n = 0; n < 2; ++n) _Pragma("unroll") for (int k = 0; k < 2; ++k) dst[n][k] = *(const LAS bf16x8*)(lds + PG8_SB(b, h) + boff + n * 2048 + k * 1024); } while (0)
#define PG8_MMA(ai, bj, At, Bt) do { __builtin_amdgcn_s_setprio(1); _Pragma("unroll") for (int m = 0; m < 4; ++m) _Pragma("unroll") for (int n = 0; n < 2; ++n) _Pragma("unroll") for (int k = 0; k < 2; ++k) \
        acc[ai][bj][m][n] = __builtin_amdgcn_mfma_f32_16x16x32_bf16(Bt[n][k], At[m][k], acc[ai][bj][m][n], 0, 0, 0); __builtin_amdgcn_s_setprio(0); } while (0)
#define PG8_WAIT_V(n) asm volatile("s_waitcnt vmcnt(" #n ")" ::: "memory")
#define PG8_WAIT_L(n) asm volatile("s_waitcnt lgkmcnt(" #n ")" ::: "memory")
#define PG8_BAR __builtin_amdgcn_s_barrier()
#define PG8_SCHED __builtin_amdgcn_sched_barrier(0)
#define PG8_AOFF(o, u) do { _Pragma("unroll") for (int _h = 0; _h < 2; ++_h) _Pragma("unroll") for (int _i = 0; _i < 2; ++_i) { \
        const int _r = Rr[_i] + HALF * _h; const unsigned _row = GATHER ? (unsigned)S.arow(u, _r) : (unsigned)_r; o[_h][_i] = _row * (unsigned)(K * 2) + colb[_i]; } } while (0)
    Unit cur, nxt; int ui = 0;
    if (!S.next(0, cur)) return;
    f32x4 acc[2][2][4][2];
#pragma unroll
    for (int a = 0; a < 2; ++a)
#pragma unroll
        for (int b = 0; b < 2; ++b)
#pragma unroll
            for (int m = 0; m < 4; ++m)
#pragma unroll
                for (int n = 0; n < 2; ++n) acc[a][b][m][n] = (f32x4){0.f, 0.f, 0.f, 0.f};
    bf16x8 At[4][2], B0[2][2], B1[2][2];
    unsigned oA[2][2], nOA[2][2];
    const char* cA = cur.A; const char* cB = cur.B;
    PG8_AOFF(oA, cur);
#pragma unroll
    for (int h = 0; h < 2; ++h)
#pragma unroll
        for (int i = 0; i < 2; ++i) nOA[h][i] = oA[h][i];
    PG8_STAGE(PG8_SB(0, 0), cB, voffB); PG8_STAGE(PG8_SB(0, 1), cB + hstep, voffB); PG8_STAGE(PG8_SA(0, 0), cA, oA[0]); PG8_STAGE(PG8_SA(0, 1), cA, oA[1]);
    if (wr == 1) PG8_BAR;
    PG8_WAIT_V(2); PG8_BAR;
    PG8_STAGE(PG8_SB(1, 0), cB + kstep, voffB); PG8_STAGE(PG8_SA(1, 0), cA + kstep, oA[0]); PG8_STAGE(PG8_SB(1, 1), cB + hstep + kstep, voffB);
    PG8_WAIT_V(6); PG8_BAR;
    for (;;) {
        const bool has_next = S.next(ui + 1, nxt);
        const char* nA = has_next ? nxt.A : cA; const char* nB = has_next ? nxt.B : cB;
        if (GATHER) { if (has_next) { PG8_AOFF(nOA, nxt); } }
        for (int t = 0; t < nt; t += 2) {
            const bool last = (t == nt - 2);
            const char* a1 = cA + (size_t)(t + 1) * kstep;
            const char* a2 = last ? nA : cA + (size_t)(t + 2) * kstep; const char* b2 = last ? nB : cB + (size_t)(t + 2) * kstep;
            const char* a3 = a2 + kstep; const char* b3 = b2 + kstep;
            unsigned o2[2][2];
#pragma unroll
            for (int h = 0; h < 2; ++h)
#pragma unroll
                for (int i = 0; i < 2; ++i) o2[h][i] = (GATHER && last) ? nOA[h][i] : oA[h][i];
            PG8_LDB(B0, 0, 0); PG8_LDB(B1, 0, 1); PG8_SCHED; PG8_LDA(At, 0, 0); PG8_STAGE(PG8_SA(1, 1), a1, oA[1]);
            PG8_WAIT_V(8); PG8_WAIT_L(0); PG8_BAR; PG8_MMA(0, 0, At, B0); PG8_MMA(0, 1, At, B1); PG8_BAR; PG8_SCHED;
            PG8_LDA(At, 0, 1); PG8_STAGE(PG8_SB(0, 0), b2, voffB); PG8_STAGE(PG8_SB(0, 1), b2 + hstep, voffB); PG8_STAGE(PG8_SA(0, 0), a2, o2[0]);
            PG8_WAIT_V(8); PG8_WAIT_L(0); PG8_BAR; PG8_MMA(1, 0, At, B0); PG8_MMA(1, 1, At, B1); PG8_BAR; PG8_SCHED;
            PG8_LDB(B0, 1, 0); PG8_LDB(B1, 1, 1); PG8_SCHED; PG8_LDA(At, 1, 0); PG8_STAGE(PG8_SA(0, 1), a2, o2[1]);
            PG8_WAIT_V(8); PG8_WAIT_L(0); PG8_BAR; PG8_MMA(0, 0, At, B0); PG8_MMA(0, 1, At, B1); PG8_BAR; PG8_SCHED;
            PG8_LDA(At, 1, 1); PG8_STAGE(PG8_SB(1, 0), b3, voffB); PG8_STAGE(PG8_SB(1, 1), b3 + hstep, voffB); PG8_STAGE(PG8_SA(1, 0), a3, o2[0]);
            PG8_WAIT_V(8); PG8_WAIT_L(0); PG8_BAR; PG8_MMA(1, 0, At, B0); PG8_MMA(1, 1, At, B1); PG8_BAR; PG8_SCHED;
        }
        if (wr == 0) PG8_BAR;
        const bool keep = E(acc, cur, wr, wc, fr, fq);
        if (!has_next) break;
        if (!keep) {
#pragma unroll
            for (int a = 0; a < 2; ++a)
#pragma unroll
                for (int b = 0; b < 2; ++b)
#pragma unroll
                    for (int m = 0; m < 4; ++m)
#pragma unroll
                        for (int n = 0; n < 2; ++n) acc[a][b][m][n] = (f32x4){0.f, 0.f, 0.f, 0.f};
        }
        cur = nxt; cA = nA; cB = nB; ++ui;
        if (GATHER) {
#pragma unroll
            for (int h = 0; h < 2; ++h)
#pragma unroll
                for (int i = 0; i < 2; ++i) oA[h][i] = nOA[h][i];
        }
        if (wr == 1) PG8_BAR;
    }
    PG8_WAIT_V(0);
    PG8_BAR;
#undef PG8_SA
#undef PG8_SB
#undef PG8_STAGE
#undef PG8_LDA
#undef PG8_LDB
#undef PG8_MMA
#undef PG8_WAIT_V
#undef PG8_WAIT_L
#undef PG8_BAR
#undef PG8_SCHED
#undef PG8_AOFF
}
}
template <class RowMap>
__device__ __forceinline__ void transpose_item(const float* W, int K, int ld, bf16_t* WT, RowMap rowmap, LAS float* scr, int kb, int nb, int lane) {
    const int k0 = 64 * kb, n0 = 32 * nb;
#pragma unroll 8
    for (int i = 0; i < 32; ++i) { const int kk = 2 * i + (lane >> 5); scr[kk * 33 + (lane & 31)] = W[(size_t)(k0 + kk) * ld + n0 + (lane & 31)]; }
    asm volatile("s_waitcnt lgkmcnt(0)" ::: "memory");
    const int c = lane & 7;
#pragma unroll
    for (int j = 0; j < 4; ++j) { const int n = (lane >> 3) + 8 * j; const LAS float* s = scr + (8 * c) * 33 + n;
        u32x4 o; o.x = cvt_pk_bf16(s[0 * 33], s[1 * 33]); o.y = cvt_pk_bf16(s[2 * 33], s[3 * 33]); o.z = cvt_pk_bf16(s[4 * 33], s[5 * 33]); o.w = cvt_pk_bf16(s[6 * 33], s[7 * 33]);
        *(u32x4*)(WT + (size_t)rowmap(n0 + n) * K + k0 + 8 * c) = o; }
    asm volatile("s_waitcnt lgkmcnt(0)" ::: "memory");
}
template <class RowMap>
__device__ __forceinline__ void transpose_item64(const float* W, int K, int ld, bf16_t* WT, RowMap rowmap, LAS float* scr, int kb, int nb, int lane, const float* kscale = nullptr) {
    const int k0 = 64 * kb, n0 = 64 * nb, lr = lane >> 4, lc = (lane & 15) * 4;
    f32x4 v[16];
#pragma unroll
    for (int i = 0; i < 16; ++i) v[i] = *(const f32x4*)(W + (size_t)(k0 + 4 * i + lr) * ld + n0 + lc);
    if (kscale) {
#pragma unroll
        for (int i = 0; i < 16; ++i) v[i] = v[i] * kscale[k0 + 4 * i + lr]; }
#pragma unroll
    for (int i = 0; i < 16; ++i) { LAS float* d = scr + (4 * i + lr) * 65 + lc; d[0] = v[i].x; d[1] = v[i].y; d[2] = v[i].z; d[3] = v[i].w; }
    asm volatile("s_waitcnt lgkmcnt(0)" ::: "memory");
    const int c = lane & 7;
#pragma unroll
    for (int j = 0; j < 8; ++j) { const int n = (lane >> 3) + 8 * j; const LAS float* s = scr + (8 * c) * 65 + n;
        u32x4 o; o.x = cvt_pk_bf16(s[0 * 65], s[1 * 65]); o.y = cvt_pk_bf16(s[2 * 65], s[3 * 65]); o.z = cvt_pk_bf16(s[4 * 65], s[5 * 65]); o.w = cvt_pk_bf16(s[6 * 65], s[7 * 65]);
        *(u32x4*)(WT + (size_t)rowmap(n0 + n) * K + k0 + 8 * c) = o; }
    asm volatile("s_waitcnt lgkmcnt(0)" ::: "memory");
}
struct RowId { int off; __device__ __forceinline__ int operator()(int n) const { return off + n; } };
struct RowUp { int which; __device__ __forceinline__ int operator()(int n) const { return 256 * (n >> 7) + 128 * which + (n & 127); } };

__device__ __forceinline__ void p0_prologue(LAS unsigned char* lds, const float* const* in, unsigned char* ws, int G) {
    const int tid = tid_opaque(), lane = tid & 63, wave = __builtin_amdgcn_readfirstlane(tid >> 6);
    const int gw = blockIdx.x * NWAVES + wave, NGW = G * NWAVES;
    LAS float* scr = (LAS float*)(lds + wave * 16640);
    const float* w_in = in[2]; const float* w_da = in[15]; const float* w_ml = in[16]; const float* w_gate = in[17]; const float* w_out = in[19];
    bf16_t* WinT = (bf16_t*)(ws + WS_WIN); bf16_t* WdaT = (bf16_t*)(ws + WS_WDA); bf16_t* WmlT = (bf16_t*)(ws + WS_WML); bf16_t* WoutT = (bf16_t*)(ws + WS_WOUT);
    constexpr int I_IN = 16 * (3584 / 64), I_G = 16 * (2048 / 64), I_DA = 8 * (1024 / 64), I_ML = I_DA, I_OUT = 16 * (1024 / 64);
    constexpr int NITEMS = I_IN + I_G + I_DA + I_ML + I_OUT;
    for (int it = gw; it < NITEMS; it += NGW) {
        int r = it;
        if (r < I_IN) { transpose_item64(w_in, 1024, IN_W, WinT, RowId{0}, scr, r / 56, r % 56, lane); continue; } r -= I_IN;
        if (r < I_G) { transpose_item64(w_gate, 1024, 2048, WinT, RowId{3584}, scr, r / 32, r % 32, lane); continue; } r -= I_G;
        if (r < I_DA) { transpose_item64(w_da, 512, 1024, WdaT, RowId{0}, scr, r / 16, r % 16, lane); continue; } r -= I_DA;
        if (r < I_ML) { transpose_item64(w_ml, 512, 1024, WmlT, RowId{0}, scr, r / 16, r % 16, lane); continue; } r -= I_ML;
        transpose_item64(w_out, 1024, 1024, WoutT, RowId{0}, scr, r / 16, r % 16, lane);
    }
    __syncthreads();
    LAS float* wif = (LAS float*)lds;
    for (int i = tid; i < 8192; i += NTHREADS) { const int d = i >> 3, j = i & 7; wif[j * 1024 + d] = w_in[(size_t)d * IN_W + 3584 + j]; }
    __syncthreads();
    const float* x = in[0]; const float* g = in[1]; const float* ib = in[12]; const float* fb = in[13];
    bf16_t* HB = (bf16_t*)(ws + WS_HB); float* IFP = (float*)(ws + WS_IFP);
    f32x4 gv[4];
#pragma unroll
    for (int j = 0; j < 4; ++j) gv[j] = *(const f32x4*)(g + lane * 4 + 256 * j);
    const int pidx = ((lane >> 5) & 1) * 8 + ((lane >> 4) & 1) * 4 + ((lane >> 3) & 1) * 2 + ((lane >> 2) & 1), pr = pidx >> 3, pc = pidx & 7;
    const float pbias = (pc < 4) ? ib[pc] : fb[pc - 4];
    for (int row0 = gw * 4; row0 < T; row0 += NGW * 4) {
        f32x4 v[4][4];
#pragma unroll
        for (int r = 0; r < 4; ++r) { const f32x4* xr = (const f32x4*)(x + (size_t)(row0 + r) * D) + lane;
#pragma unroll
            for (int j = 0; j < 4; ++j) v[r][j] = xr[64 * j]; }
#pragma unroll
        for (int r = 0; r < 4; ++r) { float s = 0.f;
#pragma unroll
            for (int j = 0; j < 4; ++j) s += (v[r][j].x * v[r][j].x + v[r][j].y * v[r][j].y) + (v[r][j].z * v[r][j].z + v[r][j].w * v[r][j].w);
            const float rstd = 1.0f / sqrtf(wave_sum(s) * (1.f / D) + NORM_EPS);
            unsigned long long* o8 = (unsigned long long*)(HB + (size_t)(row0 + r) * D) + lane;
#pragma unroll
            for (int j = 0; j < 4; ++j) { v[r][j] = v[r][j] * rstd * gv[j];
                o8[64 * j] = (unsigned long long)cvt_pk_bf16(v[r][j].x, v[r][j].y) | ((unsigned long long)cvt_pk_bf16(v[r][j].z, v[r][j].w) << 32); }
        }
#pragma unroll
        for (int rp = 0; rp < 2; ++rp) {
            float p[16];
#pragma unroll
            for (int c = 0; c < 8; ++c) {
                f32x4 w[4];
#pragma unroll
                for (int j = 0; j < 4; ++j) w[j] = *(const LAS f32x4*)(wif + c * 1024 + lane * 4 + 256 * j);
#pragma unroll
                for (int r = 0; r < 2; ++r) { float a = 0.f;
#pragma unroll
                    for (int j = 0; j < 4; ++j) a += (v[2 * rp + r][j].x * w[j].x + v[2 * rp + r][j].y * w[j].y) + (v[2 * rp + r][j].z * w[j].z + v[2 * rp + r][j].w * w[j].w);
                    p[r * 8 + c] = a; }
            }
            { const bool up = (lane & 32) != 0;
#pragma unroll
              for (int i = 0; i < 8; ++i) { const float send = up ? p[i] : p[8 + i]; const float keep = up ? p[8 + i] : p[i]; p[i] = keep + __shfl_xor(send, 32); } }
            { const bool up = (lane & 16) != 0;
#pragma unroll
              for (int i = 0; i < 4; ++i) { const float send = up ? p[i] : p[4 + i]; const float keep = up ? p[4 + i] : p[i]; p[i] = keep + __shfl_xor(send, 16); } }
            { const bool up = (lane & 8) != 0;
#pragma unroll
              for (int i = 0; i < 2; ++i) { const float send = up ? p[i] : p[2 + i]; const float keep = up ? p[2 + i] : p[i]; p[i] = keep + __shfl_xor(send, 8); } }
            { const bool up = (lane & 4) != 0; const float send = up ? p[0] : p[1]; const float keep = up ? p[1] : p[0]; p[0] = keep + __shfl_xor(send, 4); }
            p[0] += __shfl_xor(p[0], 2); p[0] += __shfl_xor(p[0], 1);
            if ((lane & 3) == 0) {
                float val = p[0] + pbias;
                if (pc >= 4) { const float z = val; val = fminf(z, 0.f) - log1pf(__expf(-fabsf(z))); }
                IFP[(size_t)(row0 + 2 * rp + pr) * 8 + pc] = val;
            }
        }
    }
}

__device__ __forceinline__ void moe_weight_convert(LAS unsigned char* lds, const float* const* in, unsigned char* ws, int G) {
    const int tid = tid_opaque(), lane = tid & 63, wave = __builtin_amdgcn_readfirstlane(tid >> 6);
    const int gw = blockIdx.x * NWAVES + wave, NGW = G * NWAVES;
    LAS float* scr = (LAS float*)(lds + wave * 16640);
    const float* w1 = in[25]; const float* w3 = in[26]; const float* w2 = in[27];
    bf16_t* W13 = (bf16_t*)(ws + WS_W13); bf16_t* W2T = (bf16_t*)(ws + WS_W2);
    constexpr int I_UP = 16 * 8;
    constexpr int I_DN = 8 * 16;
    constexpr int NIT = NEXP * (2 * I_UP + I_DN);
    for (int it = gw; it < NIT; it += NGW) {
        const int e = it / (2 * I_UP + I_DN); int r = it % (2 * I_UP + I_DN);
        if (r < I_UP) { transpose_item64(w1 + (size_t)e * 1024 * 512, 1024, 512, W13 + (size_t)e * 1024 * 1024, RowUp{0}, scr, r / 8, r % 8, lane, in[20]); continue; } r -= I_UP;
        if (r < I_UP) { transpose_item64(w3 + (size_t)e * 1024 * 512, 1024, 512, W13 + (size_t)e * 1024 * 1024, RowUp{1}, scr, r / 8, r % 8, lane, in[20]); continue; } r -= I_UP;
        transpose_item64(w2 + (size_t)e * 512 * 1024, 512, 1024, W2T + (size_t)e * 1024 * 512, RowId{0}, scr, r / 16, r % 16, lane);
    }
}

__device__ __forceinline__ void da_qk_norm(unsigned char* ws, const float* gq, const float* gk, int G) {
    const int tid = tid_opaque(), lane = tid & 63, wave = __builtin_amdgcn_readfirstlane(tid >> 6);
    const int gw = blockIdx.x * NWAVES + wave, NGW = G * NWAVES;
    bf16_t* P = (bf16_t*)(ws + WS_P);
    const bool isq = lane < 32; const float* gsrc = (isq ? gq : gk) + (lane & 3) * 16; const float extra = isq ? (0.125f * LOG2E) : 1.0f;
    float gn[16];
#pragma unroll
    for (int i = 0; i < 16; ++i) gn[i] = gsrc[i] * extra;
    for (int row = gw; row < T; row += NGW) {
        u32x4* p = (u32x4*)(P + (size_t)row * PW + lane * 16);
        const u32x4 a = p[0], b = p[1];
        float v[16];
        v[0] = bf_lo(a.x); v[1] = bf_hi(a.x); v[2] = bf_lo(a.y); v[3] = bf_hi(a.y); v[4] = bf_lo(a.z); v[5] = bf_hi(a.z); v[6] = bf_lo(a.w); v[7] = bf_hi(a.w);
        v[8] = bf_lo(b.x); v[9] = bf_hi(b.x); v[10] = bf_lo(b.y); v[11] = bf_hi(b.y); v[12] = bf_lo(b.z); v[13] = bf_hi(b.z); v[14] = bf_lo(b.w); v[15] = bf_hi(b.w);
        float s = 0.f;
#pragma unroll
        for (int i = 0; i < 16; ++i) s += v[i] * v[i];
        s += __shfl_xor(s, 1); s += __shfl_xor(s, 2);
        const float rstd = 1.0f / sqrtf(s * (1.f / 64.f) + NORM_EPS);
#pragma unroll
        for (int i = 0; i < 16; ++i) v[i] = v[i] * rstd * gn[i];
        u32x4 oa, ob;
        oa.x = cvt_pk_bf16(v[0], v[1]); oa.y = cvt_pk_bf16(v[2], v[3]); oa.z = cvt_pk_bf16(v[4], v[5]); oa.w = cvt_pk_bf16(v[6], v[7]);
        ob.x = cvt_pk_bf16(v[8], v[9]); ob.y = cvt_pk_bf16(v[10], v[11]); ob.z = cvt_pk_bf16(v[12], v[13]); ob.w = cvt_pk_bf16(v[14], v[15]);
        p[0] = oa; p[1] = ob;
    }
}
typedef short v4i16_t __attribute__((ext_vector_type(4)));
constexpr int AT_KSTR = 1040;
constexpr int AT_KBUF = 16 * AT_KSTR;
constexpr int AT_QSTR = 528, AT_QBUF = 16 * AT_QSTR;
constexpr int AT_KOFF = 0, AT_VOFF = 2 * AT_KBUF, AT_QOFF = AT_VOFF + 2 * 16384;
static_assert(AT_QOFF + 8 * AT_QBUF <= LDS_MISC_OFF, "attention LDS");
__device__ __forceinline__ int crow(int r, int hi) { return (r & 3) + 8 * (r >> 2) + 4 * hi; }
__device__ __forceinline__ int v_off(int row, int ch) { return 2048 * (row >> 3) + 512 * (ch >> 2) + 64 * (row & 7) + 16 * ((ch & 3) ^ ((row >> 2) & 3)); }

__device__ __forceinline__ void attn_unit(LAS unsigned char* lds, const bf16_t* P, bf16_t* YDA, int b, int h, int qb, float lam, float mref, float slope2, const float* gout) {
    const int tid = tid_opaque(), lane = tid & 63, r32 = lane & 31, hh = lane >> 5, wid = __builtin_amdgcn_readfirstlane(tid >> 6);
    const int rowbase = b * SEQ;
    const int q0 = qb * 256 + wid * 32;
    const int qpos = q0 + r32;
    LAS unsigned char* Qw = lds + AT_QOFF + wid * AT_QBUF;
    const __amdgpu_buffer_rsrc_t prs = __builtin_amdgcn_make_buffer_rsrc((void*)P, 0, (int)0x7fffffff, 0x00020000);
    const int pbase = (rowbase * PW + h * 128) * 2;
    { const int qo = ((lane >> 4) * PW + PC_Q + (lane & 15) * 8) * 2;
#pragma unroll
      for (int i = 0; i < 8; ++i) { const int r = (lane >> 4) + 4 * i; const u32x4 v = __builtin_amdgcn_raw_buffer_load_b128(prs, qo, pbase + (q0 + 4 * i) * PW * 2, 0);
          *(LAS u32x4*)(Qw + (lane & 15) * AT_QSTR + r * 16) = v; } }
    const LAS unsigned char* qrd = Qw + hh * AT_QSTR + r32 * 16;
    f32x16 o1[4], o2[4];
#pragma unroll
    for (int t = 0; t < 4; ++t) { o1[t] = f32x16{}; o2[t] = f32x16{}; }
    float l1 = 0.f, l2 = 0.f;
    const int ntiles = 4 * qb + 4;
    const int sch = tid & 15;
    unsigned kdst[2], vdst[2]; int goff[2];
#pragma unroll
    for (int i = 0; i < 2; ++i) { const int r = (tid >> 4) + 32 * i; goff[i] = (r * PW + PC_K + sch * 8) * 2;
        kdst[i] = (unsigned)(sch * AT_KSTR + r * 16);
        vdst[i] = (unsigned)v_off(r, sch); }
    u32x4 kreg[2], vreg[2];
#define AT_LOADT(kt) do { const int _so = pbase + (kt) * 64 * PW * 2; _Pragma("unroll") for (int _i = 0; _i < 2; ++_i) { \
        kreg[_i] = __builtin_amdgcn_raw_buffer_load_b128(prs, goff[_i], _so, 0); vreg[_i] = __builtin_amdgcn_raw_buffer_load_b128(prs, goff[_i] + (PC_V - PC_K) * 2, _so, 0); } } while (0)
#define AT_WRITET(buf) do { _Pragma("unroll") for (int _i = 0; _i < 2; ++_i) { \
        *(LAS u32x4*)(lds + AT_KOFF + (buf) * AT_KBUF + kdst[_i]) = kreg[_i]; *(LAS u32x4*)(lds + AT_VOFF + (buf) * 16384 + vdst[_i]) = vreg[_i]; } } while (0)
    AT_LOADT(ntiles - 1); AT_WRITET(0); __syncthreads();
    const int tg = lane >> 4, tq = (lane >> 2) & 3, tp = lane & 3;
    const int vlo = 64 * (4 * hh + tq) + 16 * ((2 * (tg & 1) + (tp >> 1)) ^ hh) + 8 * (tp & 1);
    const int vhi = 64 * (4 * hh + tq) + 16 * ((2 * (tg & 1) + (tp >> 1)) ^ (hh + 2)) + 8 * (tp & 1);
    const int klane = hh * AT_KSTR + r32 * 16;
    for (int it = 0; it < ntiles; ++it) {
        const int kt = ntiles - 1 - it, cur = it & 1;
        if (it + 1 < ntiles) AT_LOADT(kt - 1);
        const int kb0 = kt * 64;
        const LAS unsigned char* Kb = lds + AT_KOFF + cur * AT_KBUF + klane;
        const LAS unsigned char* Vlo = lds + AT_VOFF + cur * 16384 + vlo;
        const LAS unsigned char* Vhi = lds + AT_VOFF + cur * 16384 + vhi;
#pragma unroll
        for (int sb = 0; sb < 2; ++sb) {
            const int kb = kb0 + 32 * sb;
            if (kb <= q0 + 31) {
                const float base = slope2 * (float)(kb + 4 * hh - qpos) - mref;
                bf16x8 pf1[2], pf2[2];
#pragma unroll
                for (int mp = 0; mp < 2; ++mp) {
                    f32x16 sc;
#pragma unroll
                    for (int r = 0; r < 16; ++r) sc[r] = __builtin_fmaf(slope2, (float)((r & 3) + 8 * (r >> 2)), base);
#pragma unroll
                    for (int dd = 0; dd < 4; ++dd) {
                        const bf16x8 ka = *(const LAS bf16x8*)(Kb + (mp * 8 + dd * 2) * AT_KSTR + sb * 512);
                        const bf16x8 qa = *(const LAS bf16x8*)(qrd + (mp * 8 + dd * 2) * AT_QSTR);
                        sc = __builtin_amdgcn_mfma_f32_32x32x16_bf16(ka, qa, sc, 0, 0, 0);
                    }
                    if (kb + 31 > q0) {
#pragma unroll
                        for (int r = 0; r < 16; ++r) { const bool dead = (kb + crow(r, hh)) > qpos; sc[r] = dead ? -INFINITY : sc[r]; }
                    }
                    float ls = 0.f;
#pragma unroll
                    for (int r = 0; r < 16; ++r) { sc[r] = __builtin_amdgcn_exp2f(sc[r]); ls += sc[r]; }
#pragma unroll
                    for (int s = 0; s < 2; ++s) {
                        u32x4 w;
                        w.x = cvt_pk_bf16(sc[8 * s + 0], sc[8 * s + 1]); w.y = cvt_pk_bf16(sc[8 * s + 2], sc[8 * s + 3]); w.z = cvt_pk_bf16(sc[8 * s + 4], sc[8 * s + 5]); w.w = cvt_pk_bf16(sc[8 * s + 6], sc[8 * s + 7]);
                        if (mp == 0) pf1[s] = __builtin_bit_cast(bf16x8, w); else pf2[s] = __builtin_bit_cast(bf16x8, w);
                    }
                    if (mp == 0) l1 += ls; else l2 += ls;
                }
#pragma unroll
                for (int s = 0; s < 2; ++s) {
#pragma unroll
                    for (int t = 0; t < 4; ++t) {
                        const s16x4 lo = __builtin_bit_cast(s16x4, __builtin_amdgcn_ds_read_tr16_b64_v4i16((LAS v4i16_t*)(Vlo + 2048 * (4 * sb + 2 * s) + 512 * t)));
                        const s16x4 hi = __builtin_bit_cast(s16x4, __builtin_amdgcn_ds_read_tr16_b64_v4i16((LAS v4i16_t*)(Vhi + 2048 * (4 * sb + 2 * s + 1) + 512 * t)));
                        const bf16x8 vf = (bf16x8){lo[0], lo[1], lo[2], lo[3], hi[0], hi[1], hi[2], hi[3]};
                        o1[t] = __builtin_amdgcn_mfma_f32_32x32x16_bf16(vf, pf1[s], o1[t], 0, 0, 0);
                        o2[t] = __builtin_amdgcn_mfma_f32_32x32x16_bf16(vf, pf2[s], o2[t], 0, 0, 0);
                    }
                }
            }
        }
        if (it + 1 < ntiles) AT_WRITET(cur ^ 1);
        __syncthreads();
    }
#undef AT_LOADT
#undef AT_WRITET
    l1 += __shfl_xor(l1, 32); l2 += __shfl_xor(l2, 32);
    const float inv1 = 1.0f / l1, c2 = lam / l2;
    float ss = 0.f;
#pragma unroll
    for (int t = 0; t < 4; ++t)
#pragma unroll
        for (int r = 0; r < 16; ++r) { const float v = o1[t][r] * inv1 - o2[t][r] * c2; o1[t][r] = v; ss += v * v; }
    ss += __shfl_xor(ss, 32);
    const float rstd = 0.8f / sqrtf(ss * (1.f / 128.f) + NORM_EPS);
    bf16_t* yrow = YDA + (size_t)(rowbase + qpos) * 512 + h * 128 + 4 * hh;
#pragma unroll
    for (int t = 0; t < 4; ++t)
#pragma unroll
        for (int g4 = 0; g4 < 4; ++g4) {
            const f32x4 gv = *(const f32x4*)(gout + 32 * t + 8 * g4 + 4 * hh);
            u32x2 w; w.x = cvt_pk_bf16(o1[t][4 * g4 + 0] * rstd * gv.x, o1[t][4 * g4 + 1] * rstd * gv.y); w.y = cvt_pk_bf16(o1[t][4 * g4 + 2] * rstd * gv.z, o1[t][4 * g4 + 3] * rstd * gv.w);
            *(u32x2*)(yrow + 32 * t + 8 * g4) = w;
        }
}

#ifndef ASTAMP
#define ASTAMP(k) do { } while (0)
#endif
__device__ __forceinline__ void attn_unit2(LAS unsigned char* lds, const bf16_t* P, bf16_t* YDA, int b, int h, int j, int kt_lo, float lam, float mref, float slope2, const float* gout) {
    const int tid = tid_opaque(), lane = tid & 63, r32 = lane & 31, hh = lane >> 5, wid = __builtin_amdgcn_readfirstlane(tid >> 6);
    const int rg = wid & 3, mp = wid >> 2;
    const int rowbase = b * SEQ;
    const int q0 = j * 128 + rg * 32;
    const int qpos = q0 + r32;
    const __amdgpu_buffer_rsrc_t prs = __builtin_amdgcn_make_buffer_rsrc((void*)P, 0, (int)0x7fffffff, 0x00020000);
    const int pbase = (rowbase * PW + h * 128) * 2;
    LAS unsigned char* Qw = lds + AT_QOFF + rg * AT_QBUF;
    { const int ch = mp * 8 + (lane & 7); const int qo = ((lane >> 3) * PW + PC_Q + ch * 8) * 2;
#pragma unroll
      for (int i = 0; i < 4; ++i) { const int r = (lane >> 3) + 8 * i; const u32x4 v = __builtin_amdgcn_raw_buffer_load_b128(prs, qo, pbase + (q0 + 8 * i) * PW * 2, 0);
          *(LAS u32x4*)(Qw + ch * AT_QSTR + r * 16) = v; } }
    const LAS unsigned char* qrd = Qw + (mp * 8 + hh) * AT_QSTR + r32 * 16;
    f32x16 o[4];
#pragma unroll
    for (int t = 0; t < 4; ++t) o[t] = f32x16{};
    float l = 0.f;
    const int kt_hi = 2 * j + 1, ntiles = kt_hi - kt_lo + 1;
    const int sch = tid & 15;
    unsigned kdst[2], vdst[2]; int goff[2];
#pragma unroll
    for (int i = 0; i < 2; ++i) { const int r = (tid >> 4) + 32 * i; goff[i] = (r * PW + PC_K + sch * 8) * 2;
        kdst[i] = (unsigned)(sch * AT_KSTR + r * 16);
        vdst[i] = (unsigned)v_off(r, sch); }
    u32x4 krA[2], vrA[2], krB[2], vrB[2];
#define AT_LOADT(KR, VR, kt) do { const int _so = pbase + (kt) * 64 * PW * 2; _Pragma("unroll") for (int _i = 0; _i < 2; ++_i) { \
        KR[_i] = __builtin_amdgcn_raw_buffer_load_b128(prs, goff[_i], _so, 0); VR[_i] = __builtin_amdgcn_raw_buffer_load_b128(prs, goff[_i] + (PC_V - PC_K) * 2, _so, 0); } } while (0)
#define AT_WRITET(KR, VR, buf) do { _Pragma("unroll") for (int _i = 0; _i < 2; ++_i) { \
        *(LAS u32x4*)(lds + AT_KOFF + (buf) * AT_KBUF + kdst[_i]) = KR[_i]; *(LAS u32x4*)(lds + AT_VOFF + (buf) * 16384 + vdst[_i]) = VR[_i]; } } while (0)
    AT_LOADT(krA, vrA, kt_hi);
    if (ntiles > 1) AT_LOADT(krB, vrB, kt_hi - 1);
    AT_WRITET(krA, vrA, 0); __syncthreads();
    if (ntiles > 2) AT_LOADT(krA, vrA, kt_hi - 2);
    const int tg = lane >> 4, tq = (lane >> 2) & 3, tp = lane & 3;
    const int vlo = 64 * (4 * hh + tq) + 16 * ((2 * (tg & 1) + (tp >> 1)) ^ hh) + 8 * (tp & 1);
    const int vhi = 64 * (4 * hh + tq) + 16 * ((2 * (tg & 1) + (tp >> 1)) ^ (hh + 2)) + 8 * (tp & 1);
    const int klane = (mp * 8 + hh) * AT_KSTR + r32 * 16;
    bf16x8 qf[4];
#pragma unroll
    for (int dd = 0; dd < 4; ++dd) qf[dd] = *(const LAS bf16x8*)(qrd + (dd * 2) * AT_QSTR);
#define AT_VREAD(sb_, s_, t_) (__builtin_amdgcn_ds_read_tr16_b64_v4i16((LAS v4i16_t*)(Vlo + 2048 * (4 * (sb_) + 2 * (s_)) + 512 * (t_))))
#define AT_VREADH(sb_, s_, t_) (__builtin_amdgcn_ds_read_tr16_b64_v4i16((LAS v4i16_t*)(Vhi + 2048 * (4 * (sb_) + 2 * (s_) + 1) + 512 * (t_))))
#define AT_BLOCK(sb_) do { const int kb = kb0 + 32 * (sb_); \
        v4i16_t vl[2][4], vh[2][4]; \
        _Pragma("unroll") for (int s = 0; s < 2; ++s) _Pragma("unroll") for (int t = 0; t < 4; ++t) { vl[s][t] = AT_VREAD(sb_, s, t); vh[s][t] = AT_VREADH(sb_, s, t); } \
        __builtin_amdgcn_sched_barrier(0); \
        const float base = slope2 * (float)(kb + 4 * hh - qpos) - mref; \
        f32x16 sc; \
        _Pragma("unroll") for (int r = 0; r < 16; ++r) sc[r] = __builtin_fmaf(slope2, (float)((r & 3) + 8 * (r >> 2)), base); \
        _Pragma("unroll") for (int dd = 0; dd < 4; ++dd) sc = __builtin_amdgcn_mfma_f32_32x32x16_bf16(kf[dd], qf[dd], sc, 0, 0, 0); \
        __builtin_amdgcn_sched_barrier(0); \
        if ((sb_) == 0 && (kb0 + 32 <= q0 + 31)) { _Pragma("unroll") for (int dd = 0; dd < 4; ++dd) kf[dd] = *(const LAS bf16x8*)(Kb + (dd * 2) * AT_KSTR + 512); } \
        if (kb + 31 > q0) { \
            _Pragma("unroll") for (int r = 0; r < 16; ++r) { const bool dead = (kb + crow(r, hh)) > qpos; sc[r] = dead ? -INFINITY : sc[r]; } \
        } \
        _Pragma("unroll") for (int r = 0; r < 16; ++r) { sc[r] = __builtin_amdgcn_exp2f(sc[r]); l += sc[r]; } \
        bf16x8 pf[2]; \
        _Pragma("unroll") for (int s = 0; s < 2; ++s) { u32x4 w; \
            w.x = cvt_pk_bf16(sc[8 * s + 0], sc[8 * s + 1]); w.y = cvt_pk_bf16(sc[8 * s + 2], sc[8 * s + 3]); w.z = cvt_pk_bf16(sc[8 * s + 4], sc[8 * s + 5]); w.w = cvt_pk_bf16(sc[8 * s + 6], sc[8 * s + 7]); \
            pf[s] = __builtin_bit_cast(bf16x8, w); } \
        __builtin_amdgcn_sched_barrier(0); \
        _Pragma("unroll") for (int s = 0; s < 2; ++s) _Pragma("unroll") for (int t = 0; t < 4; ++t) { \
            const s16x4 lo = __builtin_bit_cast(s16x4, vl[s][t]), hi = __builtin_bit_cast(s16x4, vh[s][t]); \
            const bf16x8 vf = (bf16x8){lo[0], lo[1], lo[2], lo[3], hi[0], hi[1], hi[2], hi[3]}; \
            o[t] = __builtin_amdgcn_mfma_f32_32x32x16_bf16(vf, pf[s], o[t], 0, 0, 0); } \
        __builtin_amdgcn_sched_barrier(0); \
    } while (0)
#define AT_COMPUTE(it_) do { const int kt = kt_hi - (it_); const int cur = (it_) & 1; \
        const int kb0 = kt * 64; \
        if (kb0 <= q0 + 31) { \
            const LAS unsigned char* Kb = lds + AT_KOFF + cur * AT_KBUF + klane; \
            const LAS unsigned char* Vlo = lds + AT_VOFF + cur * 16384 + vlo; \
            const LAS unsigned char* Vhi = lds + AT_VOFF + cur * 16384 + vhi; \
            bf16x8 kf[4]; \
            _Pragma("unroll") for (int dd = 0; dd < 4; ++dd) kf[dd] = *(const LAS bf16x8*)(Kb + (dd * 2) * AT_KSTR); \
            AT_BLOCK(0); \
            if (kb0 + 32 <= q0 + 31) AT_BLOCK(1); \
        } \
    } while (0)
    for (int it = 0; it < ntiles; it += 2) {
        AT_COMPUTE(it);
        if (it + 1 < ntiles) AT_WRITET(krB, vrB, 1);
        __syncthreads();
        if (it + 3 < ntiles) AT_LOADT(krB, vrB, kt_hi - it - 3);
        if (it + 1 < ntiles) {
            AT_COMPUTE(it + 1);
            if (it + 2 < ntiles) AT_WRITET(krA, vrA, 0);
            __syncthreads();
            if (it + 4 < ntiles) AT_LOADT(krA, vrA, kt_hi - it - 4);
        }
    }
#undef AT_COMPUTE
#undef AT_BLOCK
#undef AT_VREAD
#undef AT_VREADH
#undef AT_LOADT
#undef AT_WRITET
    l += __shfl_xor(l, 32);
    LAS float* CB = (LAS float*)(lds + AT_KOFF + rg * 16384) + lane;
    if (mp == 1) {
        const float c2 = lam / l;
#pragma unroll
        for (int t = 0; t < 4; ++t)
#pragma unroll
            for (int r = 0; r < 16; ++r) CB[(t * 16 + r) * 64] = o[t][r] * c2;
    }
    __syncthreads();
    if (mp == 0) {
        const float inv1 = 1.0f / l;
        float ss = 0.f;
#pragma unroll
        for (int t = 0; t < 4; ++t)
#pragma unroll
            for (int r = 0; r < 16; ++r) { const float v = o[t][r] * inv1 - CB[(t * 16 + r) * 64]; o[t][r] = v; ss += v * v; }
        ss += __shfl_xor(ss, 32);
        const float rstd = 0.8f / sqrtf(ss * (1.f / 128.f) + NORM_EPS);
        bf16_t* yrow = YDA + (size_t)(rowbase + qpos) * 512 + h * 128 + 4 * hh;
#pragma unroll
        for (int t = 0; t < 4; ++t)
#pragma unroll
            for (int g4 = 0; g4 < 4; ++g4) {
                const f32x4 gv = *(const f32x4*)(gout + 32 * t + 8 * g4 + 4 * hh);
                u32x2 w; w.x = cvt_pk_bf16(o[t][4 * g4 + 0] * rstd * gv.x, o[t][4 * g4 + 1] * rstd * gv.y); w.y = cvt_pk_bf16(o[t][4 * g4 + 2] * rstd * gv.z, o[t][4 * g4 + 3] * rstd * gv.w);
                *(u32x2*)(yrow + 32 * t + 8 * g4) = w;
            }
    }
    __syncthreads();
}

__device__ __forceinline__ int attn_kt_lo(int j, float dh) { const float f = (128.f * (float)j - 63.f - dh) * (1.f / 64.f); const int k = f >= 0.f ? (int)floorf(f) + 1 : 0; return k > 2 * j + 1 ? 2 * j + 1 : k; }

__device__ __forceinline__ void attn_phase(LAS unsigned char* lds, const float* const* in, unsigned char* ws, int G) {
    const bf16_t* P = (const bf16_t*)(ws + WS_P); bf16_t* YDA = (bf16_t*)(ws + WS_YDA);
    const float* gq = in[3]; const float* gk = in[4]; const float* lq1 = in[5]; const float* lk1 = in[6]; const float* lq2 = in[7]; const float* lk2 = in[8]; const float* gout = in[9];
    float lam, mref;
    { const int ln = threadIdx.x & 63;
      float mq = fabsf(gq[ln]), mk = fabsf(gk[ln]), a1 = lq1[ln] * lk1[ln], a2 = lq2[ln] * lk2[ln];
#pragma unroll
      for (int o = 1; o < 64; o <<= 1) { mq = fmaxf(mq, __shfl_xor(mq, o)); mk = fmaxf(mk, __shfl_xor(mk, o)); a1 += __shfl_xor(a1, o); a2 += __shfl_xor(a2, o); }
      lam = __expf(a1) - __expf(a2) + 0.2f;
      mref = 8.0f * mq * mk * LOG2E * 1.02f + 0.25f; }
    const float thr = 2.0f * mref + 45.0f;
    const int tid = tid_opaque(), lane = tid & 63;
    LAS int* cst = (LAS int*)(lds + AT_QOFF); LAS int* sel = cst + 128;
    const int b = blockIdx.x & 7, bin = blockIdx.x >> 3;
    if (tid < 128) { const int hh_ = tid >> 5, j = tid & 31; const float s2 = exp2f(-2.0f * (float)(hh_ + 1)) * LOG2E; cst[tid] = 2 * j + 2 - attn_kt_lo(j, thr / s2); }
    __syncthreads();
    if (tid < 128) { const int c = cst[tid]; int rk = 0;
        for (int v = 0; v < 128; ++v) { const int cv = cst[v]; rk += (cv > c || (cv == c && v < tid)) ? 1 : 0; }
        if (rk == bin) sel[0] = tid; if (rk == 63 - bin) sel[1] = tid; if (rk == 64 + bin) sel[2] = tid; if (rk == 127 - bin) sel[3] = tid; }
    __syncthreads();
    int us[4];
#pragma unroll
    for (int i = 0; i < 4; ++i) us[i] = sel[i];
    __syncthreads();
    ASTAMP(0);
    if (blockIdx.x < 256) {
#pragma unroll 1
        for (int i = 0; i < 4; ++i) { ASTAMP(1 + i); const int u = __builtin_amdgcn_readfirstlane(us[i]); const int h = u >> 5, j = u & 31;
            const float slope2 = exp2f(-2.0f * (float)(h + 1)) * LOG2E;
            attn_unit2(lds, P, YDA, b, h, j, attn_kt_lo(j, thr / slope2), lam, mref, slope2, gout); }
    }
}
constexpr int ML_L = 256, ML_NC = SEQ / ML_L, ML_UNITS = NBATCH * 4 * ML_NC;
constexpr size_t MO_U = 0;
constexpr size_t MO_NL = MO_U + (size_t)ML_UNITS * 16384 * 4;
constexpr size_t MO_GU = MO_NL + (size_t)ML_UNITS * 128 * 4;
constexpr size_t MO_C = MO_GU + (size_t)ML_UNITS * 2 * 4;
constexpr size_t MO_N = MO_C + (size_t)ML_UNITS * 16384 * 2;
constexpr size_t MO_M = MO_N + (size_t)ML_UNITS * 128 * 4;
constexpr size_t MO_END = MO_M + (size_t)ML_UNITS * 4;
static_assert(MO_END <= (size_t)T * D * 4, "mLSTM scratch must fit the output buffer");

__device__ __forceinline__ u32x4 ml_conv8(const bf16_t* P, size_t t, int pos, int ch, const float* cw, const float* cb, float scale) {
    u32x4 u[4];
#pragma unroll
    for (int j = 0; j < 4; ++j) { const size_t tt = (pos - 3 + j >= 0) ? (t - 3 + j) : t; u[j] = *(const u32x4*)(P + tt * PW + PC_MQ + ch); }
    float acc[8];
    { const f32x4 b0 = *(const f32x4*)(cb + ch), b1 = *(const f32x4*)(cb + ch + 4);
      acc[0] = b0.x; acc[1] = b0.y; acc[2] = b0.z; acc[3] = b0.w; acc[4] = b1.x; acc[5] = b1.y; acc[6] = b1.z; acc[7] = b1.w; }
#pragma unroll
    for (int j = 0; j < 4; ++j) {
        const float ok = (pos - 3 + j >= 0) ? 1.0f : 0.0f;
        const f32x4 w0 = *(const f32x4*)(cw + j * 1024 + ch) * ok, w1 = *(const f32x4*)(cw + j * 1024 + ch + 4) * ok;
        acc[0] += bf_lo(u[j].x) * w0.x; acc[1] += bf_hi(u[j].x) * w0.y; acc[2] += bf_lo(u[j].y) * w0.z; acc[3] += bf_hi(u[j].y) * w0.w;
        acc[4] += bf_lo(u[j].z) * w1.x; acc[5] += bf_hi(u[j].z) * w1.y; acc[6] += bf_lo(u[j].w) * w1.z; acc[7] += bf_hi(u[j].w) * w1.w;
    }
#pragma unroll
    for (int e = 0; e < 8; ++e) acc[e] = acc[e] * fast_sigmoid(acc[e]) * scale;
    u32x4 o; o.x = cvt_pk_bf16(acc[0], acc[1]); o.y = cvt_pk_bf16(acc[2], acc[3]); o.z = cvt_pk_bf16(acc[4], acc[5]); o.w = cvt_pk_bf16(acc[6], acc[7]);
    return o;
}

__device__ __forceinline__ void ml_gate_scan(const float* IFP, int t0, int h, int lane, LAS float* ga, LAS float* gz, LAS float* gp) {
    float f[4], iv[4];
#pragma unroll
    for (int j = 0; j < 4; ++j) { const float* r = IFP + (size_t)(t0 + 4 * lane + j) * 8; iv[j] = r[h]; f[j] = r[4 + h]; }
    float c[4]; c[0] = f[0]; c[1] = c[0] + f[1]; c[2] = c[1] + f[2]; c[3] = c[2] + f[3];
    float incl = c[3];
#pragma unroll
    for (int o = 1; o < 64; o <<= 1) { const float v = __shfl_up(incl, o); if (lane >= o) incl += v; }
    const float excl = incl - c[3];
    float a[4], z[4], p[4];
#pragma unroll
    for (int j = 0; j < 4; ++j) { a[j] = excl + c[j]; z[j] = iv[j] - a[j]; }
    p[0] = z[0]; p[1] = fmaxf(p[0], z[1]); p[2] = fmaxf(p[1], z[2]); p[3] = fmaxf(p[2], z[3]);
    float pin = p[3];
#pragma unroll
    for (int o = 1; o < 64; o <<= 1) { const float v = __shfl_up(pin, o); if (lane >= o) pin = fmaxf(pin, v); }
    float pex = __shfl_up(pin, 1); if (lane == 0) pex = -INFINITY;
    *(LAS f32x4*)(ga + 4 * lane) = (f32x4){a[0], a[1], a[2], a[3]};
    *(LAS f32x4*)(gz + 4 * lane) = (f32x4){z[0], z[1], z[2], z[3]};
    *(LAS f32x4*)(gp + 4 * lane) = (f32x4){fmaxf(pex, p[0]), fmaxf(pex, p[1]), fmaxf(pex, p[2]), fmaxf(pex, p[3])};
}

constexpr int MLK_STR = 256 * 16 + 16;
constexpr int MLL_K = 0;
constexpr int MLL_V = 16 * MLK_STR;
constexpr int MLL_G = MLL_V + 65536;
constexpr int MLL_END = MLL_G + 3 * 1024;
static_assert(MLL_END <= LDS_MISC_OFF, "mLSTM LDS");

#ifndef MSTAMP
#define MSTAMP(k) do { } while (0)
#endif
__device__ __forceinline__ void ml_state_unit(LAS unsigned char* lds, unsigned char* ws, unsigned char* mo, const float* cw, const float* cb, int unit) {
    const int tid = tid_opaque(), lane = tid & 63, r32 = lane & 31, hh = lane >> 5, wid = __builtin_amdgcn_readfirstlane(tid >> 6);
    const int bh = unit >> 4, c = unit & 15, b = bh >> 2, h = bh & 3, t0 = b * SEQ + c * ML_L;
    const float* IFP = (const float*)(ws + WS_IFP); const bf16_t* P = (const bf16_t*)(ws + WS_P); bf16_t* MLQK = (bf16_t*)(ws + WS_MLQK);
    LAS float* ga = (LAS float*)(lds + MLL_G); LAS float* gz = ga + 256; LAS float* gp = gz + 256;
    MSTAMP(0);
    if (wid == 0) ml_gate_scan(IFP, t0, h, lane, ga, gz, gp);
    __syncthreads();
    MSTAMP(1);
    const float g = ga[255], pmL = gp[255];
    if (tid == 0) { float* gu = (float*)(mo + MO_GU) + unit * 2; gu[0] = g; gu[1] = g + pmL; }
    const int sch = tid & 15;
    {
        const int chq = h * 128 + sch * 8, chk = 512 + chq;
        f32x4 wq[4][2], wk[4][2], bq[2], bk[2];
#pragma unroll
        for (int j = 0; j < 4; ++j) { wq[j][0] = *(const f32x4*)(cw + j * 1024 + chq); wq[j][1] = *(const f32x4*)(cw + j * 1024 + chq + 4); wk[j][0] = *(const f32x4*)(cw + j * 1024 + chk); wk[j][1] = *(const f32x4*)(cw + j * 1024 + chk + 4); }
        bq[0] = *(const f32x4*)(cb + chq); bq[1] = *(const f32x4*)(cb + chq + 4); bk[0] = *(const f32x4*)(cb + chk); bk[1] = *(const f32x4*)(cb + chk + 4);
#pragma unroll 1
        for (int ib = 0; ib < 8; ib += 2) {
            u32x4 uq[2][4], uk[2][4], uv[2];
#pragma unroll
            for (int ii = 0; ii < 2; ++ii) { const int r = (tid >> 4) + 32 * (ib + ii); const int pos = c * ML_L + r; const size_t t = (size_t)(t0 + r);
#pragma unroll
                for (int j = 0; j < 4; ++j) { const size_t tt = (pos - 3 + j >= 0) ? (t - 3 + j) : t; uq[ii][j] = *(const u32x4*)(P + tt * PW + PC_MQ + chq); uk[ii][j] = *(const u32x4*)(P + tt * PW + PC_MQ + chk); }
                uv[ii] = *(const u32x4*)(P + t * PW + PC_MV + h * 128 + sch * 8); }
#pragma unroll
            for (int ii = 0; ii < 2; ++ii) { const int r = (tid >> 4) + 32 * (ib + ii); const int pos = c * ML_L + r; const size_t t = (size_t)(t0 + r);
                float aq[8] = {bq[0].x, bq[0].y, bq[0].z, bq[0].w, bq[1].x, bq[1].y, bq[1].z, bq[1].w};
                float ak[8] = {bk[0].x, bk[0].y, bk[0].z, bk[0].w, bk[1].x, bk[1].y, bk[1].z, bk[1].w};
#pragma unroll
                for (int j = 0; j < 4; ++j) { const float ok = (pos - 3 + j >= 0) ? 1.0f : 0.0f;
                    const f32x4 a0 = wq[j][0] * ok, a1 = wq[j][1] * ok, k0 = wk[j][0] * ok, k1 = wk[j][1] * ok; const u32x4 x = uq[ii][j], y = uk[ii][j];
                    aq[0] += bf_lo(x.x) * a0.x; aq[1] += bf_hi(x.x) * a0.y; aq[2] += bf_lo(x.y) * a0.z; aq[3] += bf_hi(x.y) * a0.w; aq[4] += bf_lo(x.z) * a1.x; aq[5] += bf_hi(x.z) * a1.y; aq[6] += bf_lo(x.w) * a1.z; aq[7] += bf_hi(x.w) * a1.w;
                    ak[0] += bf_lo(y.x) * k0.x; ak[1] += bf_hi(y.x) * k0.y; ak[2] += bf_lo(y.y) * k0.z; ak[3] += bf_hi(y.y) * k0.w; ak[4] += bf_lo(y.z) * k1.x; ak[5] += bf_hi(y.z) * k1.y; ak[6] += bf_lo(y.w) * k1.z; ak[7] += bf_hi(y.w) * k1.w; }
                const float w = __builtin_amdgcn_exp2f((gz[r] - pmL) * LOG2E);
                u32x4 q, k, ks;
#pragma unroll
                for (int e = 0; e < 8; ++e) { aq[e] = aq[e] * fast_sigmoid(aq[e]) * 0.08838834764831845f; ak[e] = ak[e] * fast_sigmoid(ak[e]); }
                q.x = cvt_pk_bf16(aq[0], aq[1]); q.y = cvt_pk_bf16(aq[2], aq[3]); q.z = cvt_pk_bf16(aq[4], aq[5]); q.w = cvt_pk_bf16(aq[6], aq[7]);
                k.x = cvt_pk_bf16(ak[0], ak[1]); k.y = cvt_pk_bf16(ak[2], ak[3]); k.z = cvt_pk_bf16(ak[4], ak[5]); k.w = cvt_pk_bf16(ak[6], ak[7]);
                *(u32x4*)(MLQK + t * 1024 + chq) = q; *(u32x4*)(MLQK + t * 1024 + chk) = k;
                ks.x = cvt_pk_bf16(bf_lo(k.x) * w, bf_hi(k.x) * w); ks.y = cvt_pk_bf16(bf_lo(k.y) * w, bf_hi(k.y) * w); ks.z = cvt_pk_bf16(bf_lo(k.z) * w, bf_hi(k.z) * w); ks.w = cvt_pk_bf16(bf_lo(k.w) * w, bf_hi(k.w) * w);
                *(LAS u32x4*)(lds + MLL_K + v_off(r, sch)) = ks; *(LAS u32x4*)(lds + MLL_V + v_off(r, sch)) = uv[ii]; }
        }
    }
    __syncthreads();
    MSTAMP(2);
    const int et = wid & 3, dt0 = 2 * (wid >> 2);
    f32x16 acc0 = f32x16{}, acc1 = f32x16{}, accn0 = f32x16{}, accn1 = f32x16{};
    const int tg = lane >> 4, tq = (lane >> 2) & 3, tp = lane & 3;
    const int vlo = 64 * (4 * hh + tq) + 16 * ((2 * (tg & 1) + (tp >> 1)) ^ hh) + 8 * (tp & 1);
    const int vhi = 64 * (4 * hh + tq) + 16 * ((2 * (tg & 1) + (tp >> 1)) ^ (hh + 2)) + 8 * (tp & 1);
    const bf16x8 ones = (bf16x8){0x3F80, 0x3F80, 0x3F80, 0x3F80, 0x3F80, 0x3F80, 0x3F80, 0x3F80};
#pragma unroll 4
    for (int ks = 0; ks < 16; ++ks) {
        const int sub = 2048 * (2 * ks);
        const s16x4 vl = __builtin_bit_cast(s16x4, __builtin_amdgcn_ds_read_tr16_b64_v4i16((LAS v4i16_t*)(lds + MLL_V + vlo + sub + 512 * et)));
        const s16x4 vh = __builtin_bit_cast(s16x4, __builtin_amdgcn_ds_read_tr16_b64_v4i16((LAS v4i16_t*)(lds + MLL_V + vhi + sub + 2048 + 512 * et)));
        const bf16x8 vf = (bf16x8){vl[0], vl[1], vl[2], vl[3], vh[0], vh[1], vh[2], vh[3]};
        const s16x4 al = __builtin_bit_cast(s16x4, __builtin_amdgcn_ds_read_tr16_b64_v4i16((LAS v4i16_t*)(lds + MLL_K + vlo + sub + 512 * dt0)));
        const s16x4 ah = __builtin_bit_cast(s16x4, __builtin_amdgcn_ds_read_tr16_b64_v4i16((LAS v4i16_t*)(lds + MLL_K + vhi + sub + 2048 + 512 * dt0)));
        const bf16x8 af = (bf16x8){al[0], al[1], al[2], al[3], ah[0], ah[1], ah[2], ah[3]};
        const s16x4 bl = __builtin_bit_cast(s16x4, __builtin_amdgcn_ds_read_tr16_b64_v4i16((LAS v4i16_t*)(lds + MLL_K + vlo + sub + 512 * (dt0 + 1))));
        const s16x4 bhv = __builtin_bit_cast(s16x4, __builtin_amdgcn_ds_read_tr16_b64_v4i16((LAS v4i16_t*)(lds + MLL_K + vhi + sub + 2048 + 512 * (dt0 + 1))));
        const bf16x8 bf = (bf16x8){bl[0], bl[1], bl[2], bl[3], bhv[0], bhv[1], bhv[2], bhv[3]};
        acc0 = __builtin_amdgcn_mfma_f32_32x32x16_bf16(af, vf, acc0, 0, 0, 0);
        acc1 = __builtin_amdgcn_mfma_f32_32x32x16_bf16(bf, vf, acc1, 0, 0, 0);
        if (et == 0) { accn0 = __builtin_amdgcn_mfma_f32_32x32x16_bf16(af, ones, accn0, 0, 0, 0); accn1 = __builtin_amdgcn_mfma_f32_32x32x16_bf16(bf, ones, accn1, 0, 0, 0); }
    }
    float* U = (float*)(mo + MO_U) + (size_t)unit * 16384 + (size_t)(32 * et + r32) * 128;
#pragma unroll
    for (int g4 = 0; g4 < 4; ++g4) {
        *(f32x4*)(U + 32 * dt0 + 8 * g4 + 4 * hh) = (f32x4){acc0[4 * g4], acc0[4 * g4 + 1], acc0[4 * g4 + 2], acc0[4 * g4 + 3]};
        *(f32x4*)(U + 32 * (dt0 + 1) + 8 * g4 + 4 * hh) = (f32x4){acc1[4 * g4], acc1[4 * g4 + 1], acc1[4 * g4 + 2], acc1[4 * g4 + 3]};
    }
    if (et == 0 && r32 == 0) {
        float* NL = (float*)(mo + MO_NL) + (size_t)unit * 128;
#pragma unroll
        for (int g4 = 0; g4 < 4; ++g4) {
            *(f32x4*)(NL + 32 * dt0 + 8 * g4 + 4 * hh) = (f32x4){accn0[4 * g4], accn0[4 * g4 + 1], accn0[4 * g4 + 2], accn0[4 * g4 + 3]};
            *(f32x4*)(NL + 32 * (dt0 + 1) + 8 * g4 + 4 * hh) = (f32x4){accn1[4 * g4], accn1[4 * g4 + 1], accn1[4 * g4 + 2], accn1[4 * g4 + 3]};
        }
    }
    __syncthreads();
    MSTAMP(3);
}

__device__ __forceinline__ void ml_scan_phase(unsigned char* mo, int G) {
    const int tid = tid_opaque();
    const float* GU = (const float*)(mo + MO_GU);
    for (int i = blockIdx.x * NTHREADS + tid; i < 32 * 4096; i += G * NTHREADS) {
        const int bh = i >> 12, e4 = i & 4095;
        const float* U = (const float*)(mo + MO_U) + (size_t)bh * 16 * 16384 + e4 * 4;
        bf16_t* C = (bf16_t*)(mo + MO_C) + (size_t)bh * 16 * 16384 + e4 * 4;
        f32x4 st = (f32x4){0.f, 0.f, 0.f, 0.f}; float m = 0.f;
#pragma unroll 5
        for (int c = 0; c < 15; ++c) {
            const float g = GU[(bh * 16 + c) * 2], u = GU[(bh * 16 + c) * 2 + 1];
            const float mn = fmaxf(g + m, u), dec = __expf(g + m - mn), sc = __expf(u - mn);
            const f32x4 uv = *(const f32x4*)(U + (size_t)c * 16384);
            st = st * dec + uv * sc; m = mn;
            u32x2 o; o.x = cvt_pk_bf16(st.x, st.y); o.y = cvt_pk_bf16(st.z, st.w);
            *(u32x2*)(C + (size_t)(c + 1) * 16384) = o;
        }
    }
    for (int i = blockIdx.x * NTHREADS + tid; i < 32 * 32; i += G * NTHREADS) {
        const int bh = i >> 5, d4 = i & 31;
        const float* NL = (const float*)(mo + MO_NL) + (size_t)bh * 16 * 128 + d4 * 4;
        float* N = (float*)(mo + MO_N) + (size_t)bh * 16 * 128 + d4 * 4; float* M = (float*)(mo + MO_M) + bh * 16;
        f32x4 st = (f32x4){0.f, 0.f, 0.f, 0.f}; float m = 0.f;
        if (d4 == 0) M[0] = 0.f;
        for (int c = 0; c < 15; ++c) {
            const float g = GU[(bh * 16 + c) * 2], u = GU[(bh * 16 + c) * 2 + 1];
            const float mn = fmaxf(g + m, u), dec = __expf(g + m - mn), sc = __expf(u - mn);
            const f32x4 uv = *(const f32x4*)(NL + (size_t)c * 128);
            st = st * dec + uv * sc; m = mn;
            *(f32x4*)(N + (size_t)(c + 1) * 128) = st;
            if (d4 == 0) M[c + 1] = m;
        }
    }
}

__device__ __forceinline__ void ml_out_unit(LAS unsigned char* lds, unsigned char* ws, const unsigned char* mo, const float* gnorm, int unit) {
    const int tid = tid_opaque(), lane = tid & 63, r32 = lane & 31, hh = lane >> 5, wid = __builtin_amdgcn_readfirstlane(tid >> 6);
    const int bh = unit >> 4, c = unit & 15, b = bh >> 2, h = bh & 3, t0 = b * SEQ + c * ML_L;
    const float* IFP = (const float*)(ws + WS_IFP); const bf16_t* P = (const bf16_t*)(ws + WS_P); const bf16_t* MLQK = (const bf16_t*)(ws + WS_MLQK);
    bf16_t* YML = (bf16_t*)(ws + WS_YML);
    LAS float* ga = (LAS float*)(lds + MLL_G); LAS float* gz = ga + 256; LAS float* gp = gz + 256;
    if (wid == 0) ml_gate_scan(IFP, t0, h, lane, ga, gz, gp);
    const int sch = tid & 15;
    {
        u32x4 kreg[8], vreg[8];
#pragma unroll
        for (int i = 0; i < 8; ++i) { const size_t t = (size_t)(t0 + (tid >> 4) + 32 * i);
            kreg[i] = *(const u32x4*)(MLQK + t * 1024 + 512 + h * 128 + sch * 8); vreg[i] = *(const u32x4*)(P + t * PW + PC_MV + h * 128 + sch * 8); }
#pragma unroll
        for (int i = 0; i < 8; ++i) { const int r = (tid >> 4) + 32 * i;
            *(LAS u32x4*)(lds + MLL_K + sch * MLK_STR + r * 16) = kreg[i]; *(LAS u32x4*)(lds + MLL_V + v_off(r, sch)) = vreg[i]; }
    }
    const float m_prev = (c > 0) ? ((const float*)(mo + MO_M))[unit] : 0.f;
    const int lq = 32 * wid + r32;
    bf16x8 qf[8];
    { const bf16_t* qp = MLQK + (size_t)(t0 + lq) * 1024 + h * 128 + hh * 8;
#pragma unroll
      for (int dd = 0; dd < 8; ++dd) qf[dd] = *(const bf16x8*)(qp + dd * 16); }
    f32x16 o[4]; f32x16 o4 = f32x16{};
#pragma unroll
    for (int et = 0; et < 4; ++et) o[et] = f32x16{};
    if (c > 0) {
        const bf16_t* Cg = (const bf16_t*)(mo + MO_C) + (size_t)unit * 16384 + (size_t)r32 * 128 + hh * 8; const float* Ng = (const float*)(mo + MO_N) + (size_t)unit * 128 + hh * 8;
        bf16x8 cfa[8], cfb[8]; f32x4 nn[8][2];
#pragma unroll
        for (int dd = 0; dd < 8; ++dd) cfa[dd] = *(const bf16x8*)(Cg + dd * 16);
#pragma unroll
        for (int dd = 0; dd < 8; ++dd) cfb[dd] = *(const bf16x8*)(Cg + (size_t)1 * 32 * 128 + dd * 16);
#pragma unroll
        for (int dd = 0; dd < 8; ++dd) o[0] = __builtin_amdgcn_mfma_f32_32x32x16_bf16(cfa[dd], qf[dd], o[0], 0, 0, 0);
#pragma unroll
        for (int dd = 0; dd < 8; ++dd) cfa[dd] = *(const bf16x8*)(Cg + (size_t)2 * 32 * 128 + dd * 16);
#pragma unroll
        for (int dd = 0; dd < 8; ++dd) o[1] = __builtin_amdgcn_mfma_f32_32x32x16_bf16(cfb[dd], qf[dd], o[1], 0, 0, 0);
#pragma unroll
        for (int dd = 0; dd < 8; ++dd) cfb[dd] = *(const bf16x8*)(Cg + (size_t)3 * 32 * 128 + dd * 16);
#pragma unroll
        for (int dd = 0; dd < 8; ++dd) { nn[dd][0] = (f32x4){0.f, 0.f, 0.f, 0.f}; nn[dd][1] = nn[dd][0]; }
        if (r32 == 0) {
#pragma unroll
            for (int dd = 0; dd < 8; ++dd) { nn[dd][0] = *(const f32x4*)(Ng + dd * 16); nn[dd][1] = *(const f32x4*)(Ng + dd * 16 + 4); } }
#pragma unroll
        for (int dd = 0; dd < 8; ++dd) o[2] = __builtin_amdgcn_mfma_f32_32x32x16_bf16(cfa[dd], qf[dd], o[2], 0, 0, 0);
#pragma unroll
        for (int dd = 0; dd < 8; ++dd) o[3] = __builtin_amdgcn_mfma_f32_32x32x16_bf16(cfb[dd], qf[dd], o[3], 0, 0, 0);
#pragma unroll
        for (int dd = 0; dd < 8; ++dd) { u32x4 nv; nv.x = cvt_pk_bf16(nn[dd][0].x, nn[dd][0].y); nv.y = cvt_pk_bf16(nn[dd][0].z, nn[dd][0].w); nv.z = cvt_pk_bf16(nn[dd][1].x, nn[dd][1].y); nv.w = cvt_pk_bf16(nn[dd][1].z, nn[dd][1].w);
            o4 = __builtin_amdgcn_mfma_f32_32x32x16_bf16(__builtin_bit_cast(bf16x8, nv), qf[dd], o4, 0, 0, 0); }
    }
    __syncthreads();
    const float a_l = ga[lq], M_l = fmaxf(gp[lq], m_prev);
    const float w_inter = __expf(m_prev - M_l);
    const float dinter = __shfl(o4[0], r32);
#pragma unroll
    for (int et = 0; et < 4; ++et)
#pragma unroll
        for (int r = 0; r < 16; ++r) o[et][r] *= w_inter;
    const int tg = lane >> 4, tq = (lane >> 2) & 3, tp = lane & 3;
    const int vlo = 64 * (4 * hh + tq) + 16 * ((2 * (tg & 1) + (tp >> 1)) ^ hh) + 8 * (tp & 1);
    const int vhi = 64 * (4 * hh + tq) + 16 * ((2 * (tg & 1) + (tp >> 1)) ^ (hh + 2)) + 8 * (tp & 1);
    const int klane = hh * MLK_STR + r32 * 16;
    float dintra = 0.f;
    for (int kb32 = 0; kb32 <= wid; ++kb32) {
        const int kb = 32 * kb32;
        f32x16 sc = f32x16{};
#pragma unroll
        for (int dd = 0; dd < 8; ++dd) { const bf16x8 ka = *(const LAS bf16x8*)(lds + MLL_K + klane + (dd * 2) * MLK_STR + kb32 * 512); sc = __builtin_amdgcn_mfma_f32_32x32x16_bf16(ka, qf[dd], sc, 0, 0, 0); }
#pragma unroll
        for (int g4 = 0; g4 < 4; ++g4) { const f32x4 zv = *(const LAS f32x4*)(gz + kb + 8 * g4 + 4 * hh);
#pragma unroll
            for (int e = 0; e < 4; ++e) { const int s = kb + 8 * g4 + 4 * hh + e; const float wgt = (s <= lq) ? __builtin_amdgcn_exp2f((zv[e] - M_l) * LOG2E) : 0.f; sc[4 * g4 + e] *= wgt; dintra += sc[4 * g4 + e]; } }
        bf16x8 pf[2];
#pragma unroll
        for (int s = 0; s < 2; ++s) { u32x4 w;
            w.x = cvt_pk_bf16(sc[8 * s + 0], sc[8 * s + 1]); w.y = cvt_pk_bf16(sc[8 * s + 2], sc[8 * s + 3]); w.z = cvt_pk_bf16(sc[8 * s + 4], sc[8 * s + 5]); w.w = cvt_pk_bf16(sc[8 * s + 6], sc[8 * s + 7]);
            pf[s] = __builtin_bit_cast(bf16x8, w); }
#pragma unroll
        for (int s = 0; s < 2; ++s)
#pragma unroll
            for (int et = 0; et < 4; ++et) {
                const s16x4 lo = __builtin_bit_cast(s16x4, __builtin_amdgcn_ds_read_tr16_b64_v4i16((LAS v4i16_t*)(lds + MLL_V + vlo + 2048 * (4 * kb32 + 2 * s) + 512 * et)));
                const s16x4 hi = __builtin_bit_cast(s16x4, __builtin_amdgcn_ds_read_tr16_b64_v4i16((LAS v4i16_t*)(lds + MLL_V + vhi + 2048 * (4 * kb32 + 2 * s + 1) + 512 * et)));
                const bf16x8 vf = (bf16x8){lo[0], lo[1], lo[2], lo[3], hi[0], hi[1], hi[2], hi[3]};
                o[et] = __builtin_amdgcn_mfma_f32_32x32x16_bf16(vf, pf[s], o[et], 0, 0, 0);
            }
    }
    dintra += __shfl_xor(dintra, 32);
    const float den = dintra + w_inter * dinter;
    const float hsc = 1.0f / fmaxf(fabsf(den), __expf(-(a_l + M_l)));
    float ss = 0.f;
#pragma unroll
    for (int et = 0; et < 4; ++et)
#pragma unroll
        for (int r = 0; r < 16; ++r) { o[et][r] *= hsc; ss += o[et][r] * o[et][r]; }
    ss += __shfl_xor(ss, 32);
    const float rstd = 1.0f / sqrtf(ss * (1.f / 128.f) + NORM_EPS);
    const size_t tok = (size_t)(t0 + lq);
    u32x2 og[4][4]; f32x4 gv[4][4];
#pragma unroll
    for (int et = 0; et < 4; ++et)
#pragma unroll
        for (int g4 = 0; g4 < 4; ++g4) { const int e0 = 32 * et + 8 * g4 + 4 * hh; og[et][g4] = *(const u32x2*)(P + tok * PW + PC_MO + h * 128 + e0); gv[et][g4] = *(const f32x4*)(gnorm + h * 128 + e0); }
#pragma unroll
    for (int et = 0; et < 4; ++et)
#pragma unroll
        for (int g4 = 0; g4 < 4; ++g4) {
            const int e0 = 32 * et + 8 * g4 + 4 * hh; const u32x2 g = og[et][g4]; const f32x4 gg = gv[et][g4];
            u32x2 w; w.x = cvt_pk_bf16(o[et][4 * g4 + 0] * rstd * gg.x * bf_lo(g.x), o[et][4 * g4 + 1] * rstd * gg.y * bf_hi(g.x));
            w.y = cvt_pk_bf16(o[et][4 * g4 + 2] * rstd * gg.z * bf_lo(g.y), o[et][4 * g4 + 3] * rstd * gg.w * bf_hi(g.y));
            *(u32x2*)(YML + tok * 512 + h * 128 + e0) = w;
        }
    __syncthreads();
}
struct SchedStatic {
    const char* A; const char* B; int nM, nN, G, c; size_t abytes, bbytes;
    __device__ __forceinline__ bool next(int i, pg8::Unit& u) const {
        int pm, pn; if (!pg8::static_tile(nM, nN, G, c, i, pm, pn)) return false;
        u.pm = pm; u.pn = pn; u.aux = 0; u.A = A + (size_t)pm * abytes; u.B = B + (size_t)pn * bbytes; return true; }
    __device__ __forceinline__ int arow(const pg8::Unit&, int r) const { return r; }
};
template <bool TWO> struct SchedPair {
    const char* A0; const char* A1; const char* B0; const char* B1; int nM, nN, G, c; size_t abytes, bbytes;
    __device__ __forceinline__ bool next(int i, pg8::Unit& u) const {
        const int p = TWO ? (i >> 1) : i, which = TWO ? (i & 1) : 0;
        int pm, pn; if (!pg8::static_tile(nM, nN, G, c, p, pm, pn)) return false;
        u.pm = pm; u.pn = pn; u.aux = which; u.A = (which ? A1 : A0) + (size_t)pm * abytes; u.B = (which ? B1 : B0) + (size_t)pn * bbytes; return true; }
    __device__ __forceinline__ int arow(const pg8::Unit&, int r) const { return r; }
};

struct EpiProj {
    static constexpr bool PERM = true;
    static constexpr int BHALF = 32;
    __host__ __device__ static __forceinline__ int brow(int R) { return 64 * ((R >> 5) & 3) + pg8::perm32(R & 31); }
    bf16_t* P; const float* bgate; const float* gq; const float* gk;
    __device__ __forceinline__ bool operator()(f32x4 (&acc)[2][2][4][2], const pg8::Unit& u, int wr, int wc, int fr, int fq) const {
        const int row0 = u.pm * 256 + wr * 64 + fr, col0 = u.pn * 256 + wc * 64 + 8 * fq;
        const int mode = u.pn < 4 ? 3 : (u.pn < 12 ? 0 : (u.pn < 14 ? 1 : 2));
        f32x4 bv[2][2];
#pragma unroll
        for (int bj = 0; bj < 2; ++bj)
#pragma unroll
            for (int n = 0; n < 2; ++n) {
                if (mode == 2) bv[bj][n] = *(const f32x4*)(bgate + (col0 - PC_G) + bj * 32 + 4 * n);
                else if (mode == 3) { bv[bj][n] = *(const f32x4*)((u.pn < 2 ? gq : gk) + 8 * fq + bj * 32 + 4 * n); if (u.pn < 2) bv[bj][n] = bv[bj][n] * (0.125f * LOG2E); }
                else bv[bj][n] = (f32x4){0.f, 0.f, 0.f, 0.f}; }
#pragma unroll
        for (int ai = 0; ai < 2; ++ai)
#pragma unroll
            for (int m = 0; m < 4; ++m) { bf16_t* rowp = P + (size_t)(row0 + ai * 128 + m * 16) * PW + col0;
                float rstd = 1.f;
                if (mode == 3) { float ss = 0.f;
#pragma unroll
                    for (int bj = 0; bj < 2; ++bj)
#pragma unroll
                        for (int n = 0; n < 2; ++n) { const f32x4 v = acc[ai][bj][m][n]; ss += (v[0] * v[0] + v[1] * v[1]) + (v[2] * v[2] + v[3] * v[3]); }
                    ss += __shfl_xor(ss, 16); ss += __shfl_xor(ss, 32);
                    rstd = 1.0f / sqrtf(ss * (1.f / 64.f) + NORM_EPS); }
#pragma unroll
                for (int bj = 0; bj < 2; ++bj) { f32x4 v0, v1;
                    if (mode == 3) { v0 = acc[ai][bj][m][0] * rstd * bv[bj][0]; v1 = acc[ai][bj][m][1] * rstd * bv[bj][1]; }
                    else { v0 = acc[ai][bj][m][0] + bv[bj][0]; v1 = acc[ai][bj][m][1] + bv[bj][1]; }
                    if (mode == 1 || mode == 2) {
#pragma unroll
                        for (int j = 0; j < 4; ++j) { v0[j] = fast_sigmoid(v0[j]); v1[j] = fast_sigmoid(v1[j]); } }
                    u32x4 w; w.x = cvt_pk_bf16(v0[0], v0[1]); w.y = cvt_pk_bf16(v0[2], v0[3]); w.z = cvt_pk_bf16(v1[0], v1[1]); w.w = cvt_pk_bf16(v1[2], v1[3]);
                    *(u32x4*)(rowp + bj * 32) = w; } }
        return false;
    }
};

template <bool TWO> struct EpiMixed {
    static constexpr bool PERM = true;
    static constexpr int BHALF = 128;
    __host__ __device__ static __forceinline__ int brow(int R) { return pg8::perm_rows(R); }
    const bf16_t* P; bf16_t* MIX;
    __device__ __forceinline__ bool operator()(f32x4 (&acc)[2][2][4][2], const pg8::Unit& u, int wr, int wc, int fr, int fq) const {
        const int row0 = u.pm * 256 + wr * 64 + fr, col0 = u.pn * 256 + wc * 32 + 8 * fq;
        const bool first = TWO && (u.aux == 0);
#pragma unroll
        for (int ai = 0; ai < 2; ++ai) {
            u32x4 ga[4][2], gb[4][2];
#pragma unroll
            for (int m = 0; m < 4; ++m) { const bf16_t* gp = P + (size_t)(row0 + ai * 128 + m * 16) * PW + PC_G + col0;
#pragma unroll
                for (int bj = 0; bj < 2; ++bj) { if (!TWO || first) ga[m][bj] = *(const u32x4*)(gp + bj * 128); if (TWO) gb[m][bj] = *(const u32x4*)(gp + 1024 + bj * 128); } }
#pragma unroll
            for (int m = 0; m < 4; ++m) { const int row = row0 + ai * 128 + m * 16;
#pragma unroll
                for (int bj = 0; bj < 2; ++bj) {
                    if (first) {
                        const u32x4 a = ga[m][bj], b = gb[m][bj];
                        const float g1[8] = {bf_lo(a.x), bf_hi(a.x), bf_lo(a.y), bf_hi(a.y), bf_lo(a.z), bf_hi(a.z), bf_lo(a.w), bf_hi(a.w)};
                        const float g2[8] = {bf_lo(b.x), bf_hi(b.x), bf_lo(b.y), bf_hi(b.y), bf_lo(b.z), bf_hi(b.z), bf_lo(b.w), bf_hi(b.w)};
#pragma unroll
                        for (int j = 0; j < 4; ++j) { acc[ai][bj][m][0][j] *= g1[j] * __builtin_amdgcn_rcpf(fmaxf(g2[j], 1e-30f)); acc[ai][bj][m][1][j] *= g1[4 + j] * __builtin_amdgcn_rcpf(fmaxf(g2[4 + j], 1e-30f)); }
                    } else {
                        const u32x4 b = TWO ? gb[m][bj] : ga[m][bj];
                        const float g[8] = {bf_lo(b.x), bf_hi(b.x), bf_lo(b.y), bf_hi(b.y), bf_lo(b.z), bf_hi(b.z), bf_lo(b.w), bf_hi(b.w)};
                        f32x4 v0 = acc[ai][bj][m][0], v1 = acc[ai][bj][m][1];
#pragma unroll
                        for (int j = 0; j < 4; ++j) { v0[j] *= g[j]; v1[j] *= g[4 + j]; }
                        u32x4 w; w.x = cvt_pk_bf16(v0[0], v0[1]); w.y = cvt_pk_bf16(v0[2], v0[3]); w.z = cvt_pk_bf16(v1[0], v1[1]); w.w = cvt_pk_bf16(v1[2], v1[3]);
                        *(u32x4*)(MIX + (size_t)row * 1024 + col0 + bj * 128) = w;
                    }
                } }
        }
        return first;
    }
};

struct EpiWout {
    static constexpr bool PERM = true;
    static constexpr int BHALF = 128;
    __host__ __device__ static __forceinline__ int brow(int R) { return pg8::perm_rows(R); }
    const float* x; bf16_t* x1b;
    __device__ __forceinline__ bool operator()(f32x4 (&acc)[2][2][4][2], const pg8::Unit& u, int wr, int wc, int fr, int fq) const {
        const int row0 = u.pm * 256 + wr * 64 + fr, col0 = u.pn * 256 + wc * 32 + 8 * fq;
#pragma unroll
        for (int ai = 0; ai < 2; ++ai) {
            f32x4 xv[4][2][2];
#pragma unroll
            for (int m = 0; m < 4; ++m) { const size_t ro = (size_t)(row0 + ai * 128 + m * 16) * D + col0;
#pragma unroll
                for (int bj = 0; bj < 2; ++bj)
#pragma unroll
                    for (int n = 0; n < 2; ++n) xv[m][bj][n] = *(const f32x4*)(x + ro + bj * 128 + n * 4); }
#pragma unroll
            for (int m = 0; m < 4; ++m) { const size_t ro = (size_t)(row0 + ai * 128 + m * 16) * D + col0;
#pragma unroll
                for (int bj = 0; bj < 2; ++bj) { const f32x4 v0 = xv[m][bj][0] + acc[ai][bj][m][0], v1 = xv[m][bj][1] + acc[ai][bj][m][1];
                    u32x4 w; w.x = cvt_pk_bf16(v0[0], v0[1]); w.y = cvt_pk_bf16(v0[2], v0[3]); w.z = cvt_pk_bf16(v1[0], v1[1]); w.w = cvt_pk_bf16(v1[2], v1[3]);
                    *(u32x4*)(x1b + ro + bj * 128) = w; } }
        }
        return false;
    }
};
constexpr size_t WS_TILEE = WS_WGCNT + (size_t)256 * 64 * 4;
constexpr size_t WS_NT = WS_TILEE + 384 * 4;
constexpr size_t WS_RSTD = WS_NT + 256;
constexpr size_t WS_RSLOT = WS_RSTD + (size_t)T * 4;
static_assert(WS_RSLOT + (size_t)MOE_ROWS * 4 <= WS_END, "MoE tables must fit the P region");
__device__ __forceinline__ int ld_i32(const int* p) { return (int)__hip_atomic_load((const unsigned*)p, __ATOMIC_RELAXED, __HIP_MEMORY_SCOPE_AGENT); }

constexpr int RT_WSTR = 1028;
constexpr int RT_LG = 36 * RT_WSTR * 4;
constexpr int RT_HIST = RT_LG + 8 * 8 * 36 * 4;
static_assert(RT_HIST + 256 <= LDS_MISC_OFF, "router LDS");

#ifndef RSTAMP
#define RSTAMP() do { } while (0)
#define RSTAMPW() do { } while (0)
#endif
__device__ __forceinline__ void router_phase(LAS unsigned char* lds, const float* const* in, unsigned char* ws, const bf16_t* x1, int G) {
    moe_weight_convert(lds, in, ws, G);
    __syncthreads();
    RSTAMP();
    const int tid = tid_opaque(), lane = tid & 63, wave = __builtin_amdgcn_readfirstlane(tid >> 6);
    const int gw = blockIdx.x * NWAVES + wave, NGW = G * NWAVES;
    const float* gn = in[20]; const float* w_group = in[21]; const float* b_group = in[22]; const float* w_router = in[23]; const float* b_router = in[24];
    LAS float* wr = (LAS float*)lds;
    for (int i = tid; i < 4096; i += NTHREADS) { const int d = i >> 2, j = i & 3; wr[j * RT_WSTR + d] = w_group[i] * gn[d]; }
    for (int i = tid; i < 32768; i += NTHREADS) { const int d = i >> 5, j = i & 31; wr[(4 + j) * RT_WSTR + d] = w_router[i] * gn[d]; }
    LAS float* lg = (LAS float*)(lds + RT_LG) + wave * (8 * 36);
    LAS int* hist = (LAS int*)(lds + RT_HIST);
    if (tid < 64) hist[tid] = 0;
    __syncthreads();
    int* TEID = (int*)(ws + WS_TEID); float* TGATE = (float*)(ws + WS_TGATE);
    const int li = lane & 15, lq = lane >> 4;
    for (int row0 = gw * 16; row0 < T; row0 += NGW * 16) {
        const bf16_t* xr = x1 + (size_t)(row0 + li) * D + 4 * lq;
        const LAS float* wb0 = wr + li * RT_WSTR + 4 * lq;
        const LAS float* wb1 = wr + (16 + li) * RT_WSTR + 4 * lq;
        const LAS float* wb2 = wr + (li < 4 ? 32 + li : 35) * RT_WSTR + 4 * lq;
        f32x4 acc0 = (f32x4){0.f, 0.f, 0.f, 0.f}, acc1 = acc0, acc2 = acc0; float ssq = 0.f;
#define RT_LOAD(buf, c0) do { _Pragma("unroll") for (int _u = 0; _u < 8; ++_u) buf[_u] = *(const u32x2*)(xr + 16 * ((c0) + _u)); } while (0)
#define RT_STEP(buf, c0) do { _Pragma("unroll") for (int _u = 0; _u < 8; ++_u) { const int c = (c0) + _u; const f32x4 a4 = (f32x4){bf_lo(buf[_u].x), bf_hi(buf[_u].x), bf_lo(buf[_u].y), bf_hi(buf[_u].y)}; \
            const f32x4 b0 = *(const LAS f32x4*)(wb0 + 16 * c), b1 = *(const LAS f32x4*)(wb1 + 16 * c), b2 = *(const LAS f32x4*)(wb2 + 16 * c); \
            ssq += (a4.x * a4.x + a4.y * a4.y) + (a4.z * a4.z + a4.w * a4.w); \
            _Pragma("unroll") for (int e = 0; e < 4; ++e) { \
                acc0 = __builtin_amdgcn_mfma_f32_16x16x4f32(a4[e], b0[e], acc0, 0, 0, 0); \
                acc1 = __builtin_amdgcn_mfma_f32_16x16x4f32(a4[e], b1[e], acc1, 0, 0, 0); \
                acc2 = __builtin_amdgcn_mfma_f32_16x16x4f32(a4[e], b2[e], acc2, 0, 0, 0); } } } while (0)
        u32x2 xa[8], xb[8];
        RT_LOAD(xa, 0);
#pragma unroll 1
        for (int cb = 0; cb < 64; cb += 16) {
            RT_LOAD(xb, cb + 8);
            RT_STEP(xa, cb);
            if (cb + 16 < 64) RT_LOAD(xa, cb + 16);
            RT_STEP(xb, cb + 8);
        }
#undef RT_LOAD
#undef RT_STEP
        ssq += __shfl_xor(ssq, 16); ssq += __shfl_xor(ssq, 32);
        const float rstd_i = 1.0f / sqrtf(ssq * (1.f / D) + NORM_EPS);
        if (lq == 0) ((float*)(ws + WS_RSTD))[row0 + li] = rstd_i;
        float rs[4];
#pragma unroll
        for (int r = 0; r < 4; ++r) rs[r] = __shfl(rstd_i, 4 * lq + r);
#pragma unroll
        for (int h8 = 0; h8 < 2; ++h8) {
            if ((lq >> 1) == h8) {
#pragma unroll
                for (int r = 0; r < 4; ++r) { const int rr = 4 * (lq & 1) + r;
                    lg[rr * 36 + li] = acc0[r] * rs[r]; lg[rr * 36 + 16 + li] = acc1[r] * rs[r]; if (li < 4) lg[rr * 36 + 32 + li] = acc2[r] * rs[r]; }
            }
            asm volatile("s_waitcnt lgkmcnt(0)" ::: "memory");
            if (lane < 8) {
                const LAS float* L = lg + lane * 36;
                float gl[4]; int gi = 0; float gm = -INFINITY;
#pragma unroll
                for (int i = 0; i < 4; ++i) { gl[i] = L[i] + b_group[i]; if (gl[i] > gm) { gm = gl[i]; gi = i; } }
                float gs = 0.f;
#pragma unroll
                for (int i = 0; i < 4; ++i) gs += __expf(gl[i] - gm);
                const float gtop = 1.0f / gs;
                float l1 = -INFINITY, l2 = -INFINITY; int e1 = 0, e2 = 0;
                for (int i = 0; i < 8; ++i) { const float l = L[4 + gi * 8 + i] + b_router[gi * 8 + i];
                    if (l > l1) { l2 = l1; e2 = e1; l1 = l; e1 = i; } else if (l > l2) { l2 = l; e2 = i; } }
                const float p2 = __expf(l2 - l1), w1 = 1.0f / (1.0f + p2), w2 = p2 * w1;
                const int t = row0 + 8 * h8 + lane;
                TEID[t * 2] = gi * 8 + e1; TEID[t * 2 + 1] = gi * 8 + e2; TGATE[t * 2] = gtop * w1; TGATE[t * 2 + 1] = gtop * w2;
                __hip_atomic_fetch_add(&hist[gi * 8 + e1], 1, __ATOMIC_RELAXED, __HIP_MEMORY_SCOPE_WORKGROUP); __hip_atomic_fetch_add(&hist[32 + gi * 8 + e2], 1, __ATOMIC_RELAXED, __HIP_MEMORY_SCOPE_WORKGROUP);
            }
            asm volatile("s_waitcnt lgkmcnt(0)" ::: "memory");
        }
    }
    __syncthreads();
    if (tid < 64) ((int*)(ws + WS_WGCNT))[blockIdx.x * 64 + tid] = hist[tid];
}

__device__ __forceinline__ void moe_plan_phase(LAS unsigned char* lds, unsigned char* ws, int G) {
    const int tid = tid_opaque();
    LAS int* tot = (LAS int*)lds; LAS int* pre = tot + 64; LAS int* base = pre + 64; LAS int* lcnt = base + 64; LAS int* pt = lcnt + 64; LAS int* pp = pt + 512;
    const int* WGCNT = (const int*)(ws + WS_WGCNT);
    { const int j = tid & 63, part = tid >> 6; int t = 0, p = 0;
#pragma unroll 8
      for (int w = 32 * part; w < 32 * part + 32; ++w) { const int v = ld_i32(WGCNT + w * 64 + j); t += v; p += (w < (int)blockIdx.x) ? v : 0; }
      pt[tid] = t; pp[tid] = p; }
    __syncthreads();
    if (tid < 64) { int t = 0, p = 0;
#pragma unroll
        for (int q = 0; q < 8; ++q) { t += pt[q * 64 + tid]; p += pp[q * 64 + tid]; }
        tot[tid] = t; pre[tid] = p; lcnt[tid] = 0; }
    __syncthreads();
    if (tid == 0) { int run = 0; for (int j = 0; j < 64; ++j) { base[j] = run; run += ((tot[j] + 255) >> 8) << 8; } }
    __syncthreads();
    int* RTOK = (int*)(ws + WS_RTOK); float* RGATE = (float*)(ws + WS_RGATE); float* RSLOT = (float*)(ws + WS_RSLOT);
    if (tid < 256) {
        const int k = tid & 1, ts = tid >> 1;
        const int t = (int)blockIdx.x * 128 + ts;
        const int e = ld_i32((const int*)(ws + WS_TEID) + t * 2 + k); const float g = __uint_as_float((unsigned)ld_i32((const int*)(ws + WS_TGATE) + t * 2 + k));
        const float rs = __uint_as_float((unsigned)ld_i32((const int*)(ws + WS_RSTD) + t));
        const int j = k * 32 + e; const int rk = __hip_atomic_fetch_add(&lcnt[j], 1, __ATOMIC_RELAXED, __HIP_MEMORY_SCOPE_WORKGROUP);
        const int slot = base[j] + pre[j] + rk;
        RTOK[slot] = t; RGATE[slot] = g; RSLOT[slot] = rs;
    }
    if (blockIdx.x < 64) { const int j = blockIdx.x; const int s0 = base[j] + tot[j], s1 = base[j] + (((tot[j] + 255) >> 8) << 8);
        for (int s = s0 + tid; s < s1; s += NTHREADS) { RTOK[s] = -1; RGATE[s] = 0.f; RSLOT[s] = 0.f; } }
    if (blockIdx.x == 0 && tid < 64) { int* TE = (int*)(ws + WS_TILEE); int* NT = (int*)(ws + WS_NT);
        const int n = (tot[tid] + 255) >> 8, b0 = base[tid] >> 8;
        for (int q = 0; q < n; ++q) TE[b0 + q] = tid & 31;
        if (tid == 31) NT[0] = b0 + n;
        if (tid == 63) NT[1] = b0 + n; }
    __syncthreads();
}

struct SchedUp {
    const char* HN; const char* W13; const int* RTOK; const int* TE; int ntiles, G, c;
    __device__ __forceinline__ bool next(int i, pg8::Unit& u) const {
        const int L = i * G + c; if (L >= ntiles * 4) return false;
        const int tau = L >> 2, pn = L & 3, e = ld_i32(TE + tau);
        u.pm = tau; u.pn = pn; u.aux = e; u.A = HN; u.B = W13 + (size_t)e * (1024 * 1024 * 2) + (size_t)pn * (256 * 1024 * 2); return true; }
    __device__ __forceinline__ int arow(const pg8::Unit& u, int r) const { const int t = ld_i32(RTOK + u.pm * 256 + r); return t < 0 ? 0 : t; }
};
struct EpiUp {
    static constexpr bool PERM = true;
    static constexpr int BHALF = 128;
    __host__ __device__ static __forceinline__ int brow(int R) { return pg8::perm_rows(R); }
    bf16_t* HID; const float* RSLOT;
    __device__ __forceinline__ bool operator()(f32x4 (&acc)[2][2][4][2], const pg8::Unit& u, int wr, int wc, int fr, int fq) const {
        const int row0 = u.pm * 256 + wr * 64 + fr, col0 = u.pn * 128 + wc * 32 + 8 * fq;
#pragma unroll
        for (int ai = 0; ai < 2; ++ai)
#pragma unroll
            for (int m = 0; m < 4; ++m) {
                const float rs = __uint_as_float((unsigned)ld_i32((const int*)RSLOT + row0 + ai * 128 + m * 16));
                float hv[8];
#pragma unroll
                for (int n = 0; n < 2; ++n)
#pragma unroll
                    for (int j = 0; j < 4; ++j) { const float a = acc[ai][0][m][n][j] * rs; hv[4 * n + j] = a * fast_sigmoid(a) * (acc[ai][1][m][n][j] * rs); }
                u32x4 w; w.x = cvt_pk_bf16(hv[0], hv[1]); w.y = cvt_pk_bf16(hv[2], hv[3]); w.z = cvt_pk_bf16(hv[4], hv[5]); w.w = cvt_pk_bf16(hv[6], hv[7]);
                *(u32x4*)(HID + (size_t)(row0 + ai * 128 + m * 16) * 512 + col0) = w;
            }
        return false;
    }
};
struct SchedDown {
    const char* HID; const char* W2T; const int* TE; int t0, t1, G, c;
    __device__ __forceinline__ bool next(int i, pg8::Unit& u) const {
        const int L = i * G + c; if (L >= (t1 - t0) * 4) return false;
        const int tau = t0 + (L >> 2), pn = L & 3, e = ld_i32(TE + tau);
        u.pm = tau; u.pn = pn; u.aux = e; u.A = HID + (size_t)tau * (256 * 512 * 2); u.B = W2T + (size_t)e * (1024 * 512 * 2) + (size_t)pn * (256 * 512 * 2); return true; }
    __device__ __forceinline__ int arow(const pg8::Unit&, int r) const { return r; }
};
struct EpiDownY {
    static constexpr bool PERM = true;
    static constexpr int BHALF = 128;
    __host__ __device__ static __forceinline__ int brow(int R) { return pg8::perm_rows(R); }
    const int* RTOK; const float* RGATE; bf16_t* Y1;
    __device__ __forceinline__ bool operator()(f32x4 (&acc)[2][2][4][2], const pg8::Unit& u, int wr, int wc, int fr, int fq) const {
        const int row0 = u.pm * 256 + wr * 64 + fr, col0 = u.pn * 256 + wc * 32 + 8 * fq;
#pragma unroll
        for (int ai = 0; ai < 2; ++ai)
#pragma unroll
            for (int m = 0; m < 4; ++m) { const int slot = row0 + ai * 128 + m * 16; const int tok = ld_i32(RTOK + slot);
                if (tok >= 0) { const float g = __uint_as_float((unsigned)ld_i32((const int*)RGATE + slot)); bf16_t* op = Y1 + (size_t)tok * D + col0;
#pragma unroll
                    for (int bj = 0; bj < 2; ++bj) { const f32x4 v0 = acc[ai][bj][m][0] * g, v1 = acc[ai][bj][m][1] * g;
                        u32x4 w; w.x = cvt_pk_bf16(v0[0], v0[1]); w.y = cvt_pk_bf16(v0[2], v0[3]); w.z = cvt_pk_bf16(v1[0], v1[1]); w.w = cvt_pk_bf16(v1[2], v1[3]);
                        *(u32x4*)(op + bj * 128) = w; } } }
        return false;
    }
};
struct EpiDown {
    static constexpr bool PERM = true;
    static constexpr int BHALF = 128;
    __host__ __device__ static __forceinline__ int brow(int R) { return pg8::perm_rows(R); }
    const int* RTOK; const float* RGATE; float* out; const bf16_t* Y1; const bf16_t* X1B;
    __device__ __forceinline__ bool operator()(f32x4 (&acc)[2][2][4][2], const pg8::Unit& u, int wr, int wc, int fr, int fq) const {
        const int row0 = u.pm * 256 + wr * 64 + fr, col0 = u.pn * 256 + wc * 32 + 8 * fq;
        int tok[2][4]; float gt[2][4];
#pragma unroll
        for (int ai = 0; ai < 2; ++ai)
#pragma unroll
            for (int m = 0; m < 4; ++m) { const int slot = row0 + ai * 128 + m * 16; tok[ai][m] = ld_i32(RTOK + slot); gt[ai][m] = __uint_as_float((unsigned)ld_i32((const int*)RGATE + slot)); }
#pragma unroll
        for (int ai = 0; ai < 2; ++ai) {
            u32x4 xv[4][2], yv[4][2];
#pragma unroll
            for (int m = 0; m < 4; ++m) { const size_t ro = (size_t)(tok[ai][m] < 0 ? 0 : tok[ai][m]) * D + col0;
#pragma unroll
                for (int bj = 0; bj < 2; ++bj) { xv[m][bj] = *(const u32x4*)(X1B + ro + bj * 128); yv[m][bj] = *(const u32x4*)(Y1 + ro + bj * 128); } }
#pragma unroll
            for (int m = 0; m < 4; ++m) { if (tok[ai][m] >= 0) { const size_t ro = (size_t)tok[ai][m] * D + col0; const float g = gt[ai][m];
#pragma unroll
                for (int bj = 0; bj < 2; ++bj) { const u32x4 y = yv[m][bj], x = xv[m][bj];
                    *(f32x4*)(out + ro + bj * 128) = (f32x4){bf_lo(x.x), bf_hi(x.x), bf_lo(x.y), bf_hi(x.y)} + acc[ai][bj][m][0] * g + (f32x4){bf_lo(y.x), bf_hi(y.x), bf_lo(y.y), bf_hi(y.y)};
                    *(f32x4*)(out + ro + bj * 128 + 4) = (f32x4){bf_lo(x.z), bf_hi(x.z), bf_lo(x.w), bf_hi(x.w)} + acc[ai][bj][m][1] * g + (f32x4){bf_lo(y.z), bf_hi(y.z), bf_lo(y.w), bf_hi(y.w)}; } } }
        }
        return false;
    }
};
struct Args { const float* in[28]; float* out; unsigned char* ws; };

__global__ void __launch_bounds__(NTHREADS, 2) fwd(Args a) {
    extern __shared__ __attribute__((aligned(16))) unsigned char lds_raw[];
    LAS unsigned char* lds = (LAS unsigned char*)lds_raw;
    const int tid = threadIdx.x; const int G = (int)gridDim.x;
    volatile LAS unsigned* misc = (volatile LAS unsigned*)(lds + LDS_MISC_OFF);
    if (tid < 64) misc[tid] = 0u;
    __syncthreads();
    unsigned* ctl = (unsigned*)(a.ws + WS_CTL);
    XcdBarrier bar = xcd_barrier_post(ctl + CW_BAR, misc);
    unsigned char* ws = a.ws;

    p0_prologue(lds, a.in, ws, G);
    xcd_barrier(bar);
    {
        SchedStatic S{(const char*)(ws + WS_HB), (const char*)(ws + WS_WIN), 128, 22, G, (int)blockIdx.x, (size_t)256 * 1024 * 2, (size_t)256 * 1024 * 2};
        EpiProj E{(bf16_t*)(ws + WS_P), a.in[18], a.in[3], a.in[4]};
        pg8::gemm_run<EpiProj, SchedStatic, false>(lds, 1024, S, E);
    }
    xcd_barrier(bar);
    unsigned char* mo = (unsigned char*)a.out;
    for (int u = blockIdx.x; u < ML_UNITS; u += G) ml_state_unit(lds, ws, mo, a.in[10], a.in[11], u);
    xcd_barrier(bar);
    ml_scan_phase(mo, G);
    xcd_barrier(bar);
    attn_phase(lds, a.in, ws, G);
    __syncthreads();
    for (int u = blockIdx.x; u < ML_UNITS; u += G) ml_out_unit(lds, ws, mo, a.in[14], u);
    xcd_barrier(bar);
    {
        SchedPair<true> S{(const char*)(ws + WS_YDA), (const char*)(ws + WS_YML), (const char*)(ws + WS_WDA), (const char*)(ws + WS_WML), 128, 4, G, (int)blockIdx.x, (size_t)256 * 512 * 2, (size_t)256 * 512 * 2};
        EpiMixed<true> E{(const bf16_t*)(ws + WS_P), (bf16_t*)(ws + WS_MIX)};
        pg8::gemm_run<EpiMixed<true>, SchedPair<true>, false>(lds, 512, S, E);
    }
    xcd_barrier(bar);
    {
        SchedStatic S{(const char*)(ws + WS_MIX), (const char*)(ws + WS_WOUT), 128, 4, G, (int)blockIdx.x, (size_t)256 * 1024 * 2, (size_t)256 * 1024 * 2};
        EpiWout E{a.in[0], (bf16_t*)(ws + WS_HB)};
        pg8::gemm_run<EpiWout, SchedStatic, false>(lds, 1024, S, E);
    }
    xcd_barrier(bar);
    router_phase(lds, a.in, ws, (const bf16_t*)(ws + WS_HB), G);
    xcd_barrier(bar);
    moe_plan_phase(lds, ws, G);
    xcd_barrier(bar);
    const int nt0 = ld_i32((const int*)(ws + WS_NT)), nt1 = ld_i32((const int*)(ws + WS_NT) + 1);
    {
        SchedUp S{(const char*)(ws + WS_HB), (const char*)(ws + WS_W13), (const int*)(ws + WS_RTOK), (const int*)(ws + WS_TILEE), nt1, G, (int)blockIdx.x};
        EpiUp E{(bf16_t*)(ws + WS_HID), (const float*)(ws + WS_RSLOT)};
        pg8::gemm_run<EpiUp, SchedUp, true>(lds, 1024, S, E);
    }
    xcd_barrier(bar);
    {
        SchedDown S{(const char*)(ws + WS_HID), (const char*)(ws + WS_W2), (const int*)(ws + WS_TILEE), nt0, nt1, G, (int)blockIdx.x};
        EpiDownY E{(const int*)(ws + WS_RTOK), (const float*)(ws + WS_RGATE), (bf16_t*)(ws + WS_MLQK)};
        pg8::gemm_run<EpiDownY, SchedDown, false>(lds, 512, S, E);
    }
    xcd_barrier(bar);
    {
        SchedDown S{(const char*)(ws + WS_HID), (const char*)(ws + WS_W2), (const int*)(ws + WS_TILEE), 0, nt0, G, (int)blockIdx.x};
        EpiDown E{(const int*)(ws + WS_RTOK), (const float*)(ws + WS_RGATE), a.out, (const bf16_t*)(ws + WS_MLQK), (const bf16_t*)(ws + WS_HB)};
        pg8::gemm_run<EpiDown, SchedDown, false>(lds, 512, S, E);
    }
}

extern "C" void kernel_launch(void* const* d_in, const int* in_sizes, int n_in, void* d_out, int out_size, void* d_ws, size_t ws_size, hipStream_t stream) {
    static int grid = 0;
    if (grid == 0) {
        if (n_in != 28 || out_size != T * D || ws_size < WS_END) { fprintf(stderr, "kernel_launch: unexpected shapes (n_in %d, out %d, ws %zu, need %zu)\n", n_in, out_size, ws_size, (size_t)WS_END); grid = -1; return; }
        int dev = 0, cus = 0, per_cu = 0;
        if (hipGetDevice(&dev) != hipSuccess || hipDeviceGetAttribute(&cus, hipDeviceAttributeMultiprocessorCount, dev) != hipSuccess) { grid = -1; return; }
        if (hipFuncSetAttribute((const void*)fwd, hipFuncAttributeMaxDynamicSharedMemorySize, LDS_BYTES) != hipSuccess) { fprintf(stderr, "kernel_launch: hipFuncSetAttribute failed\n"); grid = -1; return; }
        if (hipOccupancyMaxActiveBlocksPerMultiprocessor(&per_cu, (const void*)fwd, NTHREADS, LDS_BYTES) != hipSuccess || per_cu < 1) { fprintf(stderr, "kernel_launch: occupancy query reports %d\n", per_cu); }
        (void)hipGetLastError();
        grid = cus;
        if (grid != 256) { fprintf(stderr, "kernel_launch: built for a 256-CU device (got %d)\n", cus); grid = -1; return; }
    }
    if (grid < 0) return;
    if (hipMemsetAsync((char*)d_ws + WS_CTL, 0, CTL_BYTES, stream) != hipSuccess) return;
    Args a{};
    for (int i = 0; i < 28; ++i) a.in[i] = (const float*)d_in[i];
    a.out = (float*)d_out; a.ws = (unsigned char*)d_ws;
    hipLaunchKernelGGL(fwd, dim3(grid), dim3(NTHREADS), LDS_BYTES, stream, a);
}
```
